# Optimizing an MI355X kernel written in HIP

```python
import math
import jax, jax.numpy as jnp
from jax import lax
import numpy as np

D_MODEL = 1024
BATCH = 4
SEQ = 8192
DEPTH = 1

CHUNK = 64
QBLK = 128
P_DIM = 256
MLA_HEADS = 8
Q_LORA = 256
KV_LORA = 128
NOPE_D = 64
ROPE_D = 32
V_D = 64
ROPE_THETA = 10000.0
ML_HEADS = 4
ML_HD = 128
ML_W = ML_HEADS * ML_HD
CONV_K = 4
MIX_W = MLA_HEADS * V_D + ML_W
IN_W = Q_LORA + KV_LORA + ROPE_D + ML_W + ML_W + ML_HEADS + ML_HEADS
N_GROUPS = 4
EXPERTS_PER_GROUP = 8
N_EXPERTS = N_GROUPS * EXPERTS_PER_GROUP
TOP_K = 2
D_EXPERT = 256
MOE_BLK = 128
EPS = 1e-6

kernel_name = 'hybrid_mla_mlstm_hier_moe'


def _rmsnorm(x, g):
    xf = x.astype(jnp.float32)
    r = lax.rsqrt(jnp.mean(xf * xf, axis=-1, keepdims=True) + EPS)
    return (xf * r * g.astype(jnp.float32)).astype(x.dtype)


def _split_in(proj):
    sizes = (Q_LORA, KV_LORA, ROPE_D, ML_W, ML_W, ML_HEADS, ML_HEADS)
    offs = np.cumsum(sizes)[:-1].tolist()
    return jnp.split(proj, offs, axis=-1)


def _rope_cs(positions):
    inv = 1.0 / (ROPE_THETA ** (jnp.arange(0, ROPE_D, 2, dtype=jnp.float32) / ROPE_D))
    ang = positions.astype(jnp.float32)[..., None] * inv
    return jnp.cos(ang), jnp.sin(ang)


def _apply_rope(x, cos, sin):
    xf = x.astype(jnp.float32)
    x1, x2 = xf[..., :ROPE_D // 2], xf[..., ROPE_D // 2:]
    return jnp.concatenate([x1 * cos - x2 * sin, x1 * sin + x2 * cos], axis=-1).astype(x.dtype)


def _mla_attention(q_nope, q_rope, k_nope, k_rope, v):
    B, S = q_nope.shape[:2]
    nq = S // QBLK
    scale = 1.0 / math.sqrt(NOPE_D + ROPE_D)
    k_chunk = jnp.arange(S) // CHUNK

    def blocks(t):
        return t.reshape(B, nq, QBLK, MLA_HEADS, t.shape[-1]).transpose(1, 0, 3, 2, 4)

    def one(args):
        qn, qr, blk = args
        s = (jnp.einsum('bhqd,bkhd->bhqk', qn, k_nope)
             + jnp.einsum('bhqr,bkr->bhqk', qr, k_rope)).astype(jnp.float32) * scale
        q_chunk = (blk * QBLK + jnp.arange(QBLK)) // CHUNK
        mask = k_chunk[None, :] <= q_chunk[:, None]
        s = jnp.where(mask, s, -1e30)
        pr = jax.nn.softmax(s, axis=-1).astype(v.dtype)
        return jnp.einsum('bhqk,bkhv->bhqv', pr, v)

    o = lax.map(one, (blocks(q_nope), blocks(q_rope), jnp.arange(nq)))
    return o.transpose(1, 0, 3, 2, 4).reshape(B, S, MLA_HEADS * V_D)


def _causal_conv(x, w, b):
    S = x.shape[1]
    xp = jnp.pad(x, ((0, 0), (CONV_K - 1, 0), (0, 0)))
    return sum(xp[:, k:k + S] * w[k] for k in range(CONV_K)) + b


def _mlstm_chunkwise(q, k, v, i_pre, f_pre):
    B, H, S, dk = q.shape
    dv = v.shape[-1]
    L = CHUNK
    nc = S // L

    def chunks(t):
        return t.reshape(B, H, nc, L, t.shape[-1]).transpose(2, 0, 1, 3, 4).astype(jnp.float32)

    qc, kc, vc = chunks(q), chunks(k), chunks(v)
    ic = i_pre.astype(jnp.float32).reshape(B, H, nc, L).transpose(2, 0, 1, 3)
    logf = jax.nn.log_sigmoid(f_pre.astype(jnp.float32)).reshape(B, H, nc, L).transpose(2, 0, 1, 3)
    bc = jnp.cumsum(logf, axis=-1)
    tril = jnp.tril(jnp.ones((L, L), dtype=bool))

    def step(carry, inp):
        C, n, m = carry
        q_, k_, v_, i_, b_ = inp
        D = b_[..., :, None] - b_[..., None, :] + i_[..., None, :]
        D = jnp.where(tril, D, -jnp.inf)
        inter = b_ + m[..., None]
        m_t = jnp.maximum(jnp.max(D, axis=-1), inter)
        w_intra = jnp.exp(D - m_t[..., None])
        w_inter = jnp.exp(inter - m_t)
        qk = jnp.einsum('bhtd,bhsd->bhts', q_, k_) * w_intra
        num = jnp.einsum('bhts,bhsv->bhtv', qk, v_) + w_inter[..., None] * jnp.einsum('bhtd,bhdv->bhtv', q_, C)
        den = jnp.sum(qk, axis=-1) + w_inter * jnp.einsum('bhtd,bhd->bht', q_, n)
        den = jnp.maximum(jnp.abs(den), jnp.exp(-m_t))
        h = num / den[..., None]
        bL = b_[..., -1]
        w_s = bL[..., None] - b_ + i_
        m_new = jnp.maximum(bL + m, jnp.max(w_s, axis=-1))
        ws = jnp.exp(w_s - m_new[..., None])
        decay = jnp.exp(bL + m - m_new)
        C_new = decay[..., None, None] * C + jnp.einsum('bhs,bhsd,bhsv->bhdv', ws, k_, v_)
        n_new = decay[..., None] * n + jnp.einsum('bhs,bhsd->bhd', ws, k_)
        return (C_new, n_new, m_new), h

    init = (jnp.zeros((B, H, dk, dv), jnp.float32), jnp.zeros((B, H, dk), jnp.float32),
            jnp.zeros((B, H), jnp.float32))
    _, hs = lax.scan(step, init, (qc, kc, vc, ic, bc))
    return hs.transpose(1, 2, 0, 3, 4).reshape(B, H, S, dv)


def _hier_moe(h, w_rg, b_rg, w_re, b_re, w_g, w_u, w_d):
    B, S, D = h.shape
    T = B * S
    hf = h.reshape(T, D)
    g_prob = jax.nn.softmax((hf @ w_rg).astype(jnp.float32) + b_rg.astype(jnp.float32), axis=-1)
    g_top, g_idx = lax.top_k(g_prob, 1)
    e_logits = ((hf @ w_re).astype(jnp.float32) + b_re.astype(jnp.float32)).reshape(T, N_GROUPS, EXPERTS_PER_GROUP)
    e_in = jnp.take_along_axis(e_logits, g_idx[:, :, None], axis=1)[:, 0]
    e_top, e_idx = lax.top_k(jax.nn.softmax(e_in, axis=-1), TOP_K)
    wts = g_top * e_top / jnp.sum(e_top, axis=-1, keepdims=True)
    eid = g_idx * EXPERTS_PER_GROUP + e_idx
    M = T * TOP_K
    P = M + N_EXPERTS * MOE_BLK
    nb = P // MOE_BLK
    flat_e = eid.reshape(M).astype(jnp.int32)
    flat_w = wts.reshape(M)
    flat_tok = jnp.repeat(jnp.arange(T, dtype=jnp.int32), TOP_K)
    order = jnp.argsort(flat_e)
    sorted_e = flat_e[order]
    counts = jnp.zeros((N_EXPERTS,), jnp.int32).at[flat_e].add(1)
    starts = jnp.cumsum(counts) - counts
    padded = (counts + MOE_BLK - 1) // MOE_BLK * MOE_BLK
    pad_ends = jnp.cumsum(padded)
    pad_starts = pad_ends - padded
    dest = pad_starts[sorted_e] + (jnp.arange(M, dtype=jnp.int32) - starts[sorted_e])
    row_tok = jnp.full((P,), T, jnp.int32).at[dest].set(flat_tok[order])
    row_w = jnp.zeros((P,), jnp.float32).at[dest].set(flat_w[order])
    block_e = jnp.minimum(jnp.searchsorted(pad_ends, jnp.arange(nb, dtype=jnp.int32) * MOE_BLK, side='right'),
                          N_EXPERTS - 1)
    x_pad = jnp.concatenate([hf, jnp.zeros((1, D), hf.dtype)], axis=0)
    x_rows = x_pad[row_tok].reshape(nb, MOE_BLK, D)

    def expert(args):
        xb, e = args
        return (jax.nn.silu(xb @ w_g[e]) * (xb @ w_u[e])) @ w_d[e]

    y = lax.map(expert, (x_rows, block_e)).reshape(P, D)
    out = jnp.zeros((T + 1, D), jnp.float32).at[row_tok].add(y.astype(jnp.float32) * row_w[:, None])[:T]
    return out.reshape(B, S, D).astype(h.dtype)


def setup_inputs(seed: int = 0) -> dict:
    key = jax.random.key(seed)
    ks = jax.random.split(key, 40)
    f32 = jnp.float32

    def nrm(k, shape, fan_in):
        return jax.random.normal(k, shape, f32) * (fan_in ** -0.5)

    def gain(k, shape):
        return 1.0 + 0.05 * jax.random.normal(k, shape, f32)

    x = jax.random.normal(ks[0], (BATCH, SEQ, D_MODEL), f32)
    p = jax.random.normal(ks[1], (DEPTH, BATCH, SEQ, P_DIM), f32)
    positions = (jax.random.randint(ks[2], (BATCH, 1), 0, 4096, dtype=jnp.int32)
                 + jnp.arange(SEQ, dtype=jnp.int32)[None, :])
    return {
        'x': x,
        'p': p,
        'positions': positions,
        'norm_mix_g': gain(ks[3], (DEPTH, D_MODEL)),
        'w_in': nrm(ks[4], (DEPTH, D_MODEL, IN_W), D_MODEL),
        'q_norm_g': gain(ks[5], (DEPTH, Q_LORA)),
        'w_uq': nrm(ks[6], (DEPTH, Q_LORA, MLA_HEADS * (NOPE_D + ROPE_D)), Q_LORA),
        'kv_norm_g': gain(ks[7], (DEPTH, KV_LORA)),
        'w_ukv': nrm(ks[8], (DEPTH, KV_LORA, MLA_HEADS * (NOPE_D + V_D)), KV_LORA),
        'conv_w': nrm(ks[9], (DEPTH, CONV_K, ML_W), CONV_K),
        'conv_b': 0.02 * jax.random.normal(ks[10], (DEPTH, ML_W), f32),
        'w_mq': nrm(ks[11], (DEPTH, ML_HEADS, ML_HD, ML_HD), ML_HD),
        'w_mk': nrm(ks[12], (DEPTH, ML_HEADS, ML_HD, ML_HD), ML_HD),
        'w_mv': nrm(ks[13], (DEPTH, ML_HEADS, ML_HD, ML_HD), ML_HD),
        'b_igate': 0.1 * jax.random.normal(ks[14], (DEPTH, ML_HEADS), f32),
        'b_fgate': jnp.linspace(3.0, 6.0, ML_HEADS, dtype=f32)[None, :] + 0.1 * jax.random.normal(ks[15], (DEPTH, ML_HEADS), f32),
        'mh_norm_g': gain(ks[16], (DEPTH, ML_W)),
        'ml_skip': gain(ks[17], (DEPTH, ML_W)),
        'w_o': nrm(ks[18], (DEPTH, MIX_W, D_MODEL), MIX_W),
        'norm_ffn_g': gain(ks[19], (DEPTH, D_MODEL)),
        'w_router_group': nrm(ks[20], (DEPTH, D_MODEL, N_GROUPS), D_MODEL),
        'b_router_group': 0.01 * jax.random.normal(ks[21], (DEPTH, N_GROUPS), f32),
        'w_router_expert': nrm(ks[22], (DEPTH, D_MODEL, N_EXPERTS), D_MODEL),
        'b_router_expert': 0.01 * jax.random.normal(ks[23], (DEPTH, N_EXPERTS), f32),
        'w_gate_e': nrm(ks[24], (DEPTH, N_EXPERTS, D_MODEL, D_EXPERT), D_MODEL),
        'w_up_e': nrm(ks[25], (DEPTH, N_EXPERTS, D_MODEL, D_EXPERT), D_MODEL),
        'w_down_e': nrm(ks[26], (DEPTH, N_EXPERTS, D_EXPERT, D_MODEL), D_EXPERT),
        'norm_ple_g': gain(ks[27], (DEPTH, D_MODEL)),
        'w_ple': nrm(ks[28], (DEPTH, P_DIM, D_MODEL), P_DIM),
        'w_ple_gate': nrm(ks[29], (DEPTH, D_MODEL, D_MODEL), D_MODEL),
        'final_norm_g': gain(ks[30], (D_MODEL,)),
    }


def reference(x, p, positions, norm_mix_g, w_in, q_norm_g, w_uq, kv_norm_g, w_ukv, conv_w, conv_b,
              w_mq, w_mk, w_mv, b_igate, b_fgate, mh_norm_g, ml_skip, w_o, norm_ffn_g,
              w_router_group, b_router_group, w_router_expert, b_router_expert,
              w_gate_e, w_up_e, w_down_e, norm_ple_g, w_ple, w_ple_gate, final_norm_g):
    B, S, _ = x.shape
    cos, sin = _rope_cs(positions)
    for i in range(DEPTH):
        h = _rmsnorm(x, norm_mix_g[i])
        c_q, c_kv, k_r, x_m, z, i_pre, f_pre = _split_in(h @ w_in[i])
        q = (_rmsnorm(c_q, q_norm_g[i]) @ w_uq[i]).reshape(B, S, MLA_HEADS, NOPE_D + ROPE_D)
        kv = (_rmsnorm(c_kv, kv_norm_g[i]) @ w_ukv[i]).reshape(B, S, MLA_HEADS, NOPE_D + V_D)
        q_nope, q_rope = q[..., :NOPE_D], _apply_rope(q[..., NOPE_D:], cos[:, :, None], sin[:, :, None])
        k_nope, v = kv[..., :NOPE_D], kv[..., NOPE_D:]
        k_rope = _apply_rope(k_r, cos, sin)
        attn_out = _mla_attention(q_nope, q_rope, k_nope, k_rope, v)
        xc = jax.nn.silu(_causal_conv(x_m, conv_w[i], conv_b[i]))
        xch = xc.reshape(B, S, ML_HEADS, ML_HD)
        xmh = x_m.reshape(B, S, ML_HEADS, ML_HD)
        mq = jnp.einsum('bshd,hde->bhse', xch, w_mq[i])
        mk = jnp.einsum('bshd,hde->bhse', xch, w_mk[i]) * (ML_HD ** -0.5)
        mv = jnp.einsum('bshd,hde->bhse', xmh, w_mv[i])
        ig = (i_pre + b_igate[i]).transpose(0, 2, 1)
        fg = (f_pre + b_fgate[i]).transpose(0, 2, 1)
        hm = _mlstm_chunkwise(mq, mk, mv, ig, fg).transpose(0, 2, 1, 3)
        mu = jnp.mean(hm, axis=-1, keepdims=True)
        var = jnp.mean(jnp.square(hm - mu), axis=-1, keepdims=True)
        hm = ((hm - mu) * lax.rsqrt(var + EPS)).reshape(B, S, ML_W) * mh_norm_g[i].astype(jnp.float32)
        ml_out = ((hm.astype(x.dtype) + ml_skip[i] * xc) * jax.nn.silu(z)).astype(x.dtype)
        x = x + jnp.concatenate([attn_out, ml_out], axis=-1) @ w_o[i]
        x = x + _hier_moe(_rmsnorm(x, norm_ffn_g[i]), w_router_group[i], b_router_group[i],
                          w_router_expert[i], b_router_expert[i], w_gate_e[i], w_up_e[i], w_down_e[i])
        hp = _rmsnorm(x, norm_ple_g[i])
        x = x + (p[i] @ w_ple[i]) * jax.nn.sigmoid(hp @ w_ple_gate[i])
    return _rmsnorm(x, final_norm_g)
```

```cpp
#include <hip/hip_runtime.h>
#include <cstdio>
#include <cstdint>

#ifndef MK_MULTI
#define MK_MULTI 0
#endif

typedef unsigned short bf16_t;
typedef short bf16x8 __attribute__((ext_vector_type(8)));
typedef short s16x4 __attribute__((ext_vector_type(4)));
typedef float f32x4 __attribute__((ext_vector_type(4)));
typedef float f32x16 __attribute__((ext_vector_type(16)));
typedef unsigned u32x4 __attribute__((ext_vector_type(4)));
typedef unsigned u32x2 __attribute__((ext_vector_type(2)));
#define LAS __attribute__((address_space(3)))
typedef LAS const char* lds_cptr;
typedef short v4i16_t __attribute__((ext_vector_type(4)));

constexpr int T_TOK = 32768, DM = 1024, SEQ = 8192, NB = 4;
constexpr int INW = 1448, INWP = 1536;
constexpr int C_CQ = 0, C_CKV = 256, C_KR = 384, C_XM = 416, C_Z = 928, C_IG = 1440;
constexpr int QW = 768, KW = 768, VW = 512;
constexpr int NEXP = 32, DEXP = 256;
constexpr int PROWS = 65536 + 32 * 256;
constexpr float EPS = 1e-6f;
constexpr float QSCALE = 0.10206207261596577f * 1.4426950408889634f;

constexpr size_t MiB = 1ull << 20;
constexpr size_t OFF_BAR = 0;
constexpr size_t OFF_CNT = 16384;
constexpr size_t CTL_BYTES = 32768;
constexpr size_t OFF_WIN = 1 * MiB;
constexpr size_t OFF_WUQ = OFF_WIN + (size_t)INWP * 1024 * 2;
constexpr size_t OFF_WUKV = OFF_WUQ + 768 * 256 * 2;
constexpr size_t OFF_WM = OFF_WUKV + 1024 * 128 * 2;
constexpr size_t OFF_WO = OFF_WM + 12 * 128 * 128 * 2;
constexpr size_t OFF_WR = OFF_WO + 1024 * 1024 * 2;
constexpr size_t OFF_WGU = OFF_WR + 128 * 1024 * 2;
constexpr size_t OFF_WD = OFF_WGU + (size_t)32 * 512 * 1024 * 2;
constexpr size_t OFF_WPLE = OFF_WD + (size_t)32 * 1024 * 256 * 2;
constexpr size_t OFF_WPG = OFF_WPLE + 1024 * 256 * 2;
constexpr size_t OFF_ROPE = OFF_WPG + 1024 * 1024 * 2;
constexpr size_t OFF_PB = OFF_ROPE + (size_t)T_TOK * 32 * 4;
constexpr size_t OFF_GATES = OFF_PB + (size_t)T_TOK * 256 * 2;
constexpr size_t OFF_CSTAT = OFF_GATES + (size_t)T_TOK * 8 * 4;
constexpr size_t OFF_NST = OFF_CSTAT + 2048 * 2 * 4;
constexpr size_t OFF_MST = OFF_NST + 256 * 8 * 128 * 4;
constexpr size_t OFF_TOKREC = OFF_MST + 256 * 8 * 4;
constexpr size_t OFF_LIST = OFF_TOKREC + (size_t)T_TOK * 16;
constexpr size_t OFF_STATIC_END = OFF_LIST + (size_t)32 * T_TOK * 4;
static_assert(OFF_STATIC_END <= 88 * MiB, "static region");
constexpr size_t OFF_PROJ = 88 * MiB;
constexpr size_t OFF_XC = OFF_PROJ + 96 * MiB;
constexpr size_t OFF_MQ = OFF_XC + 32 * MiB;
constexpr size_t OFF_MK = OFF_MQ + 32 * MiB;
constexpr size_t OFF_MV = OFF_MK + 32 * MiB;
constexpr size_t OFF_ATT = OFF_MV + 32 * MiB;
constexpr size_t OFF_XN = OFF_ATT + 32 * MiB;
constexpr size_t OFF_STATE = OFF_XN + 64 * MiB;
constexpr size_t OFF_MLO = OFF_STATE + 64 * MiB;
constexpr size_t WS_END = OFF_MLO + 32 * MiB;
static_assert(WS_END <= 512 * MiB, "workspace");
constexpr size_t OFF_ACT = OFF_PROJ;
constexpr size_t OFF_Y = OFF_XC;
static_assert(OFF_Y + (size_t)PROWS * 1024 * 2 <= OFF_XN, "y overlay");
constexpr size_t OFF_PE = OFF_STATE;

#define XB_TMO      128
#define XB_XCNT(j)  (256  + 64 * (j))
#define XB_XSUB(j)  (1280 + 64 * (j))
#define XB_XGEN(j)  (2304 + 64 * (j))
#define XB_TOP      3328
#define XB_TOPGEN   3392
#define XCD_BAR_WORDS 3456
#define XB_SPIN_CAP (1u << 18)

__device__ __forceinline__ unsigned xb_ld(unsigned* p)              { return __hip_atomic_load(p, __ATOMIC_RELAXED, __HIP_MEMORY_SCOPE_AGENT); }
__device__ __forceinline__ unsigned xb_add(unsigned* p, unsigned v) { return __hip_atomic_fetch_add(p, v, __ATOMIC_RELAXED, __HIP_MEMORY_SCOPE_AGENT); }
__device__ __forceinline__ unsigned xb_xcc_id() { return (unsigned)__builtin_amdgcn_s_getreg((3 << 11) | 20) & 0xFu; }
#define XB_SPIN(cond, bar) do { unsigned _sp = 0; while (cond) { __builtin_amdgcn_s_sleep(1); \
    if ((++_sp & 255u) == 0u) { if (xb_ld(&(bar)[XB_TMO])) break; if (_sp > XB_SPIN_CAP) { atomicAdd(&(bar)[XB_TMO], 1u); break; } } } } while (0)

struct XcdBarrier { unsigned* bar; unsigned x; volatile LAS unsigned* st; };

__device__ __forceinline__ XcdBarrier xcd_barrier_post(unsigned* bar, volatile LAS unsigned* st) {
    XcdBarrier b; b.bar = bar; b.x = xb_xcc_id(); b.st = st;
    if (threadIdx.x == 0) (void)xb_add(&bar[XB_XCNT(b.x)], 1u);
    return b;
}
__device__ __forceinline__ void xcd_barrier_complete(unsigned* bar, unsigned x, unsigned& nloc, unsigned& nx) {
    const unsigned G = gridDim.x * gridDim.y * gridDim.z;
    unsigned sum, cnt, mine, sp = 0u;
    for (;;) {
        sum = 0u; cnt = 0u; mine = 0u;
#pragma unroll
        for (unsigned j = 0; j < 16; ++j) { const unsigned c = xb_ld(&bar[XB_XCNT(j)]); sum += c; cnt += (c > 0u) ? 1u : 0u; mine = (j == x) ? c : mine; }
        if (sum == G) break;
        __builtin_amdgcn_s_sleep(1);
        if ((++sp & 255u) == 0u) { if (xb_ld(&bar[XB_TMO])) break; if (sp > XB_SPIN_CAP) { atomicAdd(&bar[XB_TMO], 1u); break; } }
    }
    nloc = mine > 0u ? mine : 1u; nx = cnt > 0u ? cnt : 1u;
}
__device__ __forceinline__ void xcd_barrier(const XcdBarrier& b) {
    asm volatile("s_waitcnt vmcnt(0)" ::: "memory");
    __syncthreads();
    if (threadIdx.x == 0) {
        unsigned* bar = b.bar;
        __builtin_amdgcn_s_waitcnt(0);
        unsigned nloc = b.st[0], nx = b.st[1];
        if (nloc == 0u) { xcd_barrier_complete(bar, b.x, nloc, nx); b.st[0] = nloc; b.st[1] = nx; }
        const unsigned old = xb_add(&bar[XB_XSUB(b.x)], 1u);
        const unsigned gen = old / nloc;
        if (old + 1u == (gen + 1u) * nloc) {
            __builtin_amdgcn_fence(__ATOMIC_RELEASE, "agent");
            asm volatile("s_waitcnt vmcnt(0)" ::: "memory");
            const unsigned og = xb_add(&bar[XB_TOP], 1u);
            const unsigned tg = og / nx;
            if (og + 1u == (tg + 1u) * nx) xb_add(&bar[XB_TOPGEN], 1u);
            else XB_SPIN(xb_ld(&bar[XB_TOPGEN]) == tg, bar);
            __builtin_amdgcn_fence(__ATOMIC_ACQUIRE, "agent");
            xb_add(&bar[XB_XGEN(b.x)], 1u);
            asm volatile("s_waitcnt vmcnt(0)" ::: "memory");
        } else {
            XB_SPIN(xb_ld(&bar[XB_XGEN(b.x)]) == gen, bar);
            __builtin_amdgcn_fence(__ATOMIC_ACQUIRE, "agent");
            asm volatile("s_waitcnt vmcnt(0)" ::: "memory");
        }
    }
    __syncthreads();
}

typedef __bf16 bf16x2_t __attribute__((ext_vector_type(2)));
typedef float f32x2 __attribute__((ext_vector_type(2)));
__device__ __forceinline__ unsigned cvtpk(float lo, float hi) { f32x2 v = {lo, hi}; bf16x2_t b = __builtin_convertvector(v, bf16x2_t); return __builtin_bit_cast(unsigned, b); }
__device__ __forceinline__ float bf2f(unsigned short v) { return __uint_as_float((unsigned)v << 16); }
__device__ __forceinline__ float bflo(unsigned w) { return __uint_as_float(w << 16); }
__device__ __forceinline__ float bfhi(unsigned w) { return __uint_as_float(w & 0xffff0000u); }
__device__ __forceinline__ void st4bf(bf16_t* p, f32x4 v) { u32x2 w; w.x = cvtpk(v[0], v[1]); w.y = cvtpk(v[2], v[3]); *(u32x2*)p = w; }
__device__ __forceinline__ float wsum(float v) {
#pragma unroll
    for (int o = 32; o > 0; o >>= 1) v += __shfl_xor(v, o);
    return v; }
__device__ __forceinline__ float wmax(float v) {
#pragma unroll
    for (int o = 32; o > 0; o >>= 1) v = fmaxf(v, __shfl_xor(v, o));
    return v; }
__device__ __forceinline__ float siluf(float v) { return v / (1.f + __expf(-v)); }
__device__ __forceinline__ float sigmf(float v) { return 1.f / (1.f + __expf(-v)); }
__device__ __forceinline__ void glds16(const void* g, unsigned lds_base) {
    unsigned sv; asm volatile("s_mov_b32 %0, m0\n\ts_mov_b32 m0, %2\n\ts_nop 0\n\tglobal_load_lds_dwordx4 %1, off\n\ts_mov_b32 m0, %0" : "=&s"(sv) : "v"(g), "s"(lds_base) : "memory"); }
#define RFL(x) __builtin_amdgcn_readfirstlane(x)
#define MFMA16(a, b, c) __builtin_amdgcn_mfma_f32_16x16x32_bf16(a, b, c, 0, 0, 0)
#define MFMA32(a, b, c) __builtin_amdgcn_mfma_f32_32x32x16_bf16(a, b, c, 0, 0, 0)
#define WAITVM0() asm volatile("s_waitcnt vmcnt(0)" ::: "memory")
#define WAITLGKM0() asm volatile("s_waitcnt lgkmcnt(0)" ::: "memory")
__device__ __forceinline__ int crow(int r, int hi) { return (r & 3) + 8 * (r >> 2) + 4 * hi; }
__device__ __forceinline__ s16x4 vtr(lds_cptr p) { return __builtin_bit_cast(s16x4, __builtin_amdgcn_ds_read_tr16_b64_v4i16((LAS v4i16_t*)p)); }
__device__ __forceinline__ bf16x8 cat8(s16x4 a, s16x4 b) { return (bf16x8){a[0], a[1], a[2], a[3], b[0], b[1], b[2], b[3]}; }

struct Params {
    const float* x; const float* p; const int* pos;
    const float *norm_mix_g, *w_in, *q_norm_g, *w_uq, *kv_norm_g, *w_ukv, *conv_w, *conv_b, *w_mq, *w_mk, *w_mv, *b_igate, *b_fgate,
                *mh_norm_g, *ml_skip, *w_o, *norm_ffn_g, *w_rg, *b_rg, *w_re, *b_re, *w_gate_e, *w_up_e, *w_down_e, *norm_ple_g, *w_ple, *w_pg, *final_g;
    float* out; unsigned char* ws; int ph_lo, ph_hi;
};

constexpr int G_STAGE = 49152;
constexpr int LDS_GEMM = 2 * G_STAGE;
template <int MT, class RowFn>
__device__ __forceinline__ void gemm_core(f32x4 (&acc)[MT][4], const bf16_t* A0, int ld0, const bf16_t* A1, int ld1, int ksplit, RowFn rowfn,
                                          const bf16_t* Bt, int ldb, int nk, char* lds) {
    const int tid = threadIdx.x, lane = tid & 63, wid = RFL(tid >> 6), wr = wid >> 1, wc = wid & 1, fr = lane & 15, fq = lane >> 4;
    const unsigned lds0 = (unsigned)(uintptr_t)lds;
    const int cch = (lane & 7) ^ (lane >> 3);
    int growA[MT];
#pragma unroll
    for (int i = 0; i < MT; ++i) growA[i] = rowfn(i * 64 + wid * 8 + (lane >> 3));
    const bf16_t* bp0 = Bt + (size_t)(wid * 8 + (lane >> 3)) * ldb + cch * 8;
    const bf16_t* bp1 = bp0 + (size_t)64 * ldb;
#pragma unroll
    for (int m = 0; m < MT; ++m)
#pragma unroll
        for (int n = 0; n < 4; ++n) acc[m][n] = (f32x4){0.f, 0.f, 0.f, 0.f};
    auto stage = [&](int kt, int buf) {
        const bf16_t* ab = A0; int ld = ld0, kk = kt;
        if (kt >= ksplit) { ab = A1; ld = ld1; kk = kt - ksplit; }
#pragma unroll
        for (int i = 0; i < MT; ++i) glds16(ab + (size_t)growA[i] * ld + kk * 64 + cch * 8, RFL(lds0 + buf * G_STAGE + i * 8192 + wid * 1024));
        glds16(bp0 + kt * 64, RFL(lds0 + buf * G_STAGE + 32768 + wid * 1024));
        glds16(bp1 + kt * 64, RFL(lds0 + buf * G_STAGE + 32768 + 8192 + wid * 1024));
    };
    __syncthreads();
    stage(0, 0);
    for (int kt = 0; kt < nk; ++kt) {
        WAITVM0(); __syncthreads();
        if (kt + 1 < nk) stage(kt + 1, (kt + 1) & 1);
        const char* sa = lds + (kt & 1) * G_STAGE; const char* sb = sa + 32768;
#pragma unroll
        for (int kk = 0; kk < 2; ++kk) {
            bf16x8 af[MT], bfr[4];
            const int sw = ((4 * kk + fq) ^ (fr & 7)) << 4;
#pragma unroll
            for (int m = 0; m < MT; ++m) af[m] = *(const bf16x8*)(sa + (wr * 16 * MT + 16 * m + fr) * 128 + sw);
#pragma unroll
            for (int n = 0; n < 4; ++n) bfr[n] = *(const bf16x8*)(sb + (wc * 64 + 16 * n + fr) * 128 + sw);
#pragma unroll
            for (int m = 0; m < MT; ++m)
#pragma unroll
                for (int n = 0; n < 4; ++n) acc[m][n] = MFMA16(bfr[n], af[m], acc[m][n]);
        }
    }
}

__device__ __forceinline__ void tr_tile(const float* src, int N, int k0, int n0, bf16_t* dst, int ldd, int mode, float scale, const float* kgain, float* tile) {
    const int tid = threadIdx.x;
    __syncthreads();
#pragma unroll
    for (int i = 0; i < 8; ++i) { const int idx = tid + 512 * i, kk = idx >> 6, nn = idx & 63;
        float v = 0.f; if (n0 + nn < N) v = src[(size_t)(k0 + kk) * N + n0 + nn];
        if (kgain) v *= kgain[k0 + kk];
        tile[kk * 65 + nn] = v * scale; }
    __syncthreads();
#pragma unroll
    for (int i = 0; i < 8; ++i) { const int idx = tid + 512 * i, nn = idx >> 6, kk = idx & 63; const int n = n0 + nn;
        if (n < N) { int r = n; if (mode) r = (n >> 6) * 128 + ((n >> 5) & 1) * 64 + (mode - 1) * 32 + (n & 31);
            dst[(size_t)r * ldd + k0 + kk] = (bf16_t)(cvtpk(tile[kk * 65 + nn], 0.f) & 0xffffu); } }
}

__device__ __forceinline__ void phase_prep(const Params& P, char* lds) {
    unsigned char* ws = P.ws; float* tile = (float*)lds;
    const int bid = blockIdx.x, nb = gridDim.x, tid = threadIdx.x;
    const int NJ = 12;
    const int cnt[NJ] = {16 * 23, 4 * 12, 2 * 16, 12 * 4, 256, 2048, 2048, 2048, 64, 256, 16, 16};
    int total = 0;
#pragma unroll
    for (int j = 0; j < NJ; ++j) total += cnt[j];
    for (int u = bid; u < total; u += nb) {
        int j = 0, r = u;
#pragma unroll
        for (int jj = 0; jj < NJ - 1; ++jj) if (j == jj && r >= cnt[jj]) { r -= cnt[jj]; j = jj + 1; }
        switch (j) {
        case 0: tr_tile(P.w_in, INW, (r / 23) * 64, (r % 23) * 64, (bf16_t*)(ws + OFF_WIN), 1024, 0, 1.f, nullptr, tile); break;
        case 1: tr_tile(P.w_uq, 768, (r / 12) * 64, (r % 12) * 64, (bf16_t*)(ws + OFF_WUQ), 256, 0, 1.f, P.q_norm_g, tile); break;
        case 2: tr_tile(P.w_ukv, 1024, (r / 16) * 64, (r % 16) * 64, (bf16_t*)(ws + OFF_WUKV), 128, 0, 1.f, P.kv_norm_g, tile); break;
        case 3: { const int mat = r >> 2, t4 = r & 3, kind = mat >> 2, h = mat & 3; const float* s = (kind == 0 ? P.w_mq : kind == 1 ? P.w_mk : P.w_mv) + h * 16384;
                  tr_tile(s, 128, (t4 >> 1) * 64, (t4 & 1) * 64, (bf16_t*)(ws + OFF_WM) + mat * 16384, 128, 0, kind == 1 ? 0.08838834764831845f : 1.f, nullptr, tile); } break;
        case 4: tr_tile(P.w_o, 1024, (r >> 4) * 64, (r & 15) * 64, (bf16_t*)(ws + OFF_WO), 1024, 0, 1.f, nullptr, tile); break;
        case 5: { const int e = r >> 6, t6 = r & 63; tr_tile(P.w_gate_e + (size_t)e * 1024 * 256, 256, (t6 >> 2) * 64, (t6 & 3) * 64, (bf16_t*)(ws + OFF_WGU) + (size_t)e * 512 * 1024, 1024, 1, 1.f, nullptr, tile); } break;
        case 6: { const int e = r >> 6, t6 = r & 63; tr_tile(P.w_up_e + (size_t)e * 1024 * 256, 256, (t6 >> 2) * 64, (t6 & 3) * 64, (bf16_t*)(ws + OFF_WGU) + (size_t)e * 512 * 1024, 1024, 2, 1.f, nullptr, tile); } break;
        case 7: { const int e = r >> 6, t6 = r & 63; tr_tile(P.w_down_e + (size_t)e * 256 * 1024, 1024, (t6 >> 4) * 64, (t6 & 15) * 64, (bf16_t*)(ws + OFF_WD) + (size_t)e * 1024 * 256, 256, 0, 1.f, nullptr, tile); } break;
        case 8: tr_tile(P.w_ple, 1024, (r >> 4) * 64, (r & 15) * 64, (bf16_t*)(ws + OFF_WPLE), 256, 0, 1.f, nullptr, tile); break;
        case 9: tr_tile(P.w_pg, 1024, (r >> 4) * 64, (r & 15) * 64, (bf16_t*)(ws + OFF_WPG), 1024, 0, 1.f, nullptr, tile); break;
        case 10: tr_tile(P.w_rg, 4, r * 64, 0, (bf16_t*)(ws + OFF_WR), 1024, 0, 1.f, nullptr, tile); break;
        default: tr_tile(P.w_re, 32, r * 64, 0, (bf16_t*)(ws + OFF_WR) + 4 * 1024, 1024, 0, 1.f, nullptr, tile); break;
        }
    }
    { u32x4 z = (u32x4){0u, 0u, 0u, 0u};
      u32x4* a = (u32x4*)((bf16_t*)(ws + OFF_WIN) + (size_t)INW * 1024); const int na = (INWP - INW) * 1024 / 8;
      for (int i = bid * 512 + tid; i < na; i += nb * 512) a[i] = z;
      u32x4* b = (u32x4*)((bf16_t*)(ws + OFF_WR) + 36 * 1024); const int nbz = (128 - 36) * 1024 / 8;
      for (int i = bid * 512 + tid; i < nbz; i += nb * 512) b[i] = z; }
    { float2* rt = (float2*)(ws + OFF_ROPE);
      for (int i = bid * 512 + tid; i < T_TOK * 16; i += nb * 512) { const int t = i >> 4, j = i & 15;
          const float inv = 1.0f / powf(10000.0f, (float)(2 * j) / 32.0f); const float ang = (float)P.pos[t] * inv; float s, c; sincosf(ang, &s, &c); rt[i] = make_float2(c, s); } }
    { const f32x4* src = (const f32x4*)P.p; u32x2* dst = (u32x2*)(ws + OFF_PB);
      for (int i = bid * 512 + tid; i < T_TOK * 256 / 4; i += nb * 512) { const f32x4 v = src[i]; u32x2 w; w.x = cvtpk(v[0], v[1]); w.y = cvtpk(v[2], v[3]); dst[i] = w; } }
    { const int lane = tid & 63, wv = tid >> 6; bf16_t* xn = (bf16_t*)(ws + OFF_XN);
      const f32x4 g0 = *(const f32x4*)(P.norm_mix_g + lane * 8), g1 = *(const f32x4*)(P.norm_mix_g + lane * 8 + 4), g2 = *(const f32x4*)(P.norm_mix_g + 512 + lane * 8), g3 = *(const f32x4*)(P.norm_mix_g + 512 + lane * 8 + 4);
      for (int row = bid * 8 + wv; row < T_TOK; row += nb * 8) { const float* xr = P.x + (size_t)row * DM;
          const f32x4 a0 = *(const f32x4*)(xr + lane * 8), a1 = *(const f32x4*)(xr + lane * 8 + 4), a2 = *(const f32x4*)(xr + 512 + lane * 8), a3 = *(const f32x4*)(xr + 512 + lane * 8 + 4);
          float ss = 0.f;
#pragma unroll
          for (int e = 0; e < 4; ++e) ss += a0[e] * a0[e] + a1[e] * a1[e] + a2[e] * a2[e] + a3[e] * a3[e];
          ss = wsum(ss); const float r = rsqrtf(ss * (1.0f / DM) + EPS);
          u32x4 w0, w1;
          w0.x = cvtpk(a0[0] * r * g0[0], a0[1] * r * g0[1]); w0.y = cvtpk(a0[2] * r * g0[2], a0[3] * r * g0[3]); w0.z = cvtpk(a1[0] * r * g1[0], a1[1] * r * g1[1]); w0.w = cvtpk(a1[2] * r * g1[2], a1[3] * r * g1[3]);
          w1.x = cvtpk(a2[0] * r * g2[0], a2[1] * r * g2[1]); w1.y = cvtpk(a2[2] * r * g2[2], a2[3] * r * g2[3]); w1.z = cvtpk(a3[0] * r * g3[0], a3[1] * r * g3[1]); w1.w = cvtpk(a3[2] * r * g3[2], a3[3] * r * g3[3]);
          *(u32x4*)(xn + (size_t)row * DM + lane * 8) = w0; *(u32x4*)(xn + (size_t)row * DM + 512 + lane * 8) = w1; } }
}

__device__ __forceinline__ void phase_inproj(const Params& P, char* lds) {
    unsigned char* ws = P.ws; const bf16_t* xn = (const bf16_t*)(ws + OFF_XN); const bf16_t* Wt = (const bf16_t*)(ws + OFF_WIN);
    bf16_t* proj = (bf16_t*)(ws + OFF_PROJ); bf16_t* Kb = (bf16_t*)P.out + (size_t)T_TOK * QW; float* gates = (float*)(ws + OFF_GATES); const float2* rope = (const float2*)(ws + OFF_ROPE);
    const int tid = threadIdx.x, lane = tid & 63, wid = RFL(tid >> 6), wr = wid >> 1, wc = wid & 1, fr = lane & 15, fq = lane >> 4;
    for (int u = blockIdx.x; u < 128 * 12; u += gridDim.x) {
        const int mt = u / 12, nt = u % 12, m0 = mt * 256, n0 = nt * 128;
        f32x4 acc[4][4];
        gemm_core<4>(acc, xn, DM, xn, DM, 1 << 30, [&](int r) { return m0 + r; }, Wt + (size_t)n0 * DM, DM, 16, lds);
#pragma unroll
        for (int m = 0; m < 4; ++m) { const int row = m0 + wr * 64 + 16 * m + fr;
#pragma unroll
            for (int n = 0; n < 4; ++n) { const int c16 = n0 + wc * 64 + 16 * n, col = c16 + 4 * fq;
                if (c16 == C_KR) {
                    const f32x4 x1 = acc[m][n], x2 = acc[m][n + 1]; f32x4 o1, o2;
#pragma unroll
                    for (int e = 0; e < 4; ++e) { const float2 cs = rope[(size_t)row * 16 + 4 * fq + e]; o1[e] = x1[e] * cs.x - x2[e] * cs.y; o2[e] = x1[e] * cs.y + x2[e] * cs.x; }
#pragma unroll
                    for (int h = 0; h < 8; ++h) { st4bf(Kb + (size_t)row * KW + h * 96 + 64 + 4 * fq, o1); st4bf(Kb + (size_t)row * KW + h * 96 + 80 + 4 * fq, o2); }
                } else if (c16 == C_KR + 16) {   }
                else if (c16 == C_IG) { if (fq < 2) *(f32x4*)(gates + (size_t)row * 8 + 4 * fq) = acc[m][n]; }
                else if (c16 < C_IG) st4bf(proj + (size_t)row * INWP + col, acc[m][n]);
            } }
    }
}

constexpr int LDS_RS = LDS_GEMM;
__device__ __forceinline__ void mla_unit(const Params& P, int mt, int part, char* lds) {
    unsigned char* ws = P.ws; const bf16_t* proj = (const bf16_t*)(ws + OFF_PROJ);
    bf16_t* Qb = (bf16_t*)P.out; bf16_t* Kb = Qb + (size_t)T_TOK * QW; bf16_t* Vb = Kb + (size_t)T_TOK * KW; const float2* rope = (const float2*)(ws + OFF_ROPE);
    const int tid = threadIdx.x, lane = tid & 63, wid = RFL(tid >> 6), wr = wid >> 1, wc = wid & 1, fr = lane & 15, fq = lane >> 4;
    float* rs = (float*)(lds + LDS_RS);
    const int m0 = mt * 256;
    __syncthreads();
    { const int row = tid >> 1, half = tid & 1; const int cw = part == 0 ? 256 : 128, c0 = part == 0 ? C_CQ : C_CKV; const int per = cw / 2;
      const bf16_t* src = proj + (size_t)(m0 + row) * INWP + c0 + half * per; float ss = 0.f;
      for (int i = 0; i < per / 8; ++i) { const u32x4 v = *(const u32x4*)(src + i * 8);
#pragma unroll
          for (int e = 0; e < 4; ++e) { const float a = bflo(v[e]), b = bfhi(v[e]); ss += a * a + b * b; } }
      ss += __shfl_xor(ss, 1);
      if (half == 0) rs[row] = rsqrtf(ss / (float)cw + EPS); }
    __syncthreads();
    if (part == 0) {
        const bf16_t* Wt = (const bf16_t*)(ws + OFF_WUQ);
        for (int nt = 0; nt < 6; ++nt) {
            f32x4 acc[4][4];
            gemm_core<4>(acc, proj + C_CQ, INWP, proj, INWP, 1 << 30, [&](int r) { return m0 + r; }, Wt + (size_t)nt * 128 * 256, 256, 4, lds);
#pragma unroll
            for (int m = 0; m < 4; ++m) { const int lr = wr * 64 + 16 * m + fr, row = m0 + lr; const float r = rs[lr] * QSCALE;
#pragma unroll
                for (int n = 0; n < 4; n += 2) { const int g16 = nt * 8 + wc * 4 + n, h = g16 / 6, jj = g16 % 6;
                    if (jj == 4) { const f32x4 x1 = acc[m][n] * r, x2 = acc[m][n + 1] * r; f32x4 o1, o2;
#pragma unroll
                        for (int e = 0; e < 4; ++e) { const float2 cs = rope[(size_t)row * 16 + 4 * fq + e]; o1[e] = x1[e] * cs.x - x2[e] * cs.y; o2[e] = x1[e] * cs.y + x2[e] * cs.x; }
                        st4bf(Qb + (size_t)row * QW + h * 96 + 64 + 4 * fq, o1); st4bf(Qb + (size_t)row * QW + h * 96 + 80 + 4 * fq, o2);
                    } else { st4bf(Qb + (size_t)row * QW + g16 * 16 + 4 * fq, acc[m][n] * r); st4bf(Qb + (size_t)row * QW + (g16 + 1) * 16 + 4 * fq, acc[m][n + 1] * r); } } }
        }
    } else {
        const bf16_t* Wt = (const bf16_t*)(ws + OFF_WUKV);
        for (int nt = 0; nt < 8; ++nt) {
            f32x4 acc[4][4];
            gemm_core<4>(acc, proj + C_CKV, INWP, proj, INWP, 1 << 30, [&](int r) { return m0 + r; }, Wt + (size_t)nt * 128 * 128, 128, 2, lds);
#pragma unroll
            for (int m = 0; m < 4; ++m) { const int lr = wr * 64 + 16 * m + fr, row = m0 + lr; const float r = rs[lr];
#pragma unroll
                for (int n = 0; n < 4; ++n) { const int jj = wc * 4 + n;
                    if (jj < 4) st4bf(Kb + (size_t)row * KW + nt * 96 + jj * 16 + 4 * fq, acc[m][n] * r);
                    else st4bf(Vb + (size_t)row * VW + nt * 64 + (jj - 4) * 16 + 4 * fq, acc[m][n] * r); } }
        }
    }
}

__device__ __forceinline__ void gate_prep(const Params& P, int tok0, int h, float* sb, float* sgs, float* spm, float* sbl, float* sa) {
    const float* gates = (const float*)(P.ws + OFF_GATES);
    const int tid = threadIdx.x, lane = tid & 63, w = tid >> 6;
    const float fpre = gates[(size_t)(tok0 + tid) * 8 + 4 + h] + P.b_fgate[h], ig = gates[(size_t)(tok0 + tid) * 8 + h] + P.b_igate[h];
    const float logf = fminf(fpre, 0.f) - log1pf(__expf(-fabsf(fpre)));
    float b = logf;
#pragma unroll
    for (int o = 1; o < 64; o <<= 1) { const float t = __shfl_up(b, o); if (lane >= o) b += t; }
    const float gs = ig - b; float pm = gs;
#pragma unroll
    for (int o = 1; o < 64; o <<= 1) { const float t = __shfl_up(pm, o); if (lane >= o) pm = fmaxf(pm, t); }
    const float bl = __shfl(b, 63), mx = __shfl(pm, 63);
    sb[tid] = b; sgs[tid] = gs; spm[tid] = pm;
    if (lane == 0) { sbl[w] = bl; sa[w] = bl + mx; }
}

constexpr int LDS_M1_K = 0, LDS_M1_V = 16384, LDS_M1_G = LDS_GEMM + 1024;
__device__ __forceinline__ void mlstm_unit1(const Params& P, int u, char* lds) {
    unsigned char* ws = P.ws; const bf16_t* proj = (const bf16_t*)(ws + OFF_PROJ);
    bf16_t* xc = (bf16_t*)(ws + OFF_XC); bf16_t* mq = (bf16_t*)(ws + OFF_MQ); bf16_t* mk = (bf16_t*)(ws + OFF_MK); bf16_t* mv = (bf16_t*)(ws + OFF_MV);
    const int b = u >> 6, h = (u >> 4) & 3, g = u & 15, tok0 = b * SEQ + g * 512;
    const int tid = threadIdx.x, lane = tid & 63, wid = RFL(tid >> 6), wr = wid >> 1, wc = wid & 1, fr = lane & 15, fq = lane >> 4, r32 = lane & 31, hi = lane >> 5;
    { const int ch = h * 128 + (tid & 15) * 8, trow = tid >> 4;
      float wv[4][8], bias[8];
#pragma unroll
      for (int k = 0; k < 4; ++k)
#pragma unroll
          for (int e = 0; e < 8; ++e) wv[k][e] = P.conv_w[k * 512 + ch + e];
#pragma unroll
      for (int e = 0; e < 8; ++e) bias[e] = P.conv_b[ch + e];
      for (int i = 0; i < 16; ++i) { const int tl = trow + 32 * i, tin = g * 512 + tl; float a[8];
#pragma unroll
          for (int e = 0; e < 8; ++e) a[e] = bias[e];
#pragma unroll
          for (int k = 0; k < 4; ++k) { const int tt = tin - 3 + k;
              if (tt >= 0) { const u32x4 v = *(const u32x4*)(proj + (size_t)(b * SEQ + tt) * INWP + C_XM + ch);
#pragma unroll
                  for (int e = 0; e < 4; ++e) { a[2 * e] += wv[k][2 * e] * bflo(v[e]); a[2 * e + 1] += wv[k][2 * e + 1] * bfhi(v[e]); } } }
          u32x4 o;
#pragma unroll
          for (int e = 0; e < 4; ++e) o[e] = cvtpk(siluf(a[2 * e]), siluf(a[2 * e + 1]));
          *(u32x4*)(xc + (size_t)(tok0 + tl) * 512 + ch) = o; } }
    WAITVM0(); __syncthreads();
    for (int kind = 0; kind < 3; ++kind)
        for (int rt = 0; rt < 2; ++rt) {
            const int m0 = tok0 + rt * 256; const bf16_t* A = kind < 2 ? xc + h * 128 : proj + C_XM + h * 128; const int lda = kind < 2 ? 512 : INWP;
            bf16_t* dst = kind == 0 ? mq : kind == 1 ? mk : mv;
            f32x4 acc[4][4];
            gemm_core<4>(acc, A, lda, A, lda, 1 << 30, [&](int r) { return m0 + r; }, (const bf16_t*)(ws + OFF_WM) + (kind * 4 + h) * 16384, 128, 2, lds);
#pragma unroll
            for (int m = 0; m < 4; ++m) { const int row = m0 + wr * 64 + 16 * m + fr;
#pragma unroll
                for (int n = 0; n < 4; ++n) st4bf(dst + (size_t)row * 512 + h * 128 + wc * 64 + 16 * n + 4 * fq, acc[m][n]); }
        }
    WAITVM0(); __syncthreads();
    float* sb = (float*)(lds + LDS_M1_G); float* sgs = sb + 512; float* spm = sgs + 512; float* sbl = spm + 512; float* sa = sbl + 8;
    gate_prep(P, tok0, h, sb, sgs, spm, sbl, sa);
    __syncthreads();
    if (tid < 8) { float* cs = (float*)(ws + OFF_CSTAT) + ((size_t)(b * 4 + h) * 128 + g * 8 + tid) * 2; cs[0] = sbl[tid]; cs[1] = sa[tid]; }
    f32x16 cacc[2], nacc; cacc[0] = f32x16{}; cacc[1] = f32x16{}; nacc = f32x16{};
    float mloc = -INFINITY;
    bf16_t* stbase = (bf16_t*)(ws + OFF_STATE) + (size_t)u * 8 * 16384; float* nst = (float*)(ws + OFF_NST) + (size_t)u * 8 * 128; float* mst = (float*)(ws + OFF_MST) + u * 8;
    const bf16x8 ones = (bf16x8){0x3f80, 0x3f80, 0x3f80, 0x3f80, 0x3f80, 0x3f80, 0x3f80, 0x3f80};
    for (int j = 0; j < 8; ++j) {
        const float bl = sbl[j], aj = sa[j]; const float mnew = fmaxf(bl + mloc, aj); const float decay = __expf(bl + mloc - mnew);
#pragma unroll
        for (int i = 0; i < 2; ++i) { const int s = (tid >> 4) + 32 * i, c8 = tid & 15; const size_t go = (size_t)(tok0 + j * 64 + s) * 512 + h * 128 + c8 * 8;
            const u32x4 kv = *(const u32x4*)(mk + go), vv = *(const u32x4*)(mv + go); const float wsc = __expf(bl + sgs[j * 64 + s] - mnew);
            u32x4 ko;
#pragma unroll
            for (int e = 0; e < 4; ++e) ko[e] = cvtpk(bflo(kv[e]) * wsc, bfhi(kv[e]) * wsc);
            const int off = (c8 >> 2) * 4096 + s * 64 + (c8 & 3) * 16;
            *(u32x4*)(lds + LDS_M1_K + off) = ko; *(u32x4*)(lds + LDS_M1_V + off) = vv; }
        __syncthreads();
#pragma unroll
        for (int r = 0; r < 16; ++r) { cacc[0][r] *= decay; cacc[1][r] *= decay; nacc[r] *= decay; }
        { const int q = (lane & 15) >> 2, p = lane & 3, cb = (lane >> 4) & 1;
          const lds_cptr kp = (lds_cptr)lds + LDS_M1_K + wr * 4096 + (4 * hi + q) * 64 + cb * 32 + p * 8;
          const lds_cptr vp = (lds_cptr)lds + LDS_M1_V + (2 * wc) * 4096 + (4 * hi + q) * 64 + cb * 32 + p * 8;
#pragma unroll
          for (int ks = 0; ks < 4; ++ks) { const bf16x8 af = cat8(vtr(kp + ks * 1024), vtr(kp + ks * 1024 + 512));
              const bf16x8 b0 = cat8(vtr(vp + ks * 1024), vtr(vp + ks * 1024 + 512)), b1 = cat8(vtr(vp + 4096 + ks * 1024), vtr(vp + 4096 + ks * 1024 + 512));
              cacc[0] = MFMA32(af, b0, cacc[0]); cacc[1] = MFMA32(af, b1, cacc[1]);
              if (wc == 0) nacc = MFMA32(af, ones, nacc); } }
        bf16_t* st = stbase + (size_t)j * 16384;
#pragma unroll
        for (int nb2 = 0; nb2 < 2; ++nb2)
#pragma unroll
            for (int r = 0; r < 16; ++r) st[(wr * 32 + crow(r, hi)) * 128 + wc * 64 + nb2 * 32 + r32] = (bf16_t)(cvtpk(cacc[nb2][r], 0.f) & 0xffffu);
        if (wc == 0 && r32 == 0) {
#pragma unroll
            for (int r = 0; r < 16; ++r) nst[j * 128 + wr * 32 + crow(r, hi)] = nacc[r]; }
        if (tid == 0) mst[j] = mnew;
        mloc = mnew;
        __syncthreads();
    }
}

constexpr int LDS_AK = 0, LDS_AV = 2 * 12288, LDS_AW = LDS_AV + 2 * 8192;
#ifndef ATT_THR
#define ATT_THR 8.0f
#endif
__device__ __forceinline__ void attn_unit(const Params& P, int b, int h, int qb, char* lds) {
    const bf16_t* Qb = (const bf16_t*)P.out; const bf16_t* Kb = Qb + (size_t)T_TOK * QW; const bf16_t* Vb = Kb + (size_t)T_TOK * KW; bf16_t* att = (bf16_t*)(P.ws + OFF_ATT);
    const int tid = threadIdx.x, lane = tid & 63, r32 = lane & 31, hi = lane >> 5; const int wid = RFL(tid >> 6);
    const unsigned lds0 = (unsigned)(uintptr_t)lds;
    const size_t rowbase = (size_t)b * SEQ; const int q0 = qb * 256, NT = 4 * qb + 4, mynt = 4 * qb + (wid >> 1) + 1;
    const bf16_t* Qw = Qb + (rowbase + q0 + wid * 32 + r32) * QW + h * 96;
    bf16x8 qr[6];
#pragma unroll
    for (int d0 = 0; d0 < 6; ++d0) qr[d0] = *(const bf16x8*)(Qw + d0 * 16 + hi * 8);
    const bf16_t* ksrc0 = Kb + (rowbase + lane) * KW + h * 96 + wid * 8;
    const bf16_t* ksrc1 = Kb + (rowbase + lane) * KW + h * 96 + (8 + (wid & 3)) * 8;
    const bf16_t* vsrc = Vb + (rowbase + 16 * (wid & 3) + (lane >> 2)) * VW + h * 64 + (wid >> 2) * 32 + (lane & 3) * 8;
    float* wsf = (float*)(lds + LDS_AW) + wid * 64;
    float mhat = 0.f, l_reg = 0.f; f32x16 o0 = f32x16{}, o1 = f32x16{};
    const lds_cptr vp0 = (lds_cptr)lds + LDS_AV + ((lane >> 4) & 1) * 32 + (lane & 3) * 8 + (4 * hi + ((lane & 15) >> 2)) * 64;
    const char* kp0 = lds + LDS_AK + hi * 1024 + r32 * 16;
    auto dma = [&](int t, int slot) {
        glds16(ksrc0 + (size_t)t * 64 * KW, RFL(lds0 + LDS_AK + slot * 12288 + wid * 1024));
        if (wid < 4) glds16(ksrc1 + (size_t)t * 64 * KW, RFL(lds0 + LDS_AK + slot * 12288 + (8 + wid) * 1024));
        glds16(vsrc + (size_t)t * 64 * VW, RFL(lds0 + LDS_AV + slot * 8192 + wid * 1024));
    };
    __syncthreads();
    dma(0, 0);
    for (int t = 0; t < NT; ++t) {
        asm volatile("s_waitcnt vmcnt(0) lgkmcnt(0)" ::: "memory"); __syncthreads();
        if (t + 1 < NT) dma(t + 1, (t + 1) & 1);
        if (t < mynt) {
            const char* kp = kp0 + (t & 1) * 12288;
            f32x16 s0 = f32x16{}, s1 = f32x16{};
#pragma unroll
            for (int d0 = 0; d0 < 6; ++d0) { const bf16x8 k0 = *(const bf16x8*)(kp + d0 * 2048), k1 = *(const bf16x8*)(kp + d0 * 2048 + 512);
                s0 = MFMA32(k0, qr[d0], s0); s1 = MFMA32(k1, qr[d0], s1); }
            float rm = s0[0];
#pragma unroll
            for (int r = 1; r < 16; ++r) rm = fmaxf(rm, s0[r]);
#pragma unroll
            for (int r = 0; r < 16; ++r) rm = fmaxf(rm, s1[r]);
            rm = fmaxf(rm, __shfl_xor(rm, 32));
            if (t == 0) mhat = rm;
            else { const float d = rm - mhat;
                if (__any(d > ATT_THR)) { const float dl = fmaxf(d, 0.f); mhat += dl; const float f = __builtin_amdgcn_exp2f(-dl); l_reg *= f;
                    if (hi == 0) wsf[r32] = f; WAITLGKM0();
#pragma unroll
                    for (int r = 0; r < 16; ++r) { const float fr_ = wsf[crow(r, hi)]; o0[r] *= fr_; o1[r] *= fr_; }
                    WAITLGKM0(); } }
            float sacc = 0.f;
#pragma unroll
            for (int r = 0; r < 16; ++r) { s0[r] = __builtin_amdgcn_exp2f(s0[r] - mhat); s1[r] = __builtin_amdgcn_exp2f(s1[r] - mhat); sacc += s0[r] + s1[r]; }
            l_reg += sacc;
            u32x4 pw[4];
#pragma unroll
            for (int i = 0; i < 4; ++i) { pw[0][i] = cvtpk(s0[2 * i], s0[2 * i + 1]); pw[1][i] = cvtpk(s0[8 + 2 * i], s0[8 + 2 * i + 1]); pw[2][i] = cvtpk(s1[2 * i], s1[2 * i + 1]); pw[3][i] = cvtpk(s1[8 + 2 * i], s1[8 + 2 * i + 1]); }
            const lds_cptr vp = vp0 + (t & 1) * 8192;
#pragma unroll
            for (int ks = 0; ks < 4; ++ks) { const bf16x8 pa = __builtin_bit_cast(bf16x8, pw[ks]);
                const bf16x8 v0 = cat8(vtr(vp + ks * 1024), vtr(vp + ks * 1024 + 512)), v1 = cat8(vtr(vp + 4096 + ks * 1024), vtr(vp + 4096 + ks * 1024 + 512));
                o0 = MFMA32(pa, v0, o0); o1 = MFMA32(pa, v1, o1); }
        }
    }
    l_reg += __shfl_xor(l_reg, 32);
    WAITLGKM0();
    if (hi == 0) wsf[32 + r32] = l_reg;
    WAITLGKM0();
    bf16_t* Ow = att + (rowbase + q0 + wid * 32) * 512 + h * 64;
#pragma unroll
    for (int r = 0; r < 16; ++r) { const int orow = crow(r, hi); const float rl = 1.0f / wsf[32 + orow];
        Ow[(size_t)orow * 512 + r32] = (bf16_t)(cvtpk(o0[r] * rl, 0.f) & 0xffffu); Ow[(size_t)orow * 512 + 32 + r32] = (bf16_t)(cvtpk(o1[r] * rl, 0.f) & 0xffffu); }
    WAITLGKM0();
}

constexpr int LDS_M2_C = 0, LDS_M2_Q = 32768, LDS_M2_K = 49152, LDS_M2_V = 65536, LDS_M2_NUM = 81920  , LDS_M2_MISC = 81920 + 33792;
__device__ __forceinline__ void mlstm_unit2(const Params& P, int u, char* lds) {
    unsigned char* ws = P.ws; const bf16_t* proj = (const bf16_t*)(ws + OFF_PROJ);
    const bf16_t* xc = (const bf16_t*)(ws + OFF_XC); const bf16_t* mq = (const bf16_t*)(ws + OFF_MQ); const bf16_t* mk = (const bf16_t*)(ws + OFF_MK); const bf16_t* mv = (const bf16_t*)(ws + OFF_MV);
    bf16_t* mlo = (bf16_t*)(ws + OFF_MLO);
    const int b = u >> 6, h = (u >> 4) & 3, g = u & 15, tok0 = b * SEQ + g * 512, seq = b * 4 + h;
    const int tid = threadIdx.x, lane = tid & 63, wid = RFL(tid >> 6), r32 = lane & 31, hi = lane >> 5;
    float* misc = (float*)(lds + LDS_M2_MISC);
    float* sb = misc; float* sgs = sb + 512; float* spm = sgs + 512; float* sbl = spm + 512; float* sa = sbl + 8;
    float* marr = sa + 8; float* fbarr = marr + 136; float* cst = fbarr + 136;
    float* nfull = cst + 256; float* nseg = nfull + 128; float* sden = nseg + 128; float* swi = sden + 64; float* coef = swi + 64;
    __syncthreads();
    gate_prep(P, tok0, h, sb, sgs, spm, sbl, sa);
    if (tid < 256) cst[tid] = ((const float*)(ws + OFF_CSTAT))[(size_t)seq * 256 + tid];
    __syncthreads();
    if (tid == 0) { float m = 0.f, F = 0.f; const int nc = 8 * g + 8;
        for (int c = 0; c < nc; ++c) { marr[c] = m; fbarr[c] = F; const float bl = cst[2 * c], a = cst[2 * c + 1]; m = fmaxf(bl + m, a); F += bl; }
        marr[nc] = m; fbarr[nc] = F; }
    __syncthreads();
    const float* mstg = (const float*)(ws + OFF_MST);
    if (tid < 16) { float c = 0.f; if (tid < g) c = __expf(mstg[(u - g + tid) * 8 + 7] + (fbarr[8 * g] - fbarr[8 * (tid + 1)]) - marr[8 * g]); coef[tid] = c; }
    __syncthreads();
    float cseg[32];
#pragma unroll
    for (int i = 0; i < 32; ++i) cseg[i] = 0.f;
    float nsg = 0.f;
    const bf16_t* stall = (const bf16_t*)(ws + OFF_STATE); const float* nstall = (const float*)(ws + OFF_NST);
    for (int gp = 0; gp < g; ++gp) { const float c = coef[gp]; const bf16_t* st = stall + ((size_t)(u - g + gp) * 8 + 7) * 16384;
#pragma unroll
        for (int i = 0; i < 4; ++i) { const u32x4 v = *(const u32x4*)(st + (i * 512 + tid) * 8);
#pragma unroll
            for (int e = 0; e < 4; ++e) { cseg[i * 8 + 2 * e] += c * bflo(v[e]); cseg[i * 8 + 2 * e + 1] += c * bfhi(v[e]); } }
        if (tid < 128) nsg += c * nstall[((size_t)(u - g + gp) * 8 + 7) * 128 + tid]; }
    if (tid < 128) nseg[tid] = nsg;
    const int tb = wid & 1, db = wid >> 1;
    for (int j = 0; j < 8; ++j) {
        const int c = 8 * g + j; const float mc = marr[c];
        const float eloc = j > 0 ? __expf(mstg[u * 8 + j - 1] - mc) : 0.f;
        const float eseg = __expf(fbarr[c] - fbarr[8 * g] + marr[8 * g] - mc);
        __syncthreads();
        { const bf16_t* st = stall + ((size_t)u * 8 + (j > 0 ? j - 1 : 0)) * 16384;
#pragma unroll
          for (int i = 0; i < 4; ++i) { const int idx = (i * 512 + tid) * 8, dk = idx >> 7, dv8 = (idx & 127) >> 3; float v[8];
#pragma unroll
              for (int e = 0; e < 8; ++e) v[e] = eseg * cseg[i * 8 + e];
              if (j > 0) { const u32x4 w = *(const u32x4*)(st + idx);
#pragma unroll
                  for (int e = 0; e < 4; ++e) { v[2 * e] += eloc * bflo(w[e]); v[2 * e + 1] += eloc * bfhi(w[e]); } }
              u32x4 o;
#pragma unroll
              for (int e = 0; e < 4; ++e) o[e] = cvtpk(v[2 * e], v[2 * e + 1]);
              *(u32x4*)(lds + LDS_M2_C + (dv8 >> 2) * 8192 + dk * 64 + (dv8 & 3) * 16) = o; }
          if (tid < 128) { float nv = eseg * nseg[tid]; if (j > 0) nv += eloc * nstall[((size_t)u * 8 + j - 1) * 128 + tid]; nfull[tid] = nv; } }
#pragma unroll
        for (int i = 0; i < 2; ++i) { const int s = (tid >> 4) + 32 * i, c8 = tid & 15; const size_t go = (size_t)(tok0 + j * 64 + s) * 512 + h * 128 + c8 * 8;
            const u32x4 qv = *(const u32x4*)(mq + go), kv = *(const u32x4*)(mk + go), vv = *(const u32x4*)(mv + go);
            const int so = s * 256 + ((c8 ^ (s & 15)) << 4);
            *(u32x4*)(lds + LDS_M2_Q + so) = qv; *(u32x4*)(lds + LDS_M2_K + so) = kv;
            *(u32x4*)(lds + LDS_M2_V + (c8 >> 2) * 4096 + s * 64 + (c8 & 3) * 16) = vv; }
        if (tid < 64) swi[tid] = __expf(mc - fmaxf(spm[j * 64 + tid], mc));
        __syncthreads();
        { const int t = 32 * tb + r32; const float mt = fmaxf(spm[j * 64 + t], mc);
          bf16x8 qf[8];
#pragma unroll
          for (int ks = 0; ks < 8; ++ks) qf[ks] = *(const bf16x8*)(lds + LDS_M2_Q + t * 256 + (((2 * ks + hi) ^ (t & 15)) << 4));
          f32x16 sT[2]; sT[0] = f32x16{}; sT[1] = f32x16{};
#pragma unroll
          for (int sbk = 0; sbk < 2; ++sbk) { if (sbk <= tb) { const int s = 32 * sbk + r32;
#pragma unroll
              for (int ks = 0; ks < 8; ++ks) { const bf16x8 kf = *(const bf16x8*)(lds + LDS_M2_K + s * 256 + (((2 * ks + hi) ^ (s & 15)) << 4)); sT[sbk] = MFMA32(kf, qf[ks], sT[sbk]); } } }
          float dsum = 0.f;
#pragma unroll
          for (int sbk = 0; sbk < 2; ++sbk)
#pragma unroll
              for (int r = 0; r < 16; ++r) { const int s = 32 * sbk + crow(r, hi); const float w = (s <= t) ? __expf(sgs[j * 64 + s] - mt) : 0.f; const float v = sT[sbk][r] * w; sT[sbk][r] = v; dsum += v; }
          dsum += __shfl_xor(dsum, 32);
          if (db == 0 && hi == 0) sden[t] = dsum;
          u32x4 pw[4];
#pragma unroll
          for (int i = 0; i < 4; ++i) { pw[0][i] = cvtpk(sT[0][2 * i], sT[0][2 * i + 1]); pw[1][i] = cvtpk(sT[0][8 + 2 * i], sT[0][8 + 2 * i + 1]); pw[2][i] = cvtpk(sT[1][2 * i], sT[1][2 * i + 1]); pw[3][i] = cvtpk(sT[1][8 + 2 * i], sT[1][8 + 2 * i + 1]); }
          const int q = (lane & 15) >> 2, p = lane & 3, cb = (lane >> 4) & 1;
          const lds_cptr vp = (lds_cptr)lds + LDS_M2_V + db * 4096 + (4 * hi + q) * 64 + cb * 32 + p * 8;
          f32x16 o1 = f32x16{}, o2 = f32x16{};
#pragma unroll
          for (int ks = 0; ks < 4; ++ks) { if (ks < 2 * (tb + 1)) { const bf16x8 vf = cat8(vtr(vp + ks * 1024), vtr(vp + ks * 1024 + 512)); o1 = MFMA32(__builtin_bit_cast(bf16x8, pw[ks]), vf, o1); } }
          const lds_cptr cp = (lds_cptr)lds + LDS_M2_C + db * 8192 + (8 * hi + q) * 64 + cb * 32 + p * 8;
#pragma unroll
          for (int ks = 0; ks < 8; ++ks) { const bf16x8 cf = cat8(vtr(cp + ks * 1024), vtr(cp + ks * 1024 + 256)); o2 = MFMA32(qf[ks], cf, o2); }
          float* num = (float*)(lds + LDS_M2_NUM);
#pragma unroll
          for (int r = 0; r < 16; ++r) { const int tr_ = 32 * tb + crow(r, hi); num[tr_ * 132 + db * 32 + r32] = o1[r] + swi[tr_] * o2[r]; } }
        __syncthreads();
        { const int t = tid >> 3, pp = tid & 7; const float* num = (const float*)(lds + LDS_M2_NUM);
          float qn = 0.f;
#pragma unroll
          for (int cc = 0; cc < 2; ++cc) { const u32x4 qv = *(const u32x4*)(lds + LDS_M2_Q + t * 256 + (((2 * pp + cc) ^ (t & 15)) << 4));
#pragma unroll
              for (int e = 0; e < 4; ++e) qn += bflo(qv[e]) * nfull[16 * pp + 8 * cc + 2 * e] + bfhi(qv[e]) * nfull[16 * pp + 8 * cc + 2 * e + 1]; }
          qn += __shfl_xor(qn, 1); qn += __shfl_xor(qn, 2); qn += __shfl_xor(qn, 4);
          const float mt = sb[j * 64 + t] + fmaxf(spm[j * 64 + t], mc);
          float den = sden[t] + swi[t] * qn; den = fmaxf(fabsf(den), __expf(-mt)); const float rden = 1.0f / den;
          float hv[16]; float s1 = 0.f;
#pragma unroll
          for (int e = 0; e < 16; ++e) { hv[e] = num[t * 132 + 16 * pp + e] * rden; s1 += hv[e]; }
          s1 += __shfl_xor(s1, 1); s1 += __shfl_xor(s1, 2); s1 += __shfl_xor(s1, 4);
          const float mu = s1 * (1.0f / 128.0f); float s2 = 0.f;
#pragma unroll
          for (int e = 0; e < 16; ++e) { const float d = hv[e] - mu; s2 += d * d; }
          s2 += __shfl_xor(s2, 1); s2 += __shfl_xor(s2, 2); s2 += __shfl_xor(s2, 4);
          const float rstd = rsqrtf(s2 * (1.0f / 128.0f) + EPS);
          const size_t tok = (size_t)tok0 + j * 64 + t; const int ch = h * 128 + 16 * pp;
          const u32x4 xa = *(const u32x4*)(xc + tok * 512 + ch), xb = *(const u32x4*)(xc + tok * 512 + ch + 8);
          const u32x4 za = *(const u32x4*)(proj + tok * INWP + C_Z + ch), zb = *(const u32x4*)(proj + tok * INWP + C_Z + ch + 8);
          float ov[16];
#pragma unroll
          for (int e = 0; e < 16; ++e) { const unsigned xw = e < 8 ? xa[e >> 1] : xb[(e - 8) >> 1], zw = e < 8 ? za[e >> 1] : zb[(e - 8) >> 1];
              const float xcv = (e & 1) ? bfhi(xw) : bflo(xw), zv = (e & 1) ? bfhi(zw) : bflo(zw);
              const float hn = (hv[e] - mu) * rstd * P.mh_norm_g[ch + e];
              ov[e] = (hn + P.ml_skip[ch + e] * xcv) * siluf(zv); }
          u32x4 oa, ob;
#pragma unroll
          for (int e = 0; e < 4; ++e) { oa[e] = cvtpk(ov[2 * e], ov[2 * e + 1]); ob[e] = cvtpk(ov[8 + 2 * e], ov[8 + 2 * e + 1]); }
          *(u32x4*)(mlo + tok * 512 + ch) = oa; *(u32x4*)(mlo + tok * 512 + ch + 8) = ob; }
    }
}

__device__ __forceinline__ void phase_outproj(const Params& P, char* lds) {
    unsigned char* ws = P.ws; const bf16_t* att = (const bf16_t*)(ws + OFF_ATT); const bf16_t* mlo = (const bf16_t*)(ws + OFF_MLO); const bf16_t* Wt = (const bf16_t*)(ws + OFF_WO);
    const int tid = threadIdx.x, lane = tid & 63, wid = RFL(tid >> 6), wr = wid >> 1, wc = wid & 1, fr = lane & 15, fq = lane >> 4;
    for (int u = blockIdx.x; u < 128 * 8; u += gridDim.x) {
        const int mt = u >> 3, nt = u & 7, m0 = mt * 256, n0 = nt * 128;
        f32x4 acc[4][4];
        gemm_core<4>(acc, att, 512, mlo, 512, 8, [&](int r) { return m0 + r; }, Wt + (size_t)n0 * 1024, 1024, 16, lds);
#pragma unroll
        for (int m = 0; m < 4; ++m) { const size_t row = m0 + wr * 64 + 16 * m + fr;
#pragma unroll
            for (int n = 0; n < 4; ++n) { const int col = n0 + wc * 64 + 16 * n + 4 * fq; const f32x4 xv = *(const f32x4*)(P.x + row * DM + col); *(f32x4*)(P.out + row * DM + col) = xv + acc[m][n]; } }
    }
}

__device__ __forceinline__ void norm_row_store(const f32x4& a0, const f32x4& a1, const f32x4& a2, const f32x4& a3, const float* g, int lane, bf16_t* dst) {
    float ss = 0.f;
#pragma unroll
    for (int e = 0; e < 4; ++e) ss += a0[e] * a0[e] + a1[e] * a1[e] + a2[e] * a2[e] + a3[e] * a3[e];
    ss = wsum(ss); const float r = rsqrtf(ss * (1.0f / DM) + EPS);
    const f32x4 g0 = *(const f32x4*)(g + lane * 8), g1 = *(const f32x4*)(g + lane * 8 + 4), g2 = *(const f32x4*)(g + 512 + lane * 8), g3 = *(const f32x4*)(g + 512 + lane * 8 + 4);
    u32x4 w0, w1;
    w0.x = cvtpk(a0[0] * r * g0[0], a0[1] * r * g0[1]); w0.y = cvtpk(a0[2] * r * g0[2], a0[3] * r * g0[3]); w0.z = cvtpk(a1[0] * r * g1[0], a1[1] * r * g1[1]); w0.w = cvtpk(a1[2] * r * g1[2], a1[3] * r * g1[3]);
    w1.x = cvtpk(a2[0] * r * g2[0], a2[1] * r * g2[1]); w1.y = cvtpk(a2[2] * r * g2[2], a2[3] * r * g2[3]); w1.z = cvtpk(a3[0] * r * g3[0], a3[1] * r * g3[1]); w1.w = cvtpk(a3[2] * r * g3[2], a3[3] * r * g3[3]);
    *(u32x4*)(dst + lane * 8) = w0; *(u32x4*)(dst + 512 + lane * 8) = w1;
}

constexpr int LDS_LOGIT = LDS_GEMM;
__device__ __forceinline__ void phase_router(const Params& P, char* lds) {
    unsigned char* ws = P.ws; bf16_t* hn = (bf16_t*)(ws + OFF_XN); const bf16_t* Wr = (const bf16_t*)(ws + OFF_WR);
    unsigned* cnt = (unsigned*)(ws + OFF_CNT); int* list = (int*)(ws + OFF_LIST); float* tokrec = (float*)(ws + OFF_TOKREC);
    const int tid = threadIdx.x, lane = tid & 63, wid = RFL(tid >> 6), wr = wid >> 1, wc = wid & 1, fr = lane & 15, fq = lane >> 4;
    float* logit = (float*)(lds + LDS_LOGIT);
    for (int u = blockIdx.x; u < 256; u += gridDim.x) {
        const int m0 = u * 128;
        for (int i = 0; i < 16; ++i) { const size_t row = m0 + wid * 16 + i; const float* xr = P.out + row * DM;
            const f32x4 a0 = *(const f32x4*)(xr + lane * 8), a1 = *(const f32x4*)(xr + lane * 8 + 4), a2 = *(const f32x4*)(xr + 512 + lane * 8), a3 = *(const f32x4*)(xr + 512 + lane * 8 + 4);
            norm_row_store(a0, a1, a2, a3, P.norm_ffn_g, lane, hn + row * DM); }
        WAITVM0(); __syncthreads();
        f32x4 acc[2][4];
        gemm_core<2>(acc, hn, DM, hn, DM, 1 << 30, [&](int r) { return m0 + r; }, Wr, DM, 16, lds);
        if (wc == 0) {
#pragma unroll
            for (int m = 0; m < 2; ++m) { const int lr = wr * 32 + 16 * m + fr;
#pragma unroll
                for (int n = 0; n < 3; ++n) { const int col = 16 * n + 4 * fq; if (col < 36) *(f32x4*)(logit + lr * 40 + col) = acc[m][n]; } } }
        __syncthreads();
        if (tid < 128) { const int tok = m0 + tid; const float* lg = logit + tid * 40;
            float gl[4]; float gm = -INFINITY; int gi = 0;
#pragma unroll
            for (int k = 0; k < 4; ++k) { gl[k] = lg[k] + P.b_rg[k]; if (gl[k] > gm) { gm = gl[k]; gi = k; } }
            float gsum = 0.f;
#pragma unroll
            for (int k = 0; k < 4; ++k) gsum += __expf(gl[k] - gm);
            const float gtop = 1.0f / gsum;
            float el[8]; float e1 = -INFINITY, e2 = -INFINITY; int i1 = 0, i2 = 0;
#pragma unroll
            for (int k = 0; k < 8; ++k) { el[k] = lg[4 + gi * 8 + k] + P.b_re[gi * 8 + k]; }
#pragma unroll
            for (int k = 0; k < 8; ++k) { if (el[k] > e1) { e2 = e1; i2 = i1; e1 = el[k]; i1 = k; } else if (el[k] > e2) { e2 = el[k]; i2 = k; } }
            const float rr = __expf(e2 - e1); const float w1 = gtop / (1.f + rr), w2 = gtop * rr / (1.f + rr);
            const int ex1 = gi * 8 + i1, ex2 = gi * 8 + i2;
            const unsigned p1 = __hip_atomic_fetch_add(cnt + ex1 * 64, 1u, __ATOMIC_RELAXED, __HIP_MEMORY_SCOPE_AGENT);
            const unsigned p2 = __hip_atomic_fetch_add(cnt + ex2 * 64, 1u, __ATOMIC_RELAXED, __HIP_MEMORY_SCOPE_AGENT);
            list[(size_t)ex1 * T_TOK + p1] = tok; list[(size_t)ex2 * T_TOK + p2] = tok;
            f32x4 rec; rec[0] = __uint_as_float((unsigned)(ex1 << 16) | 0u); rec[1] = w1; rec[2] = __uint_as_float(p1); rec[3] = w2;
            rec[0] = __uint_as_float((unsigned)ex1 | ((unsigned)ex2 << 8));
            *(f32x4*)(tokrec + (size_t)tok * 4) = rec;
            ((unsigned*)(ws + OFF_GATES))[tok] = p2;
        }
        __syncthreads();
    }
}

__device__ __forceinline__ int moe_bases(const Params& P, int* sbase, int* stile) {
    const unsigned* cnt = (const unsigned*)(P.ws + OFF_CNT);
    __syncthreads();
    if (threadIdx.x == 0) { int acc = 0, tt = 0; for (int e = 0; e < NEXP; ++e) { const int c = (int)__hip_atomic_load(cnt + e * 64, __ATOMIC_RELAXED, __HIP_MEMORY_SCOPE_AGENT); const int nt = (c + 255) >> 8; sbase[e] = acc; stile[e] = tt; acc += nt * 256; tt += nt; } sbase[NEXP] = acc; stile[NEXP] = tt; }
    __syncthreads();
    return stile[NEXP];
}

constexpr int LDS_MOE = LDS_GEMM;
__device__ __forceinline__ void phase_moe_gu(const Params& P, char* lds) {
    unsigned char* ws = P.ws; const bf16_t* hn = (const bf16_t*)(ws + OFF_XN); bf16_t* act = (bf16_t*)(ws + OFF_ACT); const int* list = (const int*)(ws + OFF_LIST);
    const unsigned* cnt = (const unsigned*)(ws + OFF_CNT);
    int* sbase = (int*)(lds + LDS_MOE); int* stile = sbase + 40;
    const int tid = threadIdx.x, lane = tid & 63, wid = RFL(tid >> 6), wr = wid >> 1, wc = wid & 1, fr = lane & 15, fq = lane >> 4;
    const int ntiles = moe_bases(P, sbase, stile);
    for (int u = blockIdx.x; u < ntiles * 4; u += gridDim.x) {
        const int ti = u >> 2, nt = u & 3; int e = 0;
        for (int k = 1; k < NEXP; ++k) if (stile[k] <= ti) e = k;
        const int it = ti - stile[e]; const int ce = (int)cnt[e * 64]; const int* le = list + (size_t)e * T_TOK + it * 256; const int nvalid = ce - it * 256;
        f32x4 acc[4][4];
        gemm_core<4>(acc, hn, DM, hn, DM, 1 << 30, [&](int r) { return r < nvalid ? le[r] : 0; }, (const bf16_t*)(ws + OFF_WGU) + ((size_t)e * 512 + nt * 128) * 1024, 1024, 16, lds);
        const size_t rbase = (size_t)sbase[e] + it * 256;
#pragma unroll
        for (int m = 0; m < 4; ++m) { const size_t row = rbase + wr * 64 + 16 * m + fr;
#pragma unroll
            for (int n = 0; n < 2; ++n) { f32x4 v;
#pragma unroll
                for (int q = 0; q < 4; ++q) v[q] = siluf(acc[m][n][q]) * acc[m][n + 2][q];
                st4bf(act + row * DEXP + nt * 64 + wc * 32 + 16 * n + 4 * fq, v); } }
    }
}
__device__ __forceinline__ void phase_moe_down(const Params& P, char* lds) {
    unsigned char* ws = P.ws; const bf16_t* act = (const bf16_t*)(ws + OFF_ACT); bf16_t* y = (bf16_t*)(ws + OFF_Y);
    int* sbase = (int*)(lds + LDS_MOE); int* stile = sbase + 40;
    const int tid = threadIdx.x, lane = tid & 63, wid = RFL(tid >> 6), wr = wid >> 1, wc = wid & 1, fr = lane & 15, fq = lane >> 4;
    const int ntiles = moe_bases(P, sbase, stile);
    for (int u = blockIdx.x; u < ntiles * 8; u += gridDim.x) {
        const int ti = u >> 3, nt = u & 7; int e = 0;
        for (int k = 1; k < NEXP; ++k) if (stile[k] <= ti) e = k;
        const int it = ti - stile[e]; const int rbase = sbase[e] + it * 256;
        f32x4 acc[4][4];
        gemm_core<4>(acc, act, DEXP, act, DEXP, 1 << 30, [&](int r) { return rbase + r; }, (const bf16_t*)(ws + OFF_WD) + ((size_t)e * 1024 + nt * 128) * 256, 256, 4, lds);
#pragma unroll
        for (int m = 0; m < 4; ++m) { const size_t row = (size_t)rbase + wr * 64 + 16 * m + fr;
#pragma unroll
            for (int n = 0; n < 4; ++n) st4bf(y + row * DM + nt * 128 + wc * 64 + 16 * n + 4 * fq, acc[m][n]); }
    }
}
__device__ __forceinline__ void phase_combine(const Params& P, char* lds) {
    unsigned char* ws = P.ws; const bf16_t* y = (const bf16_t*)(ws + OFF_Y); bf16_t* hp = (bf16_t*)(ws + OFF_XN); const float* tokrec = (const float*)(ws + OFF_TOKREC);
    int* sbase = (int*)(lds + LDS_MOE); int* stile = sbase + 40;
    (void)moe_bases(P, sbase, stile);
    const int tid = threadIdx.x, lane = tid & 63, wv = tid >> 6;
    for (int row = blockIdx.x * 8 + wv; row < T_TOK; row += gridDim.x * 8) {
        const f32x4 rec = *(const f32x4*)(tokrec + (size_t)row * 4); const unsigned ee = __float_as_uint(rec[0]); const int e1 = ee & 255, e2 = (ee >> 8) & 255;
        const unsigned p1 = __float_as_uint(rec[2]), p2 = ((const unsigned*)(ws + OFF_GATES))[row]; const float w1 = rec[1], w2 = rec[3];
        const bf16_t* y1 = y + ((size_t)sbase[e1] + p1) * DM; const bf16_t* y2 = y + ((size_t)sbase[e2] + p2) * DM;
        float* xr = P.out + (size_t)row * DM;
        f32x4 a0 = *(const f32x4*)(xr + lane * 8), a1 = *(const f32x4*)(xr + lane * 8 + 4), a2 = *(const f32x4*)(xr + 512 + lane * 8), a3 = *(const f32x4*)(xr + 512 + lane * 8 + 4);
        const u32x4 ya = *(const u32x4*)(y1 + lane * 8), yb = *(const u32x4*)(y1 + 512 + lane * 8), yc = *(const u32x4*)(y2 + lane * 8), yd = *(const u32x4*)(y2 + 512 + lane * 8);
#pragma unroll
        for (int e = 0; e < 2; ++e) { a0[2 * e] += w1 * bflo(ya[e]) + w2 * bflo(yc[e]); a0[2 * e + 1] += w1 * bfhi(ya[e]) + w2 * bfhi(yc[e]);
            a1[2 * e] += w1 * bflo(ya[2 + e]) + w2 * bflo(yc[2 + e]); a1[2 * e + 1] += w1 * bfhi(ya[2 + e]) + w2 * bfhi(yc[2 + e]);
            a2[2 * e] += w1 * bflo(yb[e]) + w2 * bflo(yd[e]); a2[2 * e + 1] += w1 * bfhi(yb[e]) + w2 * bfhi(yd[e]);
            a3[2 * e] += w1 * bflo(yb[2 + e]) + w2 * bflo(yd[2 + e]); a3[2 * e + 1] += w1 * bfhi(yb[2 + e]) + w2 * bfhi(yd[2 + e]); }
        *(f32x4*)(xr + lane * 8) = a0; *(f32x4*)(xr + lane * 8 + 4) = a1; *(f32x4*)(xr + 512 + lane * 8) = a2; *(f32x4*)(xr + 512 + lane * 8 + 4) = a3;
        norm_row_store(a0, a1, a2, a3, P.norm_ple_g, lane, hp + (size_t)row * DM);
    }
}
__device__ __forceinline__ void phase_ple(const Params& P, char* lds) {
    unsigned char* ws = P.ws; const bf16_t* hp = (const bf16_t*)(ws + OFF_XN); const bf16_t* pb = (const bf16_t*)(ws + OFF_PB);
    const int tid = threadIdx.x, lane = tid & 63, wid = RFL(tid >> 6), wr = wid >> 1, wc = wid & 1, fr = lane & 15, fq = lane >> 4;
    for (int u = blockIdx.x; u < 128 * 8; u += gridDim.x) {
        const int mt = u >> 3, nt = u & 7, m0 = mt * 256, n0 = nt * 128;
        f32x4 acc[4][4]; u32x2 pe[4][4];
        gemm_core<4>(acc, pb, 256, pb, 256, 1 << 30, [&](int r) { return m0 + r; }, (const bf16_t*)(ws + OFF_WPLE) + (size_t)n0 * 256, 256, 4, lds);
#pragma unroll
        for (int m = 0; m < 4; ++m)
#pragma unroll
            for (int n = 0; n < 4; ++n) { pe[m][n].x = cvtpk(acc[m][n][0], acc[m][n][1]); pe[m][n].y = cvtpk(acc[m][n][2], acc[m][n][3]); }
        gemm_core<4>(acc, hp, DM, hp, DM, 1 << 30, [&](int r) { return m0 + r; }, (const bf16_t*)(ws + OFF_WPG) + (size_t)n0 * 1024, 1024, 16, lds);
#pragma unroll
        for (int m = 0; m < 4; ++m) { const size_t row = m0 + wr * 64 + 16 * m + fr;
#pragma unroll
            for (int n = 0; n < 4; ++n) { const int col = n0 + wc * 64 + 16 * n + 4 * fq; float* xp = P.out + row * DM + col; f32x4 xv = *(const f32x4*)xp;
                xv[0] += bflo(pe[m][n].x) * sigmf(acc[m][n][0]); xv[1] += bfhi(pe[m][n].x) * sigmf(acc[m][n][1]); xv[2] += bflo(pe[m][n].y) * sigmf(acc[m][n][2]); xv[3] += bfhi(pe[m][n].y) * sigmf(acc[m][n][3]);
                *(f32x4*)xp = xv; } }
    }
}
__device__ __forceinline__ void phase_final(const Params& P) {
    const int tid = threadIdx.x, lane = tid & 63, wv = tid >> 6; const float* g = P.final_g;
    const f32x4 g0 = *(const f32x4*)(g + lane * 8), g1 = *(const f32x4*)(g + lane * 8 + 4), g2 = *(const f32x4*)(g + 512 + lane * 8), g3 = *(const f32x4*)(g + 512 + lane * 8 + 4);
    for (int row = blockIdx.x * 8 + wv; row < T_TOK; row += gridDim.x * 8) { float* xr = P.out + (size_t)row * DM;
        f32x4 a0 = *(const f32x4*)(xr + lane * 8), a1 = *(const f32x4*)(xr + lane * 8 + 4), a2 = *(const f32x4*)(xr + 512 + lane * 8), a3 = *(const f32x4*)(xr + 512 + lane * 8 + 4);
        float ss = 0.f;
#pragma unroll
        for (int e = 0; e < 4; ++e) ss += a0[e] * a0[e] + a1[e] * a1[e] + a2[e] * a2[e] + a3[e] * a3[e];
        ss = wsum(ss); const float r = rsqrtf(ss * (1.0f / DM) + EPS);
        *(f32x4*)(xr + lane * 8) = a0 * r * g0; *(f32x4*)(xr + lane * 8 + 4) = a1 * r * g1; *(f32x4*)(xr + 512 + lane * 8) = a2 * r * g2; *(f32x4*)(xr + 512 + lane * 8 + 4) = a3 * r * g3; }
}

constexpr int NPHASE = 11;
constexpr int LDS_BYTES = 128 * 1024;
__global__ void __launch_bounds__(512, 2) mk_fwd(Params P) {
    extern __shared__ __attribute__((aligned(16))) char lds[];
    volatile LAS unsigned* xbw = (volatile LAS unsigned*)(LAS char*)(lds + LDS_BYTES - 16);
    if (threadIdx.x == 0) { xbw[0] = 0u; xbw[1] = 0u; xbw[2] = 0u; xbw[3] = 0u; }
    __syncthreads();
    XcdBarrier bar = xcd_barrier_post((unsigned*)(P.ws + OFF_BAR), xbw);
    const int lo = P.ph_lo, hi = P.ph_hi;
#define PH(k) (lo <= (k) && (k) < hi)
#define SEAM(k) if (lo <= (k) && (k) + 1 < hi) xcd_barrier(bar)
    if (PH(0)) phase_prep(P, lds);
    SEAM(0);
    if (PH(1)) phase_inproj(P, lds);
    SEAM(1);
    if (PH(2)) { for (int u = blockIdx.x; u < 256; u += gridDim.x) { mla_unit(P, u >> 1, u & 1, lds); mlstm_unit1(P, u, lds); } }
    SEAM(2);
    if (PH(3)) {
        for (int u = blockIdx.x; u < 512; u += gridDim.x) { const int x = u & 7, kk = u >> 3, bh = x + 8 * (kk >> 4), j = kk & 15;
#pragma unroll 1
            for (int hf = 0; hf < 2; ++hf) attn_unit(P, bh >> 3, bh & 7, hf ? 31 - j : j, lds); }
        for (int u = blockIdx.x; u < 256; u += gridDim.x) mlstm_unit2(P, u, lds);
    }
    SEAM(3);
    if (PH(4)) phase_outproj(P, lds);
    SEAM(4);
    if (PH(5)) phase_router(P, lds);
    SEAM(5);
    if (PH(6)) phase_moe_gu(P, lds);
    SEAM(6);
    if (PH(7)) phase_moe_down(P, lds);
    SEAM(7);
    if (PH(8)) phase_combine(P, lds);
    SEAM(8);
    if (PH(9)) phase_ple(P, lds);
    SEAM(9);
    if (PH(10)) phase_final(P);
}

#ifndef DBG_PHASES
#define DBG_PHASES 0
#endif
#ifndef DBG_OFF
#define DBG_OFF OFF_MQ
#endif
#ifndef DBG_LD
#define DBG_LD 512
#endif
#ifndef DBG_C0
#define DBG_C0 0
#endif
#ifndef DBG_NC
#define DBG_NC 512
#endif
#ifndef DBG_ROWS
#define DBG_ROWS T_TOK
#endif
__global__ void __launch_bounds__(256) dbg_dump(const bf16_t* src, float* out) {
    for (size_t i = (size_t)blockIdx.x * 256 + threadIdx.x; i < (size_t)T_TOK * DM; i += (size_t)gridDim.x * 256) { const size_t r = i / DM; const int c = (int)(i % DM); float a = 0.f;
        for (size_t rr = r; rr < (size_t)DBG_ROWS; rr += T_TOK) for (int cc = c; cc < DBG_NC; cc += DM) a += bf2f(src[rr * DBG_LD + DBG_C0 + cc]);
        out[i] = a; }
}
extern "C" void kernel_launch(void* const* d_in, const int* in_sizes, int n_in, void* d_out, int out_size, void* d_ws, size_t ws_size, hipStream_t stream) {
    static int grid = 0;
    if (grid == 0) {
        if (n_in != 31 || in_sizes[0] != T_TOK * DM || out_size != T_TOK * DM || ws_size < WS_END) { fprintf(stderr, "kernel_launch: unexpected shapes (n_in %d, ws %zu < %zu)\n", n_in, ws_size, (size_t)WS_END); grid = -1; return; }
        int dev = 0, cus = 0, per_cu = 0;
        if (hipGetDevice(&dev) != hipSuccess || hipDeviceGetAttribute(&cus, hipDeviceAttributeMultiprocessorCount, dev) != hipSuccess) { grid = -1; return; }
        if (hipFuncSetAttribute((const void*)mk_fwd, hipFuncAttributeMaxDynamicSharedMemorySize, LDS_BYTES) != hipSuccess) { fprintf(stderr, "kernel_launch: hipFuncSetAttribute failed\n"); grid = -1; return; }
        if (hipOccupancyMaxActiveBlocksPerMultiprocessor(&per_cu, (const void*)mk_fwd, 512, LDS_BYTES) != hipSuccess || per_cu < 1) fprintf(stderr, "kernel_launch: occupancy query reports %d\n", per_cu);
        (void)hipGetLastError();
        grid = cus;
    }
    if (grid < 0) return;
    (void)hipMemsetAsync(d_ws, 0, CTL_BYTES, stream);
    Params P{};
    P.x = (const float*)d_in[0]; P.p = (const float*)d_in[1]; P.pos = (const int*)d_in[2];
    P.norm_mix_g = (const float*)d_in[3]; P.w_in = (const float*)d_in[4]; P.q_norm_g = (const float*)d_in[5]; P.w_uq = (const float*)d_in[6]; P.kv_norm_g = (const float*)d_in[7]; P.w_ukv = (const float*)d_in[8];
    P.conv_w = (const float*)d_in[9]; P.conv_b = (const float*)d_in[10]; P.w_mq = (const float*)d_in[11]; P.w_mk = (const float*)d_in[12]; P.w_mv = (const float*)d_in[13];
    P.b_igate = (const float*)d_in[14]; P.b_fgate = (const float*)d_in[15]; P.mh_norm_g = (const float*)d_in[16]; P.ml_skip = (const float*)d_in[17]; P.w_o = (const float*)d_in[18];
    P.norm_ffn_g = (const float*)d_in[19]; P.w_rg = (const float*)d_in[20]; P.b_rg = (const float*)d_in[21]; P.w_re = (const float*)d_in[22]; P.b_re = (const float*)d_in[23];
    P.w_gate_e = (const float*)d_in[24]; P.w_up_e = (const float*)d_in[25]; P.w_down_e = (const float*)d_in[26]; P.norm_ple_g = (const float*)d_in[27]; P.w_ple = (const float*)d_in[28]; P.w_pg = (const float*)d_in[29]; P.final_g = (const float*)d_in[30];
    P.out = (float*)d_out; P.ws = (unsigned char*)d_ws;
#if DBG_PHASES
    for (int k = 0; k < DBG_PHASES; ++k) { P.ph_lo = k; P.ph_hi = k + 1; hipLaunchKernelGGL(mk_fwd, dim3(grid), dim3(512), LDS_BYTES, stream, P); }
    hipLaunchKernelGGL(dbg_dump, dim3(2048), dim3(256), 0, stream, (const bf16_t*)((unsigned char*)d_ws + DBG_OFF), (float*)d_out);
#elif MK_MULTI
    for (int k = 0; k < NPHASE; ++k) { P.ph_lo = k; P.ph_hi = k + 1; hipLaunchKernelGGL(mk_fwd, dim3(grid), dim3(512), LDS_BYTES, stream, P); }
#else
    P.ph_lo = 0; P.ph_hi = NPHASE; hipLaunchKernelGGL(mk_fwd, dim3(grid), dim3(512), LDS_BYTES, stream, P);
#endif
}
```

```cpp
#include <hip/hip_runtime.h>
#include <cstdio>
#include <cstdint>

#ifndef MK_MULTI
#define MK_MULTI 0
#endif

typedef unsigned short bf16_t;
typedef short bf16x8 __attribute__((ext_vector_type(8)));
typedef short s16x4 __attribute__((ext_vector_type(4)));
typedef float f32x4 __attribute__((ext_vector_type(4)));
typedef float f32x16 __attribute__((ext_vector_type(16)));
typedef unsigned u32x4 __attribute__((ext_vector_type(4)));
typedef unsigned u32x2 __attribute__((ext_vector_type(2)));
#define LAS __attribute__((address_space(3)))
typedef LAS const char* lds_cptr;
typedef short v4i16_t __attribute__((ext_vector_type(4)));

constexpr int T_TOK = 32768, DM = 1024, SEQ = 8192, NB = 4;
constexpr int INW = 1448, INWP = 1536;
constexpr int C_CQ = 0, C_CKV = 256, C_KR = 384, C_XM = 416, C_Z = 928, C_IG = 1440;
constexpr int QW = 768, KW = 768, VW = 512;
constexpr int NEXP = 32, DEXP = 256;
constexpr int PROWS = 65536 + 32 * 256;
constexpr float EPS = 1e-6f;
constexpr float QSCALE = 0.10206207261596577f * 1.4426950408889634f;

constexpr size_t MiB = 1ull << 20;
constexpr size_t OFF_BAR = 0;
constexpr size_t OFF_CNT = 16384;
constexpr size_t CTL_BYTES = 32768;
constexpr size_t OFF_WIN = 1 * MiB;
constexpr size_t OFF_WUQ = OFF_WIN + (size_t)INWP * 1024 * 2;
constexpr size_t OFF_WUKV = OFF_WUQ + 768 * 256 * 2;
constexpr size_t OFF_WM = OFF_WUKV + 1024 * 128 * 2;
constexpr size_t OFF_WO = OFF_WM + 12 * 128 * 128 * 2;
constexpr size_t OFF_WR = OFF_WO + 1024 * 1024 * 2;
constexpr size_t OFF_WGU = OFF_WR + 128 * 1024 * 2;
constexpr size_t OFF_WD = OFF_WGU + (size_t)32 * 512 * 1024 * 2;
constexpr size_t OFF_WPLE = OFF_WD + (size_t)32 * 1024 * 256 * 2;
constexpr size_t OFF_WPG = OFF_WPLE + 1024 * 256 * 2;
constexpr size_t OFF_ROPE = OFF_WPG + 1024 * 1024 * 2;
constexpr size_t OFF_PB = OFF_ROPE + (size_t)T_TOK * 32 * 4;
constexpr size_t OFF_GATES = OFF_PB + (size_t)T_TOK * 256 * 2;
constexpr size_t OFF_CSTAT = OFF_GATES + (size_t)T_TOK * 8 * 4;
constexpr size_t OFF_NST = OFF_CSTAT + 2048 * 2 * 4;
constexpr size_t OFF_MST = OFF_NST + 256 * 8 * 128 * 4;
constexpr size_t OFF_TOKREC = OFF_MST + 256 * 8 * 4;
constexpr size_t OFF_LIST = OFF_TOKREC + (size_t)T_TOK * 16;
constexpr size_t OFF_STATIC_END = OFF_LIST + (size_t)32 * T_TOK * 4;
static_assert(OFF_STATIC_END <= 88 * MiB, "static region");
constexpr size_t OFF_PROJ = 88 * MiB;
constexpr size_t OFF_XC = OFF_PROJ + 96 * MiB;
constexpr size_t OFF_MQ = OFF_XC + 32 * MiB;
constexpr size_t OFF_MK = OFF_MQ + 32 * MiB;
constexpr size_t OFF_MV = OFF_MK + 32 * MiB;
constexpr size_t OFF_ATT = OFF_MV + 32 * MiB;
constexpr size_t OFF_XN = OFF_ATT + 32 * MiB;
constexpr size_t OFF_STATE = OFF_XN + 64 * MiB;
constexpr size_t OFF_MLO = OFF_STATE + 64 * MiB;
constexpr size_t WS_END = OFF_MLO + 32 * MiB;
static_assert(WS_END <= 512 * MiB, "workspace");
constexpr size_t OFF_ACT = OFF_PROJ;
constexpr size_t OFF_Y = OFF_XC;
static_assert(OFF_Y + (size_t)PROWS * 1024 * 2 <= OFF_XN, "y overlay");
constexpr size_t OFF_PE = OFF_STATE;

#define XB_TMO      128
#define XB_XCNT(j)  (256  + 64 * (j))
#define XB_XSUB(j)  (1280 + 64 * (j))
#define XB_XGEN(j)  (2304 + 64 * (j))
#define XB_TOP      3328
#define XB_TOPGEN   3392
#define XCD_BAR_WORDS 3456
#define XB_SPIN_CAP (1u << 18)

__device__ __forceinline__ unsigned xb_ld(unsigned* p)              { return __hip_atomic_load(p, __ATOMIC_RELAXED, __HIP_MEMORY_SCOPE_AGENT); }
__device__ __forceinline__ unsigned xb_add(unsigned* p, unsigned v) { return __hip_atomic_fetch_add(p, v, __ATOMIC_RELAXED, __HIP_MEMORY_SCOPE_AGENT); }
__device__ __forceinline__ unsigned xb_xcc_id() { return (unsigned)__builtin_amdgcn_s_getreg((3 << 11) | 20) & 0xFu; }
#define XB_SPIN(cond, bar) do { unsigned _sp = 0; while (cond) { __builtin_amdgcn_s_sleep(1); \
    if ((++_sp & 255u) == 0u) { if (xb_ld(&(bar)[XB_TMO])) break; if (_sp > XB_SPIN_CAP) { atomicAdd(&(bar)[XB_TMO], 1u); break; } } } } while (0)

struct XcdBarrier { unsigned* bar; unsigned x; volatile LAS unsigned* st; };

__device__ __forceinline__ XcdBarrier xcd_barrier_post(unsigned* bar, volatile LAS unsigned* st) {
    XcdBarrier b; b.bar = bar; b.x = xb_xcc_id(); b.st = st;
    if (threadIdx.x == 0) (void)xb_add(&bar[XB_XCNT(b.x)], 1u);
    return b;
}
__device__ __forceinline__ void xcd_barrier_complete(unsigned* bar, unsigned x, unsigned& nloc, unsigned& nx) {
    const unsigned G = gridDim.x * gridDim.y * gridDim.z;
    unsigned sum, cnt, mine, sp = 0u;
    for (;;) {
        sum = 0u; cnt = 0u; mine = 0u;
#pragma unroll
        for (unsigned j = 0; j < 16; ++j) { const unsigned c = xb_ld(&bar[XB_XCNT(j)]); sum += c; cnt += (c > 0u) ? 1u : 0u; mine = (j == x) ? c : mine; }
        if (sum == G) break;
        __builtin_amdgcn_s_sleep(1);
        if ((++sp & 255u) == 0u) { if (xb_ld(&bar[XB_TMO])) break; if (sp > XB_SPIN_CAP) { atomicAdd(&bar[XB_TMO], 1u); break; } }
    }
    nloc = mine > 0u ? mine : 1u; nx = cnt > 0u ? cnt : 1u;
}
__device__ __forceinline__ void xcd_barrier(const XcdBarrier& b) {
    asm volatile("s_waitcnt vmcnt(0)" ::: "memory");
    __syncthreads();
    if (threadIdx.x == 0) {
        unsigned* bar = b.bar;
        __builtin_amdgcn_s_waitcnt(0);
        unsigned nloc = b.st[0], nx = b.st[1];
        if (nloc == 0u) { xcd_barrier_complete(bar, b.x, nloc, nx); b.st[0] = nloc; b.st[1] = nx; }
        const unsigned old = xb_add(&bar[XB_XSUB(b.x)], 1u);
        const unsigned gen = old / nloc;
        if (old + 1u == (gen + 1u) * nloc) {
            __builtin_amdgcn_fence(__ATOMIC_RELEASE, "agent");
            asm volatile("s_waitcnt vmcnt(0)" ::: "memory");
            const unsigned og = xb_add(&bar[XB_TOP], 1u);
            const unsigned tg = og / nx;
            if (og + 1u == (tg + 1u) * nx) xb_add(&bar[XB_TOPGEN], 1u);
            else XB_SPIN(xb_ld(&bar[XB_TOPGEN]) == tg, bar);
            __builtin_amdgcn_fence(__ATOMIC_ACQUIRE, "agent");
            xb_add(&bar[XB_XGEN(b.x)], 1u);
            asm volatile("s_waitcnt vmcnt(0)" ::: "memory");
        } else {
            XB_SPIN(xb_ld(&bar[XB_XGEN(b.x)]) == gen, bar);
            __builtin_amdgcn_fence(__ATOMIC_ACQUIRE, "agent");
            asm volatile("s_waitcnt vmcnt(0)" ::: "memory");
        }
    }
    __syncthreads();
}

typedef __bf16 bf16x2_t __attribute__((ext_vector_type(2)));
typedef float f32x2 __attribute__((ext_vector_type(2)));
__device__ __forceinline__ unsigned cvtpk(float lo, float hi) { f32x2 v = {lo, hi}; bf16x2_t b = __builtin_convertvector(v, bf16x2_t); return __builtin_bit_cast(unsigned, b); }
__device__ __forceinline__ float bf2f(unsigned short v) { return __uint_as_float((unsigned)v << 16); }
__device__ __forceinline__ float bflo(unsigned w) { return __uint_as_float(w << 16); }
__device__ __forceinline__ float bfhi(unsigned w) { return __uint_as_float(w & 0xffff0000u); }
__device__ __forceinline__ void st4bf(bf16_t* p, f32x4 v) { u32x2 w; w.x = cvtpk(v[0], v[1]); w.y = cvtpk(v[2], v[3]); *(u32x2*)p = w; }
__device__ __forceinline__ float wsum(float v) {
#pragma unroll
    for (int o = 32; o > 0; o >>= 1) v += __shfl_xor(v, o);
    return v; }
__device__ __forceinline__ float wmax(float v) {
#pragma unroll
    for (int o = 32; o > 0; o >>= 1) v = fmaxf(v, __shfl_xor(v, o));
    return v; }
__device__ __forceinline__ float siluf(float v) { return v / (1.f + __expf(-v)); }
__device__ __forceinline__ float sigmf(float v) { return 1.f / (1.f + __expf(-v)); }
__device__ __forceinline__ void glds16(const void* g, unsigned lds_base) {
    unsigned sv; asm volatile("s_mov_b32 %0, m0\n\ts_mov_b32 m0, %2\n\ts_nop 0\n\tglobal_load_lds_dwordx4 %1, off\n\ts_mov_b32 m0, %0" : "=&s"(sv) : "v"(g), "s"(lds_base) : "memory"); }
#define RFL(x) __builtin_amdgcn_readfirstlane(x)
#define MFMA16(a, b, c) __builtin_amdgcn_mfma_f32_16x16x32_bf16(a, b, c, 0, 0, 0)
#define MFMA32(a, b, c) __builtin_amdgcn_mfma_f32_32x32x16_bf16(a, b, c, 0, 0, 0)
#define WAITVM0() asm volatile("s_waitcnt vmcnt(0)" ::: "memory")
#define WAITLGKM0() asm volatile("s_waitcnt lgkmcnt(0)" ::: "memory")
__device__ __forceinline__ int crow(int r, int hi) { return (r & 3) + 8 * (r >> 2) + 4 * hi; }
__device__ __forceinline__ s16x4 vtr(lds_cptr p) { return __builtin_bit_cast(s16x4, __builtin_amdgcn_ds_read_tr16_b64_v4i16((LAS v4i16_t*)p)); }
__device__ __forceinline__ bf16x8 cat8(s16x4 a, s16x4 b) { return (bf16x8){a[0], a[1], a[2], a[3], b[0], b[1], b[2], b[3]}; }

struct Params {
    const float* x; const float* p; const int* pos;
    const float *norm_mix_g, *w_in, *q_norm_g, *w_uq, *kv_norm_g, *w_ukv, *conv_w, *conv_b, *w_mq, *w_mk, *w_mv, *b_igate, *b_fgate,
                *mh_norm_g, *ml_skip, *w_o, *norm_ffn_g, *w_rg, *b_rg, *w_re, *b_re, *w_gate_e, *w_up_e, *w_down_e, *norm_ple_g, *w_ple, *w_pg, *final_g;
    float* out; unsigned char* ws; int ph_lo, ph_hi, sub, pad;
};

constexpr int G_STAGE = 49152;
constexpr int LDS_GEMM = 2 * G_STAGE;
struct GDesc { const bf16_t* a0; const bf16_t* a1; const int* gather; const bf16_t* bt; int ld0, ld1, ksplit, m0, nvalid, ldb, nk; };
__device__ __forceinline__ GDesc gdesc(const bf16_t* a, int lda, int m0, const bf16_t* bt, int ldb, int nk) {
    GDesc d; d.a0 = a; d.a1 = a; d.gather = nullptr; d.bt = bt; d.ld0 = lda; d.ld1 = lda; d.ksplit = 1 << 30; d.m0 = m0; d.nvalid = 0; d.ldb = ldb; d.nk = nk; return d; }
template <int MT> __device__ __forceinline__ void g_rows(const GDesc& d, int (&rows)[MT]) {
    const int lane = threadIdx.x & 63, wid = RFL(threadIdx.x >> 6);
#pragma unroll
    for (int i = 0; i < MT; ++i) { const int r = i * 64 + wid * 8 + (lane >> 3); rows[i] = d.gather ? (r < d.nvalid ? d.gather[r] : 0) : d.m0 + r; }
}
template <int MT> __device__ __forceinline__ void g_stage(const GDesc& d, const int (&rows)[MT], int kt, int buf, unsigned lds0) {
    const int lane = threadIdx.x & 63, wid = RFL(threadIdx.x >> 6); const int cch = (lane & 7) ^ (lane >> 3);
    const bf16_t* ab = d.a0; int ld = d.ld0, kk = kt;
    if (kt >= d.ksplit) { ab = d.a1; ld = d.ld1; kk = kt - d.ksplit; }
#pragma unroll
    for (int i = 0; i < MT; ++i) glds16(ab + (size_t)rows[i] * ld + kk * 64 + cch * 8, RFL(lds0 + buf * G_STAGE + i * 8192 + wid * 1024));
    const bf16_t* bp = d.bt + (size_t)(wid * 8 + (lane >> 3)) * d.ldb + cch * 8 + kt * 64;
    glds16(bp, RFL(lds0 + buf * G_STAGE + 32768 + wid * 1024));
    glds16(bp + (size_t)64 * d.ldb, RFL(lds0 + buf * G_STAGE + 32768 + 8192 + wid * 1024));
}
template <int MT> __device__ __forceinline__ void g_compute(f32x4 (&acc)[MT][4], const char* sa) {
    const int lane = threadIdx.x & 63, wid = RFL(threadIdx.x >> 6), wr = wid >> 1, wc = wid & 1, fr = lane & 15, fq = lane >> 4;
    const char* sb = sa + 32768;
#pragma unroll
    for (int kk = 0; kk < 2; ++kk) {
        bf16x8 af[MT], bfr[4];
        const int sw = ((4 * kk + fq) ^ (fr & 7)) << 4;
#pragma unroll
        for (int m = 0; m < MT; ++m) af[m] = *(const bf16x8*)(sa + (wr * 16 * MT + 16 * m + fr) * 128 + sw);
#pragma unroll
        for (int n = 0; n < 4; ++n) bfr[n] = *(const bf16x8*)(sb + (wc * 64 + 16 * n + fr) * 128 + sw);
#pragma unroll
        for (int m = 0; m < MT; ++m)
#pragma unroll
            for (int n = 0; n < 4; ++n) acc[m][n] = MFMA16(bfr[n], af[m], acc[m][n]);
    }
}
template <int MT, class DescFn, class EpiFn>
__device__ __forceinline__ void gemm_tiles(int ntiles, DescFn df, EpiFn ef, char* lds) {
    if (ntiles <= 0) return;
    const unsigned lds0 = (unsigned)(uintptr_t)lds;
    GDesc d = df(0); int rows[MT]; g_rows<MT>(d, rows);
    int cur = 0;
    __syncthreads();
    g_stage<MT>(d, rows, 0, 0, lds0);
    for (int t = 0; t < ntiles; ++t) {
        const bool hn = t + 1 < ntiles; GDesc dn = d; int rowsn[MT];
#pragma unroll
        for (int i = 0; i < MT; ++i) rowsn[i] = rows[i];
        if (hn) { dn = df(t + 1); g_rows<MT>(dn, rowsn); }
        f32x4 acc[MT][4];
#pragma unroll
        for (int m = 0; m < MT; ++m)
#pragma unroll
            for (int n = 0; n < 4; ++n) acc[m][n] = (f32x4){0.f, 0.f, 0.f, 0.f};
        for (int kt = 0; kt < d.nk; ++kt) {
            WAITVM0(); __syncthreads();
            if (kt + 1 < d.nk) g_stage<MT>(d, rows, kt + 1, cur ^ 1, lds0); else if (hn) g_stage<MT>(dn, rowsn, 0, cur ^ 1, lds0);
            g_compute<MT>(acc, lds + cur * G_STAGE); cur ^= 1;
        }
        ef(t, acc);
        d = dn;
#pragma unroll
        for (int i = 0; i < MT; ++i) rows[i] = rowsn[i];
    }
}

__device__ __forceinline__ void tr_tile(const float* src, int N, int k0, int n0, bf16_t* dst, int ldd, int mode, float scale, const float* kgain, float* tile) {
    const int tid = threadIdx.x;
    __syncthreads();
#pragma unroll
    for (int i = 0; i < 8; ++i) { const int idx = tid + 512 * i, kk = idx >> 6, nn = idx & 63;
        float v = 0.f; if (n0 + nn < N) v = src[(size_t)(k0 + kk) * N + n0 + nn];
        if (kgain) v *= kgain[k0 + kk];
        tile[kk * 65 + nn] = v * scale; }
    __syncthreads();
#pragma unroll
    for (int i = 0; i < 8; ++i) { const int idx = tid + 512 * i, nn = idx >> 6, kk = idx & 63; const int n = n0 + nn;
        if (n < N) { int r = n; if (mode) r = (n >> 6) * 128 + ((n >> 5) & 1) * 64 + (mode - 1) * 32 + (n & 31);
            dst[(size_t)r * ldd + k0 + kk] = (bf16_t)(cvtpk(tile[kk * 65 + nn], 0.f) & 0xffffu); } }
}

__device__ __forceinline__ void phase_prep(const Params& P, char* lds) {
    unsigned char* ws = P.ws; float* tile = (float*)lds;
    const int bid = blockIdx.x, nb = gridDim.x, tid = threadIdx.x;
    const int NJ = 12;
    const int cnt[NJ] = {16 * 23, 4 * 12, 2 * 16, 12 * 4, 256, 2048, 2048, 2048, 64, 256, 16, 16};
    int total = 0;
#pragma unroll
    for (int j = 0; j < NJ; ++j) total += cnt[j];
    for (int u = bid; u < total; u += nb) {
        int j = 0, r = u;
#pragma unroll
        for (int jj = 0; jj < NJ - 1; ++jj) if (j == jj && r >= cnt[jj]) { r -= cnt[jj]; j = jj + 1; }
        switch (j) {
        case 0: tr_tile(P.w_in, INW, (r / 23) * 64, (r % 23) * 64, (bf16_t*)(ws + OFF_WIN), 1024, 0, 1.f, nullptr, tile); break;
        case 1: tr_tile(P.w_uq, 768, (r / 12) * 64, (r % 12) * 64, (bf16_t*)(ws + OFF_WUQ), 256, 0, 1.f, P.q_norm_g, tile); break;
        case 2: tr_tile(P.w_ukv, 1024, (r / 16) * 64, (r % 16) * 64, (bf16_t*)(ws + OFF_WUKV), 128, 0, 1.f, P.kv_norm_g, tile); break;
        case 3: { const int mat = r >> 2, t4 = r & 3, kind = mat >> 2, h = mat & 3; const float* s = (kind == 0 ? P.w_mq : kind == 1 ? P.w_mk : P.w_mv) + h * 16384;
                  tr_tile(s, 128, (t4 >> 1) * 64, (t4 & 1) * 64, (bf16_t*)(ws + OFF_WM) + mat * 16384, 128, 0, kind == 1 ? 0.08838834764831845f : 1.f, nullptr, tile); } break;
        case 4: tr_tile(P.w_o, 1024, (r >> 4) * 64, (r & 15) * 64, (bf16_t*)(ws + OFF_WO), 1024, 0, 1.f, nullptr, tile); break;
        case 5: { const int e = r >> 6, t6 = r & 63; tr_tile(P.w_gate_e + (size_t)e * 1024 * 256, 256, (t6 >> 2) * 64, (t6 & 3) * 64, (bf16_t*)(ws + OFF_WGU) + (size_t)e * 512 * 1024, 1024, 1, 1.f, nullptr, tile); } break;
        case 6: { const int e = r >> 6, t6 = r & 63; tr_tile(P.w_up_e + (size_t)e * 1024 * 256, 256, (t6 >> 2) * 64, (t6 & 3) * 64, (bf16_t*)(ws + OFF_WGU) + (size_t)e * 512 * 1024, 1024, 2, 1.f, nullptr, tile); } break;
        case 7: { const int e = r >> 6, t6 = r & 63; tr_tile(P.w_down_e + (size_t)e * 256 * 1024, 1024, (t6 >> 4) * 64, (t6 & 15) * 64, (bf16_t*)(ws + OFF_WD) + (size_t)e * 1024 * 256, 256, 0, 1.f, nullptr, tile); } break;
        case 8: tr_tile(P.w_ple, 1024, (r >> 4) * 64, (r & 15) * 64, (bf16_t*)(ws + OFF_WPLE), 256, 0, 1.f, nullptr, tile); break;
        case 9: tr_tile(P.w_pg, 1024, (r >> 4) * 64, (r & 15) * 64, (bf16_t*)(ws + OFF_WPG), 1024, 0, 1.f, nullptr, tile); break;
        case 10: tr_tile(P.w_rg, 4, r * 64, 0, (bf16_t*)(ws + OFF_WR), 1024, 0, 1.f, nullptr, tile); break;
        default: tr_tile(P.w_re, 32, r * 64, 0, (bf16_t*)(ws + OFF_WR) + 4 * 1024, 1024, 0, 1.f, nullptr, tile); break;
        }
    }
    { u32x4 z = (u32x4){0u, 0u, 0u, 0u};
      u32x4* a = (u32x4*)((bf16_t*)(ws + OFF_WIN) + (size_t)INW * 1024); const int na = (INWP - INW) * 1024 / 8;
      for (int i = bid * 512 + tid; i < na; i += nb * 512) a[i] = z;
      u32x4* b = (u32x4*)((bf16_t*)(ws + OFF_WR) + 36 * 1024); const int nbz = (128 - 36) * 1024 / 8;
      for (int i = bid * 512 + tid; i < nbz; i += nb * 512) b[i] = z; }
    { float2* rt = (float2*)(ws + OFF_ROPE);
      for (int i = bid * 512 + tid; i < T_TOK * 16; i += nb * 512) { const int t = i >> 4, j = i & 15;
          const float inv = 1.0f / powf(10000.0f, (float)(2 * j) / 32.0f); const float ang = (float)P.pos[t] * inv; float s, c; sincosf(ang, &s, &c); rt[i] = make_float2(c, s); } }
    { const f32x4* src = (const f32x4*)P.p; u32x2* dst = (u32x2*)(ws + OFF_PB);
      for (int i = bid * 512 + tid; i < T_TOK * 256 / 4; i += nb * 512) { const f32x4 v = src[i]; u32x2 w; w.x = cvtpk(v[0], v[1]); w.y = cvtpk(v[2], v[3]); dst[i] = w; } }
    { const int lane = tid & 63, wv = tid >> 6; bf16_t* xn = (bf16_t*)(ws + OFF_XN);
      const f32x4 g0 = *(const f32x4*)(P.norm_mix_g + lane * 8), g1 = *(const f32x4*)(P.norm_mix_g + lane * 8 + 4), g2 = *(const f32x4*)(P.norm_mix_g + 512 + lane * 8), g3 = *(const f32x4*)(P.norm_mix_g + 512 + lane * 8 + 4);
      for (int row = bid * 8 + wv; row < T_TOK; row += nb * 8) { const float* xr = P.x + (size_t)row * DM;
          const f32x4 a0 = *(const f32x4*)(xr + lane * 8), a1 = *(const f32x4*)(xr + lane * 8 + 4), a2 = *(const f32x4*)(xr + 512 + lane * 8), a3 = *(const f32x4*)(xr + 512 + lane * 8 + 4);
          float ss = 0.f;
#pragma unroll
          for (int e = 0; e < 4; ++e) ss += a0[e] * a0[e] + a1[e] * a1[e] + a2[e] * a2[e] + a3[e] * a3[e];
          ss = wsum(ss); const float r = rsqrtf(ss * (1.0f / DM) + EPS);
          u32x4 w0, w1;
          w0.x = cvtpk(a0[0] * r * g0[0], a0[1] * r * g0[1]); w0.y = cvtpk(a0[2] * r * g0[2], a0[3] * r * g0[3]); w0.z = cvtpk(a1[0] * r * g1[0], a1[1] * r * g1[1]); w0.w = cvtpk(a1[2] * r * g1[2], a1[3] * r * g1[3]);
          w1.x = cvtpk(a2[0] * r * g2[0], a2[1] * r * g2[1]); w1.y = cvtpk(a2[2] * r * g2[2], a2[3] * r * g2[3]); w1.z = cvtpk(a3[0] * r * g3[0], a3[1] * r * g3[1]); w1.w = cvtpk(a3[2] * r * g3[2], a3[3] * r * g3[3]);
          *(u32x4*)(xn + (size_t)row * DM + lane * 8) = w0; *(u32x4*)(xn + (size_t)row * DM + 512 + lane * 8) = w1; } }
}

__device__ __forceinline__ void phase_inproj(const Params& P, char* lds) {
    unsigned char* ws = P.ws; const bf16_t* xn = (const bf16_t*)(ws + OFF_XN); const bf16_t* Wt = (const bf16_t*)(ws + OFF_WIN);
    bf16_t* proj = (bf16_t*)(ws + OFF_PROJ); bf16_t* Kb = (bf16_t*)P.out + (size_t)T_TOK * QW; float* gates = (float*)(ws + OFF_GATES); const float2* rope = (const float2*)(ws + OFF_ROPE);
    const int tid = threadIdx.x, lane = tid & 63, wid = RFL(tid >> 6), wr = wid >> 1, wc = wid & 1, fr = lane & 15, fq = lane >> 4;
    const int G = gridDim.x, nmine = (128 * 12 - (int)blockIdx.x + G - 1) / G;
    gemm_tiles<4>(nmine, [&](int t) { const int u = blockIdx.x + t * G, mt = u / 12, nt = u % 12; return gdesc(xn, DM, mt * 256, Wt + (size_t)nt * 128 * DM, DM, 16); },
      [&](int t, f32x4 (&acc)[4][4]) {
        const int u = blockIdx.x + t * G, mt = u / 12, nt = u % 12, m0 = mt * 256, n0 = nt * 128;
#pragma unroll
        for (int m = 0; m < 4; ++m) { const int row = m0 + wr * 64 + 16 * m + fr;
#pragma unroll
            for (int n = 0; n < 4; ++n) { const int c16 = n0 + wc * 64 + 16 * n, col = c16 + 4 * fq;
                if (c16 == C_KR) {
                    const f32x4 x1 = acc[m][n], x2 = acc[m][(n + 1) & 3]; f32x4 o1, o2;
#pragma unroll
                    for (int e = 0; e < 4; ++e) { const float2 cs = rope[(size_t)row * 16 + 4 * fq + e]; o1[e] = x1[e] * cs.x - x2[e] * cs.y; o2[e] = x1[e] * cs.y + x2[e] * cs.x; }
#pragma unroll
                    for (int h = 0; h < 8; ++h) { st4bf(Kb + (size_t)row * KW + h * 96 + 64 + 4 * fq, o1); st4bf(Kb + (size_t)row * KW + h * 96 + 80 + 4 * fq, o2); }
                } else if (c16 == C_KR + 16) {   }
                else if (c16 == C_IG) { if (fq < 2) *(f32x4*)(gates + (size_t)row * 8 + 4 * fq) = acc[m][n]; }
                else if (c16 < C_IG) st4bf(proj + (size_t)row * INWP + col, acc[m][n]);
            } }
      }, lds);
}

constexpr int LDS_RS = LDS_GEMM;
__device__ __forceinline__ void mla_unit(const Params& P, int mt, int part, char* lds) {
    unsigned char* ws = P.ws; const bf16_t* proj = (const bf16_t*)(ws + OFF_PROJ);
    bf16_t* Qb = (bf16_t*)P.out; bf16_t* Kb = Qb + (size_t)T_TOK * QW; bf16_t* Vb = Kb + (size_t)T_TOK * KW; const float2* rope = (const float2*)(ws + OFF_ROPE);
    const int tid = threadIdx.x, lane = tid & 63, wid = RFL(tid >> 6), wr = wid >> 1, wc = wid & 1, fr = lane & 15, fq = lane >> 4;
    float* rs = (float*)(lds + LDS_RS);
    const int m0 = mt * 256;
    __syncthreads();
    { const int row = tid >> 1, half = tid & 1; const int cw = part == 0 ? 256 : 128, c0 = part == 0 ? C_CQ : C_CKV; const int per = cw / 2;
      const bf16_t* src = proj + (size_t)(m0 + row) * INWP + c0 + half * per; float ss = 0.f;
      for (int i = 0; i < per / 8; ++i) { const u32x4 v = *(const u32x4*)(src + i * 8);
#pragma unroll
          for (int e = 0; e < 4; ++e) { const float a = bflo(v[e]), b = bfhi(v[e]); ss += a * a + b * b; } }
      ss += __shfl_xor(ss, 1);
      if (half == 0) rs[row] = rsqrtf(ss / (float)cw + EPS); }
    __syncthreads();
    if (part == 0) {
        const bf16_t* Wt = (const bf16_t*)(ws + OFF_WUQ);
        gemm_tiles<4>(6, [&](int nt) { return gdesc(proj + C_CQ, INWP, m0, Wt + (size_t)nt * 128 * 256, 256, 4); },
          [&](int nt, f32x4 (&acc)[4][4]) {
#pragma unroll
            for (int m = 0; m < 4; ++m) { const int lr = wr * 64 + 16 * m + fr, row = m0 + lr; const float r = rs[lr] * QSCALE;
#pragma unroll
                for (int n = 0; n < 4; n += 2) { const int g16 = nt * 8 + wc * 4 + n, h = g16 / 6, jj = g16 % 6;
                    if (jj == 4) { const f32x4 x1 = acc[m][n] * r, x2 = acc[m][n + 1] * r; f32x4 o1, o2;
#pragma unroll
                        for (int e = 0; e < 4; ++e) { const float2 cs = rope[(size_t)row * 16 + 4 * fq + e]; o1[e] = x1[e] * cs.x - x2[e] * cs.y; o2[e] = x1[e] * cs.y + x2[e] * cs.x; }
                        st4bf(Qb + (size_t)row * QW + h * 96 + 64 + 4 * fq, o1); st4bf(Qb + (size_t)row * QW + h * 96 + 80 + 4 * fq, o2);
                    } else { st4bf(Qb + (size_t)row * QW + g16 * 16 + 4 * fq, acc[m][n] * r); st4bf(Qb + (size_t)row * QW + (g16 + 1) * 16 + 4 * fq, acc[m][n + 1] * r); } } }
          }, lds);
    } else {
        const bf16_t* Wt = (const bf16_t*)(ws + OFF_WUKV);
        gemm_tiles<4>(8, [&](int nt) { return gdesc(proj + C_CKV, INWP, m0, Wt + (size_t)nt * 128 * 128, 128, 2); },
          [&](int nt, f32x4 (&acc)[4][4]) {
#pragma unroll
            for (int m = 0; m < 4; ++m) { const int lr = wr * 64 + 16 * m + fr, row = m0 + lr; const float r = rs[lr];
#pragma unroll
                for (int n = 0; n < 4; ++n) { const int jj = wc * 4 + n;
                    if (jj < 4) st4bf(Kb + (size_t)row * KW + nt * 96 + jj * 16 + 4 * fq, acc[m][n] * r);
                    else st4bf(Vb + (size_t)row * VW + nt * 64 + (jj - 4) * 16 + 4 * fq, acc[m][n] * r); } }
          }, lds);
    }
}

__device__ __forceinline__ void gate_prep(const Params& P, int tok0, int h, float* sb, float* sgs, float* spm, float* sbl, float* sa) {
    const float* gates = (const float*)(P.ws + OFF_GATES);
    const int tid = threadIdx.x, lane = tid & 63, w = tid >> 6;
    const float fpre = gates[(size_t)(tok0 + tid) * 8 + 4 + h] + P.b_fgate[h], ig = gates[(size_t)(tok0 + tid) * 8 + h] + P.b_igate[h];
    const float logf = fminf(fpre, 0.f) - log1pf(__expf(-fabsf(fpre)));
    float b = logf;
#pragma unroll
    for (int o = 1; o < 64; o <<= 1) { const float t = __shfl_up(b, o); if (lane >= o) b += t; }
    const float gs = ig - b; float pm = gs;
#pragma unroll
    for (int o = 1; o < 64; o <<= 1) { const float t = __shfl_up(pm, o); if (lane >= o) pm = fmaxf(pm, t); }
    const float bl = __shfl(b, 63), mx = __shfl(pm, 63);
    sb[tid] = b; sgs[tid] = gs; spm[tid] = pm;
    if (lane == 0) { sbl[w] = bl; sa[w] = bl + mx; }
}

constexpr int LDS_M1_G = LDS_GEMM + 1024;
__device__ __forceinline__ void mlstm_unit1(const Params& P, int u, char* lds) {
    unsigned char* ws = P.ws; const bf16_t* proj = (const bf16_t*)(ws + OFF_PROJ);
    bf16_t* xc = (bf16_t*)(ws + OFF_XC); bf16_t* mq = (bf16_t*)(ws + OFF_MQ); bf16_t* mk = (bf16_t*)(ws + OFF_MK); bf16_t* mv = (bf16_t*)(ws + OFF_MV);
    const int b = u >> 6, h = (u >> 4) & 3, g = u & 15, tok0 = b * SEQ + g * 512;
    const int tid = threadIdx.x, lane = tid & 63, wid = RFL(tid >> 6), wr = wid >> 1, wc = wid & 1, fr = lane & 15, fq = lane >> 4, r32 = lane & 31, hi = lane >> 5;
    { const int ch = h * 128 + (tid & 15) * 8, sl = tid >> 4;
      float wv[4][8], bias[8];
#pragma unroll
      for (int k = 0; k < 4; ++k)
#pragma unroll
          for (int e = 0; e < 8; ++e) wv[k][e] = P.conv_w[k * 512 + ch + e];
#pragma unroll
      for (int e = 0; e < 8; ++e) bias[e] = P.conv_b[ch + e];
      const int tin0 = g * 512 + sl * 16; const bf16_t* src = proj + (size_t)(b * SEQ + tin0) * INWP + C_XM + ch;
      u32x4 xr[19];
#pragma unroll
      for (int i = 0; i < 19; ++i) { const int tt = tin0 - 3 + i; xr[i] = (u32x4){0u, 0u, 0u, 0u}; if (tt >= 0) xr[i] = *(const u32x4*)(src + (ptrdiff_t)(i - 3) * INWP); }
#pragma unroll
      for (int i = 0; i < 16; ++i) { float a[8];
#pragma unroll
          for (int e = 0; e < 8; ++e) a[e] = bias[e];
#pragma unroll
          for (int k = 0; k < 4; ++k) { const u32x4 v = xr[i + k];
#pragma unroll
              for (int e = 0; e < 4; ++e) { a[2 * e] += wv[k][2 * e] * bflo(v[e]); a[2 * e + 1] += wv[k][2 * e + 1] * bfhi(v[e]); } }
          u32x4 o;
#pragma unroll
          for (int e = 0; e < 4; ++e) o[e] = cvtpk(siluf(a[2 * e]), siluf(a[2 * e + 1]));
          *(u32x4*)(xc + (size_t)(tok0 + sl * 16 + i) * 512 + ch) = o; } }
    WAITVM0(); __syncthreads();
    gemm_tiles<4>(6, [&](int t) { const int kind = t >> 1, rt = t & 1; const bf16_t* A = kind < 2 ? xc + h * 128 : proj + C_XM + h * 128;
                                  return gdesc(A, kind < 2 ? 512 : INWP, tok0 + rt * 256, (const bf16_t*)(ws + OFF_WM) + (kind * 4 + h) * 16384, 128, 2); },
      [&](int t, f32x4 (&acc)[4][4]) { const int kind = t >> 1, rt = t & 1, m0 = tok0 + rt * 256; bf16_t* dst = kind == 0 ? mq : kind == 1 ? mk : mv;
#pragma unroll
        for (int m = 0; m < 4; ++m) { const int row = m0 + wr * 64 + 16 * m + fr;
#pragma unroll
            for (int n = 0; n < 4; ++n) st4bf(dst + (size_t)row * 512 + h * 128 + wc * 64 + 16 * n + 4 * fq, acc[m][n]); }
      }, lds);
    WAITVM0(); __syncthreads();
    float* sb = (float*)(lds + LDS_M1_G); float* sgs = sb + 512; float* spm = sgs + 512; float* sbl = spm + 512; float* sa = sbl + 8;
    gate_prep(P, tok0, h, sb, sgs, spm, sbl, sa);
    __syncthreads();
    if (tid < 8) { float* cs = (float*)(ws + OFF_CSTAT) + ((size_t)(b * 4 + h) * 128 + g * 8 + tid) * 2; cs[0] = sbl[tid]; cs[1] = sa[tid]; }
    float tail[8]; float mend = -INFINITY;
    { float acc = 0.f;
#pragma unroll
      for (int j = 7; j >= 0; --j) { tail[j] = acc; mend = fmaxf(mend, acc + sa[j]); acc += sbl[j]; } }
    f32x16 cacc[2], nacc; cacc[0] = f32x16{}; cacc[1] = f32x16{}; nacc = f32x16{};
    const bf16x8 ones = (bf16x8){0x3f80, 0x3f80, 0x3f80, 0x3f80, 0x3f80, 0x3f80, 0x3f80, 0x3f80};
    const int s0 = tid >> 4, c8 = tid & 15; const size_t gbase = (size_t)(tok0 + s0) * 512 + h * 128 + c8 * 8;
    u32x4 kq0 = *(const u32x4*)(mk + gbase), kq1 = *(const u32x4*)(mk + gbase + 32 * 512), vq0 = *(const u32x4*)(mv + gbase), vq1 = *(const u32x4*)(mv + gbase + 32 * 512);
#pragma unroll 1
    for (int j = 0; j < 8; ++j) {
        char* img = lds + (j & 1) * 32768;
        { const float e0 = tail[j] + sbl[j] - mend; const float w0 = __expf(e0 + sgs[j * 64 + s0]), w1 = __expf(e0 + sgs[j * 64 + s0 + 32]);
          u32x4 k0, k1;
#pragma unroll
          for (int e = 0; e < 4; ++e) { k0[e] = cvtpk(bflo(kq0[e]) * w0, bfhi(kq0[e]) * w0); k1[e] = cvtpk(bflo(kq1[e]) * w1, bfhi(kq1[e]) * w1); }
          const int off = (c8 >> 2) * 4096 + s0 * 64 + (c8 & 3) * 16;
          *(u32x4*)(img + off) = k0; *(u32x4*)(img + off + 32 * 64) = k1; *(u32x4*)(img + 16384 + off) = vq0; *(u32x4*)(img + 16384 + off + 32 * 64) = vq1; }
        if (j < 7) { const size_t gn = gbase + (size_t)(j + 1) * 64 * 512; kq0 = *(const u32x4*)(mk + gn); kq1 = *(const u32x4*)(mk + gn + 32 * 512); vq0 = *(const u32x4*)(mv + gn); vq1 = *(const u32x4*)(mv + gn + 32 * 512); }
        __syncthreads();
        { const int q = (lane & 15) >> 2, p = lane & 3, cb = (lane >> 4) & 1;
          const lds_cptr kp = (lds_cptr)img + wr * 4096 + (4 * hi + q) * 64 + cb * 32 + p * 8;
          const lds_cptr vp = (lds_cptr)img + 16384 + (2 * wc) * 4096 + (4 * hi + q) * 64 + cb * 32 + p * 8;
#pragma unroll
          for (int ks = 0; ks < 4; ++ks) { const bf16x8 af = cat8(vtr(kp + ks * 1024), vtr(kp + ks * 1024 + 512));
              const bf16x8 b0 = cat8(vtr(vp + ks * 1024), vtr(vp + ks * 1024 + 512)), b1 = cat8(vtr(vp + 4096 + ks * 1024), vtr(vp + 4096 + ks * 1024 + 512));
              cacc[0] = MFMA32(af, b0, cacc[0]); cacc[1] = MFMA32(af, b1, cacc[1]);
              if (wc == 0) nacc = MFMA32(af, ones, nacc); } }
    }
    bf16_t* st = (bf16_t*)(ws + OFF_STATE) + (size_t)u * 16384; float* nst = (float*)(ws + OFF_NST) + (size_t)u * 128; float* mst = (float*)(ws + OFF_MST) + u;
#pragma unroll
    for (int nb2 = 0; nb2 < 2; ++nb2)
#pragma unroll
        for (int r = 0; r < 16; ++r) st[(wr * 32 + crow(r, hi)) * 128 + wc * 64 + nb2 * 32 + r32] = (bf16_t)(cvtpk(cacc[nb2][r], 0.f) & 0xffffu);
    if (wc == 0 && r32 == 0) {
#pragma unroll
        for (int r = 0; r < 16; ++r) nst[wr * 32 + crow(r, hi)] = nacc[r]; }
    if (tid == 0) mst[0] = mend;
    __syncthreads();
}

constexpr int LDS_AK = 0, LDS_AV = 2 * 12288, LDS_AW = LDS_AV + 2 * 8192;
#ifndef ATT_THR
#define ATT_THR 8.0f
#endif
__device__ __forceinline__ void attn_unit(const Params& P, int b, int h, int qb, char* lds) {
    const bf16_t* Qb = (const bf16_t*)P.out; const bf16_t* Kb = Qb + (size_t)T_TOK * QW; const bf16_t* Vb = Kb + (size_t)T_TOK * KW; bf16_t* att = (bf16_t*)(P.ws + OFF_ATT);
    const int tid = threadIdx.x, lane = tid & 63, r32 = lane & 31, hi = lane >> 5; const int wid = RFL(tid >> 6);
    const unsigned lds0 = (unsigned)(uintptr_t)lds;
    const size_t rowbase = (size_t)b * SEQ; const int q0 = qb * 256, NT = 4 * qb + 4, mynt = 4 * qb + (wid >> 1) + 1;
    const bf16_t* Qw = Qb + (rowbase + q0 + wid * 32 + r32) * QW + h * 96;
    bf16x8 qr[6];
#pragma unroll
    for (int d0 = 0; d0 < 6; ++d0) qr[d0] = *(const bf16x8*)(Qw + d0 * 16 + hi * 8);
    const bf16_t* ksrc0 = Kb + (rowbase + lane) * KW + h * 96 + wid * 8;
    const bf16_t* ksrc1 = Kb + (rowbase + lane) * KW + h * 96 + (8 + (wid & 3)) * 8;
    const bf16_t* vsrc = Vb + (rowbase + 16 * (wid & 3) + (lane >> 2)) * VW + h * 64 + (wid >> 2) * 32 + (lane & 3) * 8;
    float* wsf = (float*)(lds + LDS_AW) + wid * 64;
    float mhat = 0.f, l_reg = 0.f; f32x16 o0 = f32x16{}, o1 = f32x16{};
    const lds_cptr vp0 = (lds_cptr)lds + LDS_AV + ((lane >> 4) & 1) * 32 + (lane & 3) * 8 + (4 * hi + ((lane & 15) >> 2)) * 64;
    const char* kp0 = lds + LDS_AK + hi * 1024 + r32 * 16;
    auto dma = [&](int t, int slot) {
        glds16(ksrc0 + (size_t)t * 64 * KW, RFL(lds0 + LDS_AK + slot * 12288 + wid * 1024));
        if (wid < 4) glds16(ksrc1 + (size_t)t * 64 * KW, RFL(lds0 + LDS_AK + slot * 12288 + (8 + wid) * 1024));
        glds16(vsrc + (size_t)t * 64 * VW, RFL(lds0 + LDS_AV + slot * 8192 + wid * 1024));
    };
    __syncthreads();
    dma(0, 0);
    for (int t = 0; t < NT; ++t) {
        asm volatile("s_waitcnt vmcnt(0) lgkmcnt(0)" ::: "memory"); __syncthreads();
        if (t + 1 < NT) dma(t + 1, (t + 1) & 1);
        if (t < mynt) {
            const char* kp = kp0 + (t & 1) * 12288;
            f32x16 s0 = f32x16{}, s1 = f32x16{};
#pragma unroll
            for (int d0 = 0; d0 < 6; ++d0) { const bf16x8 k0 = *(const bf16x8*)(kp + d0 * 2048), k1 = *(const bf16x8*)(kp + d0 * 2048 + 512);
                s0 = MFMA32(k0, qr[d0], s0); s1 = MFMA32(k1, qr[d0], s1); }
            float rm = s0[0];
#pragma unroll
            for (int r = 1; r < 16; ++r) rm = fmaxf(rm, s0[r]);
#pragma unroll
            for (int r = 0; r < 16; ++r) rm = fmaxf(rm, s1[r]);
            rm = fmaxf(rm, __shfl_xor(rm, 32));
            if (t == 0) mhat = rm;
            else { const float d = rm - mhat;
                if (__any(d > ATT_THR)) { const float dl = fmaxf(d, 0.f); mhat += dl; const float f = __builtin_amdgcn_exp2f(-dl); l_reg *= f;
                    if (hi == 0) wsf[r32] = f; WAITLGKM0();
#pragma unroll
                    for (int r = 0; r < 16; ++r) { const float fr_ = wsf[crow(r, hi)]; o0[r] *= fr_; o1[r] *= fr_; }
                    WAITLGKM0(); } }
            float sacc = 0.f;
#pragma unroll
            for (int r = 0; r < 16; ++r) { s0[r] = __builtin_amdgcn_exp2f(s0[r] - mhat); s1[r] = __builtin_amdgcn_exp2f(s1[r] - mhat); sacc += s0[r] + s1[r]; }
            l_reg += sacc;
            u32x4 pw[4];
#pragma unroll
            for (int i = 0; i < 4; ++i) { pw[0][i] = cvtpk(s0[2 * i], s0[2 * i + 1]); pw[1][i] = cvtpk(s0[8 + 2 * i], s0[8 + 2 * i + 1]); pw[2][i] = cvtpk(s1[2 * i], s1[2 * i + 1]); pw[3][i] = cvtpk(s1[8 + 2 * i], s1[8 + 2 * i + 1]); }
            const lds_cptr vp = vp0 + (t & 1) * 8192;
#pragma unroll
            for (int ks = 0; ks < 4; ++ks) { const bf16x8 pa = __builtin_bit_cast(bf16x8, pw[ks]);
                const bf16x8 v0 = cat8(vtr(vp + ks * 1024), vtr(vp + ks * 1024 + 512)), v1 = cat8(vtr(vp + 4096 + ks * 1024), vtr(vp + 4096 + ks * 1024 + 512));
                o0 = MFMA32(pa, v0, o0); o1 = MFMA32(pa, v1, o1); }
        }
    }
    l_reg += __shfl_xor(l_reg, 32);
    WAITLGKM0();
    if (hi == 0) wsf[32 + r32] = l_reg;
    WAITLGKM0();
    bf16_t* Ow = att + (rowbase + q0 + wid * 32) * 512 + h * 64;
#pragma unroll
    for (int r = 0; r < 16; ++r) { const int orow = crow(r, hi); const float rl = 1.0f / wsf[32 + orow];
        Ow[(size_t)orow * 512 + r32] = (bf16_t)(cvtpk(o0[r] * rl, 0.f) & 0xffffu); Ow[(size_t)orow * 512 + 32 + r32] = (bf16_t)(cvtpk(o1[r] * rl, 0.f) & 0xffffu); }
    WAITLGKM0();
}

constexpr int LDS_M2_C = 0, LDS_M2_Q = 32768, LDS_M2_K = 49152, LDS_M2_V = 65536, LDS_M2_KS = 81920, LDS_M2_NUM = 98304  , LDS_M2_MISC = 98304 + 33792;
__device__ __forceinline__ void mlstm_unit2(const Params& P, int u, char* lds) {
    unsigned char* ws = P.ws; const bf16_t* proj = (const bf16_t*)(ws + OFF_PROJ);
    const bf16_t* xc = (const bf16_t*)(ws + OFF_XC); const bf16_t* mq = (const bf16_t*)(ws + OFF_MQ); const bf16_t* mk = (const bf16_t*)(ws + OFF_MK); const bf16_t* mv = (const bf16_t*)(ws + OFF_MV);
    bf16_t* mlo = (bf16_t*)(ws + OFF_MLO);
    const int b = u >> 6, h = (u >> 4) & 3, g = u & 15, tok0 = b * SEQ + g * 512, seq = b * 4 + h;
    const int tid = threadIdx.x, lane = tid & 63, wid = RFL(tid >> 6), r32 = lane & 31, hi = lane >> 5, wr = wid >> 1, wc = wid & 1;
    float* misc = (float*)(lds + LDS_M2_MISC);
    float* sb = misc; float* sgs = sb + 512; float* spm = sgs + 512; float* sbl = spm + 512; float* sa = sbl + 8;
    float* marr = sa + 8; float* fbarr = marr + 136; float* cst = fbarr + 136;
    float* nfull = cst + 256; float* nseg = nfull + 128; float* sden = nseg + 128; float* swi = sden + 64; float* coef = swi + 64;
    __syncthreads();
    gate_prep(P, tok0, h, sb, sgs, spm, sbl, sa);
    if (tid < 256) cst[tid] = ((const float*)(ws + OFF_CSTAT))[(size_t)seq * 256 + tid];
    __syncthreads();
    if (tid == 0) { float m = 0.f, F = 0.f; const int nc = 8 * g + 8;
        for (int c = 0; c < nc; ++c) { marr[c] = m; fbarr[c] = F; const float bl = cst[2 * c], a = cst[2 * c + 1]; m = fmaxf(bl + m, a); F += bl; }
        marr[nc] = m; fbarr[nc] = F; }
    __syncthreads();
    const float* mstg = (const float*)(ws + OFF_MST);
    if (tid < 16) { float c = 0.f; if (tid < g) c = __expf(mstg[u - g + tid] + (fbarr[8 * g] - fbarr[8 * (tid + 1)]) - marr[8 * g]); coef[tid] = c; }
    __syncthreads();
    f32x16 cacc[2];
    { float cseg[32];
#pragma unroll
      for (int i = 0; i < 32; ++i) cseg[i] = 0.f;
      float nsg = 0.f;
      const bf16_t* stall = (const bf16_t*)(ws + OFF_STATE); const float* nstall = (const float*)(ws + OFF_NST);
      for (int gp = 0; gp < g; ++gp) { const float c = coef[gp]; const bf16_t* st = stall + (size_t)(u - g + gp) * 16384;
#pragma unroll
          for (int i = 0; i < 4; ++i) { const u32x4 v = *(const u32x4*)(st + (i * 512 + tid) * 8);
#pragma unroll
              for (int e = 0; e < 4; ++e) { cseg[i * 8 + 2 * e] += c * bflo(v[e]); cseg[i * 8 + 2 * e + 1] += c * bfhi(v[e]); } }
          if (tid < 128) nsg += c * nstall[(size_t)(u - g + gp) * 128 + tid]; }
      if (tid < 128) nseg[tid] = nsg;
      float* tmp = (float*)lds;
#pragma unroll
      for (int i = 0; i < 4; ++i) { *(f32x4*)(tmp + (i * 512 + tid) * 8) = (f32x4){cseg[i * 8], cseg[i * 8 + 1], cseg[i * 8 + 2], cseg[i * 8 + 3]}; *(f32x4*)(tmp + (i * 512 + tid) * 8 + 4) = (f32x4){cseg[i * 8 + 4], cseg[i * 8 + 5], cseg[i * 8 + 6], cseg[i * 8 + 7]}; }
      __syncthreads();
#pragma unroll
      for (int nb2 = 0; nb2 < 2; ++nb2)
#pragma unroll
          for (int r = 0; r < 16; ++r) cacc[nb2][r] = tmp[(wr * 32 + crow(r, hi)) * 128 + wc * 64 + nb2 * 32 + r32];
    }
    const int tb = wid & 1, db = wid >> 1;
    const int s0 = tid >> 4, c8 = tid & 15; const size_t gbase = (size_t)(tok0 + s0) * 512 + h * 128 + c8 * 8;
    u32x4 qa0 = *(const u32x4*)(mq + gbase), qa1 = *(const u32x4*)(mq + gbase + 32 * 512), ka0 = *(const u32x4*)(mk + gbase), ka1 = *(const u32x4*)(mk + gbase + 32 * 512),
          va0 = *(const u32x4*)(mv + gbase), va1 = *(const u32x4*)(mv + gbase + 32 * 512);
#pragma unroll 1
    for (int j = 0; j < 8; ++j) {
        const int c = 8 * g + j; const float mc = marr[c], mn = marr[c + 1], bl = sbl[j]; const float decay = __expf(bl + mc - mn);
        __syncthreads();
#pragma unroll
        for (int nb2 = 0; nb2 < 2; ++nb2)
#pragma unroll
            for (int r = 0; r < 16; ++r) *(bf16_t*)(lds + LDS_M2_C + (2 * wc + nb2) * 8192 + (wr * 32 + crow(r, hi)) * 64 + r32 * 2) = (bf16_t)(cvtpk(cacc[nb2][r], 0.f) & 0xffffu);
        float* ncur = (j & 1) ? nfull : nseg; float* nnxt = (j & 1) ? nseg : nfull;
        { const float w0 = __expf(bl + sgs[j * 64 + s0] - mn), w1 = __expf(bl + sgs[j * 64 + s0 + 32] - mn);
          u32x4 k0, k1;
#pragma unroll
          for (int e = 0; e < 4; ++e) { k0[e] = cvtpk(bflo(ka0[e]) * w0, bfhi(ka0[e]) * w0); k1[e] = cvtpk(bflo(ka1[e]) * w1, bfhi(ka1[e]) * w1); }
          const int so0 = s0 * 256 + ((c8 ^ (s0 & 15)) << 4), so1 = (s0 + 32) * 256 + ((c8 ^ (s0 & 15)) << 4);
          *(u32x4*)(lds + LDS_M2_Q + so0) = qa0; *(u32x4*)(lds + LDS_M2_Q + so1) = qa1; *(u32x4*)(lds + LDS_M2_K + so0) = ka0; *(u32x4*)(lds + LDS_M2_K + so1) = ka1;
          const int off = (c8 >> 2) * 4096 + s0 * 64 + (c8 & 3) * 16;
          *(u32x4*)(lds + LDS_M2_V + off) = va0; *(u32x4*)(lds + LDS_M2_V + off + 32 * 64) = va1; *(u32x4*)(lds + LDS_M2_KS + off) = k0; *(u32x4*)(lds + LDS_M2_KS + off + 32 * 64) = k1; }
        if (tid < 64) swi[tid] = __expf(mc - fmaxf(spm[j * 64 + tid], mc));
        const int ft = tid >> 3, pp = tid & 7; const size_t ftok = (size_t)tok0 + j * 64 + ft; const int fch = h * 128 + 16 * pp;
        u32x4 xa, xb, za, zb;
        __syncthreads();
        { const int t = 32 * tb + r32; const float mt = fmaxf(spm[j * 64 + t], mc);
          const char* qrow = lds + LDS_M2_Q + t * 256;
          f32x16 sT[2]; sT[0] = f32x16{}; sT[1] = f32x16{};
#pragma unroll
          for (int ks = 0; ks < 8; ++ks) { const bf16x8 qf = *(const bf16x8*)(qrow + (((2 * ks + hi) ^ (t & 15)) << 4));
              { const int s = r32; const bf16x8 kf = *(const bf16x8*)(lds + LDS_M2_K + s * 256 + (((2 * ks + hi) ^ (s & 15)) << 4)); sT[0] = MFMA32(kf, qf, sT[0]); }
              if (tb) { const int s = 32 + r32; const bf16x8 kf = *(const bf16x8*)(lds + LDS_M2_K + s * 256 + (((2 * ks + hi) ^ (s & 15)) << 4)); sT[1] = MFMA32(kf, qf, sT[1]); } }
          float dsum = 0.f;
#pragma unroll
          for (int sbk = 0; sbk < 2; ++sbk)
#pragma unroll
              for (int r = 0; r < 16; ++r) { const int s = 32 * sbk + crow(r, hi); const float w = (s <= t) ? __expf(sgs[j * 64 + s] - mt) : 0.f; const float v = sT[sbk][r] * w; sT[sbk][r] = v; dsum += v; }
          dsum += __shfl_xor(dsum, 32);
          if (db == 0 && hi == 0) sden[t] = dsum;
          u32x4 pw[4];
#pragma unroll
          for (int i = 0; i < 4; ++i) { pw[0][i] = cvtpk(sT[0][2 * i], sT[0][2 * i + 1]); pw[1][i] = cvtpk(sT[0][8 + 2 * i], sT[0][8 + 2 * i + 1]); pw[2][i] = cvtpk(sT[1][2 * i], sT[1][2 * i + 1]); pw[3][i] = cvtpk(sT[1][8 + 2 * i], sT[1][8 + 2 * i + 1]); }
          const int q = (lane & 15) >> 2, p = lane & 3, cb = (lane >> 4) & 1;
          const lds_cptr vp = (lds_cptr)lds + LDS_M2_V + db * 4096 + (4 * hi + q) * 64 + cb * 32 + p * 8;
          f32x16 o1 = f32x16{}, o2 = f32x16{};
#pragma unroll
          for (int ks = 0; ks < 4; ++ks) { if (ks < 2 * (tb + 1)) { const bf16x8 vf = cat8(vtr(vp + ks * 1024), vtr(vp + ks * 1024 + 512)); o1 = MFMA32(__builtin_bit_cast(bf16x8, pw[ks]), vf, o1); } }
          const lds_cptr cp = (lds_cptr)lds + LDS_M2_C + db * 8192 + (8 * hi + q) * 64 + cb * 32 + p * 8;
#pragma unroll
          for (int ks = 0; ks < 8; ++ks) { const bf16x8 qf = *(const bf16x8*)(qrow + (((2 * ks + hi) ^ (t & 15)) << 4)); const bf16x8 cf = cat8(vtr(cp + ks * 1024), vtr(cp + ks * 1024 + 256)); o2 = MFMA32(qf, cf, o2); }
          float* num = (float*)(lds + LDS_M2_NUM);
#pragma unroll
          for (int r = 0; r < 16; ++r) { const int tr_ = 32 * tb + crow(r, hi); num[tr_ * 132 + db * 32 + r32] = o1[r] + swi[tr_] * o2[r]; }
          if (j < 7) { const size_t gn = gbase + (size_t)(j + 1) * 64 * 512; qa0 = *(const u32x4*)(mq + gn); qa1 = *(const u32x4*)(mq + gn + 32 * 512); ka0 = *(const u32x4*)(mk + gn); ka1 = *(const u32x4*)(mk + gn + 32 * 512);
              va0 = *(const u32x4*)(mv + gn); va1 = *(const u32x4*)(mv + gn + 32 * 512); }
#pragma unroll
          for (int r = 0; r < 16; ++r) { cacc[0][r] *= decay; cacc[1][r] *= decay; }
          const lds_cptr kp = (lds_cptr)lds + LDS_M2_KS + wr * 4096 + (4 * hi + q) * 64 + cb * 32 + p * 8;
          const lds_cptr vp2 = (lds_cptr)lds + LDS_M2_V + (2 * wc) * 4096 + (4 * hi + q) * 64 + cb * 32 + p * 8;
#pragma unroll
          for (int ks = 0; ks < 4; ++ks) { const bf16x8 af = cat8(vtr(kp + ks * 1024), vtr(kp + ks * 1024 + 512));
              const bf16x8 b0 = cat8(vtr(vp2 + ks * 1024), vtr(vp2 + ks * 1024 + 512)), b1 = cat8(vtr(vp2 + 4096 + ks * 1024), vtr(vp2 + 4096 + ks * 1024 + 512));
              cacc[0] = MFMA32(af, b0, cacc[0]); cacc[1] = MFMA32(af, b1, cacc[1]); }
          if (tid < 128) { float a = 0.f; const char* kcol = lds + LDS_M2_KS + (tid >> 5) * 4096 + (tid & 31) * 2;
#pragma unroll 8
              for (int s2 = 0; s2 < 64; ++s2) a += bf2f(*(const bf16_t*)(kcol + s2 * 64));
              nnxt[tid] = decay * ncur[tid] + a; } }
        xa = *(const u32x4*)(xc + ftok * 512 + fch); xb = *(const u32x4*)(xc + ftok * 512 + fch + 8);
        za = *(const u32x4*)(proj + ftok * INWP + C_Z + fch); zb = *(const u32x4*)(proj + ftok * INWP + C_Z + fch + 8);
        __syncthreads();
        { const int t = ft; const float* num = (const float*)(lds + LDS_M2_NUM);
          float qn = 0.f;
#pragma unroll
          for (int cc = 0; cc < 2; ++cc) { const u32x4 qv = *(const u32x4*)(lds + LDS_M2_Q + t * 256 + (((2 * pp + cc) ^ (t & 15)) << 4));
#pragma unroll
              for (int e = 0; e < 4; ++e) qn += bflo(qv[e]) * ncur[16 * pp + 8 * cc + 2 * e] + bfhi(qv[e]) * ncur[16 * pp + 8 * cc + 2 * e + 1]; }
          qn += __shfl_xor(qn, 1); qn += __shfl_xor(qn, 2); qn += __shfl_xor(qn, 4);
          const float mt = sb[j * 64 + t] + fmaxf(spm[j * 64 + t], mc);
          float den = sden[t] + swi[t] * qn; den = fmaxf(fabsf(den), __expf(-mt)); const float rden = 1.0f / den;
          float hv[16]; float s1 = 0.f;
#pragma unroll
          for (int e = 0; e < 16; ++e) { hv[e] = num[t * 132 + 16 * pp + e] * rden; s1 += hv[e]; }
          s1 += __shfl_xor(s1, 1); s1 += __shfl_xor(s1, 2); s1 += __shfl_xor(s1, 4);
          const float mu = s1 * (1.0f / 128.0f); float s2 = 0.f;
#pragma unroll
          for (int e = 0; e < 16; ++e) { const float d = hv[e] - mu; s2 += d * d; }
          s2 += __shfl_xor(s2, 1); s2 += __shfl_xor(s2, 2); s2 += __shfl_xor(s2, 4);
          const float rstd = rsqrtf(s2 * (1.0f / 128.0f) + EPS);
          float ov[16];
#pragma unroll
          for (int e = 0; e < 16; ++e) { const unsigned xw = e < 8 ? xa[e >> 1] : xb[(e - 8) >> 1], zw = e < 8 ? za[e >> 1] : zb[(e - 8) >> 1];
              const float xcv = (e & 1) ? bfhi(xw) : bflo(xw), zv = (e & 1) ? bfhi(zw) : bflo(zw);
              const float hn = (hv[e] - mu) * rstd * P.mh_norm_g[fch + e];
              ov[e] = (hn + P.ml_skip[fch + e] * xcv) * siluf(zv); }
          u32x4 oa, ob;
#pragma unroll
          for (int e = 0; e < 4; ++e) { oa[e] = cvtpk(ov[2 * e], ov[2 * e + 1]); ob[e] = cvtpk(ov[8 + 2 * e], ov[8 + 2 * e + 1]); }
          *(u32x4*)(mlo + ftok * 512 + fch) = oa; *(u32x4*)(mlo + ftok * 512 + fch + 8) = ob; }
    }
}

__device__ __forceinline__ void phase_outproj(const Params& P, char* lds) {
    unsigned char* ws = P.ws; const bf16_t* att = (const bf16_t*)(ws + OFF_ATT); const bf16_t* mlo = (const bf16_t*)(ws + OFF_MLO); const bf16_t* Wt = (const bf16_t*)(ws + OFF_WO);
    const int tid = threadIdx.x, lane = tid & 63, wid = RFL(tid >> 6), wr = wid >> 1, wc = wid & 1, fr = lane & 15, fq = lane >> 4;
    const int G = gridDim.x, nmine = (128 * 8 - (int)blockIdx.x + G - 1) / G;
    gemm_tiles<4>(nmine, [&](int t) { const int u = blockIdx.x + t * G, mt = u >> 3, nt = u & 7; GDesc d = gdesc(att, 512, mt * 256, Wt + (size_t)nt * 128 * 1024, 1024, 16); d.a1 = mlo; d.ksplit = 8; return d; },
      [&](int t, f32x4 (&acc)[4][4]) { const int u = blockIdx.x + t * G, mt = u >> 3, nt = u & 7, m0 = mt * 256, n0 = nt * 128;
#pragma unroll
        for (int m = 0; m < 4; ++m) { const size_t row = m0 + wr * 64 + 16 * m + fr;
#pragma unroll
            for (int n = 0; n < 4; ++n) { const int col = n0 + wc * 64 + 16 * n + 4 * fq; const f32x4 xv = *(const f32x4*)(P.x + row * DM + col); *(f32x4*)(P.out + row * DM + col) = xv + acc[m][n]; } }
      }, lds);
}

__device__ __forceinline__ void norm_row_store(const f32x4& a0, const f32x4& a1, const f32x4& a2, const f32x4& a3, const float* g, int lane, bf16_t* dst) {
    float ss = 0.f;
#pragma unroll
    for (int e = 0; e < 4; ++e) ss += a0[e] * a0[e] + a1[e] * a1[e] + a2[e] * a2[e] + a3[e] * a3[e];
    ss = wsum(ss); const float r = rsqrtf(ss * (1.0f / DM) + EPS);
    const f32x4 g0 = *(const f32x4*)(g + lane * 8), g1 = *(const f32x4*)(g + lane * 8 + 4), g2 = *(const f32x4*)(g + 512 + lane * 8), g3 = *(const f32x4*)(g + 512 + lane * 8 + 4);
    u32x4 w0, w1;
    w0.x = cvtpk(a0[0] * r * g0[0], a0[1] * r * g0[1]); w0.y = cvtpk(a0[2] * r * g0[2], a0[3] * r * g0[3]); w0.z = cvtpk(a1[0] * r * g1[0], a1[1] * r * g1[1]); w0.w = cvtpk(a1[2] * r * g1[2], a1[3] * r * g1[3]);
    w1.x = cvtpk(a2[0] * r * g2[0], a2[1] * r * g2[1]); w1.y = cvtpk(a2[2] * r * g2[2], a2[3] * r * g2[3]); w1.z = cvtpk(a3[0] * r * g3[0], a3[1] * r * g3[1]); w1.w = cvtpk(a3[2] * r * g3[2], a3[3] * r * g3[3]);
    *(u32x4*)(dst + lane * 8) = w0; *(u32x4*)(dst + 512 + lane * 8) = w1;
}

constexpr int LDS_LOGIT = LDS_GEMM;
__device__ __forceinline__ void phase_router(const Params& P, char* lds) {
    unsigned char* ws = P.ws; bf16_t* hn = (bf16_t*)(ws + OFF_XN); const bf16_t* Wr = (const bf16_t*)(ws + OFF_WR);
    unsigned* cnt = (unsigned*)(ws + OFF_CNT); int* list = (int*)(ws + OFF_LIST); float* tokrec = (float*)(ws + OFF_TOKREC);
    const int tid = threadIdx.x, lane = tid & 63, wid = RFL(tid >> 6), wr = wid >> 1, wc = wid & 1, fr = lane & 15, fq = lane >> 4;
    float* logit = (float*)(lds + LDS_LOGIT);
    for (int u = blockIdx.x; u < 256; u += gridDim.x) {
        const int m0 = u * 128;
        for (int i = 0; i < 16; ++i) { const size_t row = m0 + wid * 16 + i; const float* xr = P.out + row * DM;
            const f32x4 a0 = *(const f32x4*)(xr + lane * 8), a1 = *(const f32x4*)(xr + lane * 8 + 4), a2 = *(const f32x4*)(xr + 512 + lane * 8), a3 = *(const f32x4*)(xr + 512 + lane * 8 + 4);
            norm_row_store(a0, a1, a2, a3, P.norm_ffn_g, lane, hn + row * DM); }
        WAITVM0(); __syncthreads();
        gemm_tiles<2>(1, [&](int) { return gdesc(hn, DM, m0, Wr, DM, 16); },
          [&](int, f32x4 (&acc)[2][4]) {
            if (wc == 0) {
#pragma unroll
                for (int m = 0; m < 2; ++m) { const int lr = wr * 32 + 16 * m + fr;
#pragma unroll
                    for (int n = 0; n < 3; ++n) { const int col = 16 * n + 4 * fq; if (col < 36) *(f32x4*)(logit + lr * 40 + col) = acc[m][n]; } } }
          }, lds);
        __syncthreads();
        if (tid < 128) { const int tok = m0 + tid; const float* lg = logit + tid * 40;
            float gl[4]; float gm = -INFINITY; int gi = 0;
#pragma unroll
            for (int k = 0; k < 4; ++k) { gl[k] = lg[k] + P.b_rg[k]; if (gl[k] > gm) { gm = gl[k]; gi = k; } }
            float gsum = 0.f;
#pragma unroll
            for (int k = 0; k < 4; ++k) gsum += __expf(gl[k] - gm);
            const float gtop = 1.0f / gsum;
            float el[8]; float e1 = -INFINITY, e2 = -INFINITY; int i1 = 0, i2 = 0;
#pragma unroll
            for (int k = 0; k < 8; ++k) { el[k] = lg[4 + gi * 8 + k] + P.b_re[gi * 8 + k]; }
#pragma unroll
            for (int k = 0; k < 8; ++k) { if (el[k] > e1) { e2 = e1; i2 = i1; e1 = el[k]; i1 = k; } else if (el[k] > e2) { e2 = el[k]; i2 = k; } }
            const float rr = __expf(e2 - e1); const float w1 = gtop / (1.f + rr), w2 = gtop * rr / (1.f + rr);
            const int ex1 = gi * 8 + i1, ex2 = gi * 8 + i2;
            const unsigned p1 = __hip_atomic_fetch_add(cnt + ex1 * 64, 1u, __ATOMIC_RELAXED, __HIP_MEMORY_SCOPE_AGENT);
            const unsigned p2 = __hip_atomic_fetch_add(cnt + ex2 * 64, 1u, __ATOMIC_RELAXED, __HIP_MEMORY_SCOPE_AGENT);
            list[(size_t)ex1 * T_TOK + p1] = tok; list[(size_t)ex2 * T_TOK + p2] = tok;
            f32x4 rec; rec[0] = __uint_as_float((unsigned)(ex1 << 16) | 0u); rec[1] = w1; rec[2] = __uint_as_float(p1); rec[3] = w2;
            rec[0] = __uint_as_float((unsigned)ex1 | ((unsigned)ex2 << 8));
            *(f32x4*)(tokrec + (size_t)tok * 4) = rec;
            ((unsigned*)(ws + OFF_GATES))[tok] = p2;
        }
        __syncthreads();
    }
}

__device__ __forceinline__ int moe_bases(const Params& P, int* sbase, int* stile) {
    const unsigned* cnt = (const unsigned*)(P.ws + OFF_CNT);
    __syncthreads();
    if (threadIdx.x == 0) { int acc = 0, tt = 0; for (int e = 0; e < NEXP; ++e) { const int c = (int)__hip_atomic_load(cnt + e * 64, __ATOMIC_RELAXED, __HIP_MEMORY_SCOPE_AGENT); const int nt = (c + 255) >> 8; sbase[e] = acc; stile[e] = tt; acc += nt * 256; tt += nt; } sbase[NEXP] = acc; stile[NEXP] = tt; }
    __syncthreads();
    return stile[NEXP];
}

constexpr int LDS_MOE = LDS_GEMM;
__device__ __forceinline__ void phase_moe_gu(const Params& P, char* lds) {
    unsigned char* ws = P.ws; const bf16_t* hn = (const bf16_t*)(ws + OFF_XN); bf16_t* act = (bf16_t*)(ws + OFF_ACT); const int* list = (const int*)(ws + OFF_LIST);
    const unsigned* cnt = (const unsigned*)(ws + OFF_CNT);
    int* sbase = (int*)(lds + LDS_MOE); int* stile = sbase + 40;
    const int tid = threadIdx.x, lane = tid & 63, wid = RFL(tid >> 6), wr = wid >> 1, wc = wid & 1, fr = lane & 15, fq = lane >> 4;
    const int ntiles = moe_bases(P, sbase, stile);
    const int G = gridDim.x, nmine = (ntiles * 4 - (int)blockIdx.x + G - 1) / G;
    auto decode = [&](int t, int& e, int& it, int& nt) { const int u = blockIdx.x + t * G, ti = u >> 2; nt = u & 3; e = 0; for (int k = 1; k < NEXP; ++k) if (stile[k] <= ti) e = k; it = ti - stile[e]; };
    gemm_tiles<4>(nmine, [&](int t) { int e, it, nt; decode(t, e, it, nt); const int ce = (int)cnt[e * 64];
                                     GDesc d = gdesc(hn, DM, 0, (const bf16_t*)(ws + OFF_WGU) + ((size_t)e * 512 + nt * 128) * 1024, 1024, 16); d.gather = list + (size_t)e * T_TOK + it * 256; d.nvalid = ce - it * 256; return d; },
      [&](int t, f32x4 (&acc)[4][4]) { int e, it, nt; decode(t, e, it, nt); const size_t rbase = (size_t)sbase[e] + it * 256;
#pragma unroll
        for (int m = 0; m < 4; ++m) { const size_t row = rbase + wr * 64 + 16 * m + fr;
#pragma unroll
            for (int n = 0; n < 2; ++n) { f32x4 v;
#pragma unroll
                for (int q = 0; q < 4; ++q) v[q] = siluf(acc[m][n][q]) * acc[m][n + 2][q];
                st4bf(act + row * DEXP + nt * 64 + wc * 32 + 16 * n + 4 * fq, v); } }
      }, lds);
}
__device__ __forceinline__ void phase_moe_down(const Params& P, char* lds) {
    unsigned char* ws = P.ws; const bf16_t* act = (const bf16_t*)(ws + OFF_ACT); bf16_t* y = (bf16_t*)(ws + OFF_Y);
    int* sbase = (int*)(lds + LDS_MOE); int* stile = sbase + 40;
    const int tid = threadIdx.x, lane = tid & 63, wid = RFL(tid >> 6), wr = wid >> 1, wc = wid & 1, fr = lane & 15, fq = lane >> 4;
    const int ntiles = moe_bases(P, sbase, stile);
    const int G = gridDim.x, nmine = (ntiles * 8 - (int)blockIdx.x + G - 1) / G;
    auto decode = [&](int t, int& e, int& rbase, int& nt) { const int u = blockIdx.x + t * G, ti = u >> 3; nt = u & 7; e = 0; for (int k = 1; k < NEXP; ++k) if (stile[k] <= ti) e = k; rbase = sbase[e] + (ti - stile[e]) * 256; };
    gemm_tiles<4>(nmine, [&](int t) { int e, rbase, nt; decode(t, e, rbase, nt); return gdesc(act, DEXP, rbase, (const bf16_t*)(ws + OFF_WD) + ((size_t)e * 1024 + nt * 128) * 256, 256, 4); },
      [&](int t, f32x4 (&acc)[4][4]) { int e, rbase, nt; decode(t, e, rbase, nt);
#pragma unroll
        for (int m = 0; m < 4; ++m) { const size_t row = (size_t)rbase + wr * 64 + 16 * m + fr;
#pragma unroll
            for (int n = 0; n < 4; ++n) st4bf(y + row * DM + nt * 128 + wc * 64 + 16 * n + 4 * fq, acc[m][n]); }
      }, lds);
}
__device__ __forceinline__ void phase_combine(const Params& P, char* lds) {
    unsigned char* ws = P.ws; const bf16_t* y = (const bf16_t*)(ws + OFF_Y); bf16_t* hp = (bf16_t*)(ws + OFF_XN); const float* tokrec = (const float*)(ws + OFF_TOKREC);
    int* sbase = (int*)(lds + LDS_MOE); int* stile = sbase + 40;
    (void)moe_bases(P, sbase, stile);
    const int tid = threadIdx.x, lane = tid & 63, wv = tid >> 6;
    for (int row = blockIdx.x * 8 + wv; row < T_TOK; row += gridDim.x * 8) {
        const f32x4 rec = *(const f32x4*)(tokrec + (size_t)row * 4); const unsigned ee = __float_as_uint(rec[0]); const int e1 = ee & 255, e2 = (ee >> 8) & 255;
        const unsigned p1 = __float_as_uint(rec[2]), p2 = ((const unsigned*)(ws + OFF_GATES))[row]; const float w1 = rec[1], w2 = rec[3];
        const bf16_t* y1 = y + ((size_t)sbase[e1] + p1) * DM; const bf16_t* y2 = y + ((size_t)sbase[e2] + p2) * DM;
        float* xr = P.out + (size_t)row * DM;
        f32x4 a0 = *(const f32x4*)(xr + lane * 8), a1 = *(const f32x4*)(xr + lane * 8 + 4), a2 = *(const f32x4*)(xr + 512 + lane * 8), a3 = *(const f32x4*)(xr + 512 + lane * 8 + 4);
        const u32x4 ya = *(const u32x4*)(y1 + lane * 8), yb = *(const u32x4*)(y1 + 512 + lane * 8), yc = *(const u32x4*)(y2 + lane * 8), yd = *(const u32x4*)(y2 + 512 + lane * 8);
#pragma unroll
        for (int e = 0; e < 2; ++e) { a0[2 * e] += w1 * bflo(ya[e]) + w2 * bflo(yc[e]); a0[2 * e + 1] += w1 * bfhi(ya[e]) + w2 * bfhi(yc[e]);
            a1[2 * e] += w1 * bflo(ya[2 + e]) + w2 * bflo(yc[2 + e]); a1[2 * e + 1] += w1 * bfhi(ya[2 + e]) + w2 * bfhi(yc[2 + e]);
            a2[2 * e] += w1 * bflo(yb[e]) + w2 * bflo(yd[e]); a2[2 * e + 1] += w1 * bfhi(yb[e]) + w2 * bfhi(yd[e]);
            a3[2 * e] += w1 * bflo(yb[2 + e]) + w2 * bflo(yd[2 + e]); a3[2 * e + 1] += w1 * bfhi(yb[2 + e]) + w2 * bfhi(yd[2 + e]); }
        *(f32x4*)(xr + lane * 8) = a0; *(f32x4*)(xr + lane * 8 + 4) = a1; *(f32x4*)(xr + 512 + lane * 8) = a2; *(f32x4*)(xr + 512 + lane * 8 + 4) = a3;
        norm_row_store(a0, a1, a2, a3, P.norm_ple_g, lane, hp + (size_t)row * DM);
    }
}
__device__ __forceinline__ void phase_ple(const Params& P, char* lds) {
    unsigned char* ws = P.ws; const bf16_t* hp = (const bf16_t*)(ws + OFF_XN); const bf16_t* pb = (const bf16_t*)(ws + OFF_PB);
    const int tid = threadIdx.x, lane = tid & 63, wid = RFL(tid >> 6), wr = wid >> 1, wc = wid & 1, fr = lane & 15, fq = lane >> 4;
    const int G = gridDim.x, nmine = (128 * 8 - (int)blockIdx.x + G - 1) / G;
    u32x2 pe[4][4];
    gemm_tiles<4>(nmine * 2, [&](int t) { const int u = blockIdx.x + (t >> 1) * G, mt = u >> 3, nt = u & 7;
                                         return (t & 1) ? gdesc(hp, DM, mt * 256, (const bf16_t*)(ws + OFF_WPG) + (size_t)nt * 128 * 1024, 1024, 16) : gdesc(pb, 256, mt * 256, (const bf16_t*)(ws + OFF_WPLE) + (size_t)nt * 128 * 256, 256, 4); },
      [&](int t, f32x4 (&acc)[4][4]) {
        if (!(t & 1)) {
#pragma unroll
            for (int m = 0; m < 4; ++m)
#pragma unroll
                for (int n = 0; n < 4; ++n) { pe[m][n].x = cvtpk(acc[m][n][0], acc[m][n][1]); pe[m][n].y = cvtpk(acc[m][n][2], acc[m][n][3]); }
        } else { const int u = blockIdx.x + (t >> 1) * G, mt = u >> 3, nt = u & 7, m0 = mt * 256, n0 = nt * 128;
#pragma unroll
            for (int m = 0; m < 4; ++m) { const size_t row = m0 + wr * 64 + 16 * m + fr;
#pragma unroll
                for (int n = 0; n < 4; ++n) { const int col = n0 + wc * 64 + 16 * n + 4 * fq; float* xp = P.out + row * DM + col; f32x4 xv = *(const f32x4*)xp;
                    xv[0] += bflo(pe[m][n].x) * sigmf(acc[m][n][0]); xv[1] += bfhi(pe[m][n].x) * sigmf(acc[m][n][1]); xv[2] += bflo(pe[m][n].y) * sigmf(acc[m][n][2]); xv[3] += bfhi(pe[m][n].y) * sigmf(acc[m][n][3]);
                    *(f32x4*)xp = xv; } } }
      }, lds);
}
__device__ __forceinline__ void phase_final(const Params& P) {
    const int tid = threadIdx.x, lane = tid & 63, wv = tid >> 6; const float* g = P.final_g;
    const f32x4 g0 = *(const f32x4*)(g + lane * 8), g1 = *(const f32x4*)(g + lane * 8 + 4), g2 = *(const f32x4*)(g + 512 + lane * 8), g3 = *(const f32x4*)(g + 512 + lane * 8 + 4);
    for (int row = blockIdx.x * 8 + wv; row < T_TOK; row += gridDim.x * 8) { float* xr = P.out + (size_t)row * DM;
        f32x4 a0 = *(const f32x4*)(xr + lane * 8), a1 = *(const f32x4*)(xr + lane * 8 + 4), a2 = *(const f32x4*)(xr + 512 + lane * 8), a3 = *(const f32x4*)(xr + 512 + lane * 8 + 4);
        float ss = 0.f;
#pragma unroll
        for (int e = 0; e < 4; ++e) ss += a0[e] * a0[e] + a1[e] * a1[e] + a2[e] * a2[e] + a3[e] * a3[e];
        ss = wsum(ss); const float r = rsqrtf(ss * (1.0f / DM) + EPS);
        *(f32x4*)(xr + lane * 8) = a0 * r * g0; *(f32x4*)(xr + lane * 8 + 4) = a1 * r * g1; *(f32x4*)(xr + 512 + lane * 8) = a2 * r * g2; *(f32x4*)(xr + 512 + lane * 8 + 4) = a3 * r * g3; }
}

constexpr int NPHASE = 11;
constexpr int LDS_BYTES = 144 * 1024;
__global__ void __launch_bounds__(512, 2) mk_fwd(Params P) {
    extern __shared__ __attribute__((aligned(16))) char lds[];
    volatile LAS unsigned* xbw = (volatile LAS unsigned*)(LAS char*)(lds + LDS_BYTES - 16);
    if (threadIdx.x == 0) { xbw[0] = 0u; xbw[1] = 0u; xbw[2] = 0u; xbw[3] = 0u; }
    __syncthreads();
    XcdBarrier bar = xcd_barrier_post((unsigned*)(P.ws + OFF_BAR), xbw);
    const int lo = P.ph_lo, hi = P.ph_hi;
#define PH(k) (lo <= (k) && (k) < hi)
#define SEAM(k) if (lo <= (k) && (k) + 1 < hi) xcd_barrier(bar)
    if (PH(0)) phase_prep(P, lds);
    SEAM(0);
    if (PH(1)) phase_inproj(P, lds);
    SEAM(1);
    if (PH(2)) { for (int u = blockIdx.x; u < 256; u += gridDim.x) { mla_unit(P, u >> 1, u & 1, lds); mlstm_unit1(P, u, lds); } }
    SEAM(2);
    if (PH(3)) {
        if (!(P.sub & 1)) for (int u = blockIdx.x; u < 512; u += gridDim.x) { const int x = u & 7, kk = u >> 3, bh = x + 8 * (kk >> 4), j = kk & 15;
#pragma unroll 1
            for (int hf = 0; hf < 2; ++hf) attn_unit(P, bh >> 3, bh & 7, hf ? 31 - j : j, lds); }
        if (!(P.sub & 2)) for (int u = blockIdx.x; u < 256; u += gridDim.x) mlstm_unit2(P, u, lds);
    }
    SEAM(3);
    if (PH(4)) phase_outproj(P, lds);
    SEAM(4);
    if (PH(5)) phase_router(P, lds);
    SEAM(5);
    if (PH(6)) phase_moe_gu(P, lds);
    SEAM(6);
    if (PH(7)) phase_moe_down(P, lds);
    SEAM(7);
    if (PH(8)) phase_combine(P, lds);
    SEAM(8);
    if (PH(9)) phase_ple(P, lds);
    SEAM(9);
    if (PH(10)) phase_final(P);
}

#ifndef DUP_PHASE
#define DUP_PHASE -1
#endif
#ifndef DUP_REPS
#define DUP_REPS 2
#endif
#ifndef DUP_SUB
#define DUP_SUB 0
#endif
#ifndef DBG_PHASES
#define DBG_PHASES 0
#endif
#ifndef DBG_OFF
#define DBG_OFF OFF_MQ
#endif
#ifndef DBG_LD
#define DBG_LD 512
#endif
#ifndef DBG_C0
#define DBG_C0 0
#endif
#ifndef DBG_NC
#define DBG_NC 512
#endif
#ifndef DBG_ROWS
#define DBG_ROWS T_TOK
#endif
__global__ void __launch_bounds__(256) dbg_dump(const bf16_t* src, float* out) {
    for (size_t i = (size_t)blockIdx.x * 256 + threadIdx.x; i < (size_t)T_TOK * DM; i += (size_t)gridDim.x * 256) { const size_t r = i / DM; const int c = (int)(i % DM); float a = 0.f;
        for (size_t rr = r; rr < (size_t)DBG_ROWS; rr += T_TOK) for (int cc = c; cc < DBG_NC; cc += DM) a += bf2f(src[rr * DBG_LD + DBG_C0 + cc]);
        out[i] = a; }
}
extern "C" void kernel_launch(void* const* d_in, const int* in_sizes, int n_in, void* d_out, int out_size, void* d_ws, size_t ws_size, hipStream_t stream) {
    static int grid = 0;
    if (grid == 0) {
        if (n_in != 31 || in_sizes[0] != T_TOK * DM || out_size != T_TOK * DM || ws_size < WS_END) { fprintf(stderr, "kernel_launch: unexpected shapes (n_in %d, ws %zu < %zu)\n", n_in, ws_size, (size_t)WS_END); grid = -1; return; }
        int dev = 0, cus = 0, per_cu = 0;
        if (hipGetDevice(&dev) != hipSuccess || hipDeviceGetAttribute(&cus, hipDeviceAttributeMultiprocessorCount, dev) != hipSuccess) { grid = -1; return; }
        if (hipFuncSetAttribute((const void*)mk_fwd, hipFuncAttributeMaxDynamicSharedMemorySize, LDS_BYTES) != hipSuccess) { fprintf(stderr, "kernel_launch: hipFuncSetAttribute failed\n"); grid = -1; return; }
        if (hipOccupancyMaxActiveBlocksPerMultiprocessor(&per_cu, (const void*)mk_fwd, 512, LDS_BYTES) != hipSuccess || per_cu < 1) fprintf(stderr, "kernel_launch: occupancy query reports %d\n", per_cu);
        (void)hipGetLastError();
        grid = cus;
    }
    if (grid < 0) return;
    (void)hipMemsetAsync(d_ws, 0, CTL_BYTES, stream);
    Params P{};
    P.x = (const float*)d_in[0]; P.p = (const float*)d_in[1]; P.pos = (const int*)d_in[2];
    P.norm_mix_g = (const float*)d_in[3]; P.w_in = (const float*)d_in[4]; P.q_norm_g = (const float*)d_in[5]; P.w_uq = (const float*)d_in[6]; P.kv_norm_g = (const float*)d_in[7]; P.w_ukv = (const float*)d_in[8];
    P.conv_w = (const float*)d_in[9]; P.conv_b = (const float*)d_in[10]; P.w_mq = (const float*)d_in[11]; P.w_mk = (const float*)d_in[12]; P.w_mv = (const float*)d_in[13];
    P.b_igate = (const float*)d_in[14]; P.b_fgate = (const float*)d_in[15]; P.mh_norm_g = (const float*)d_in[16]; P.ml_skip = (const float*)d_in[17]; P.w_o = (const float*)d_in[18];
    P.norm_ffn_g = (const float*)d_in[19]; P.w_rg = (const float*)d_in[20]; P.b_rg = (const float*)d_in[21]; P.w_re = (const float*)d_in[22]; P.b_re = (const float*)d_in[23];
    P.w_gate_e = (const float*)d_in[24]; P.w_up_e = (const float*)d_in[25]; P.w_down_e = (const float*)d_in[26]; P.norm_ple_g = (const float*)d_in[27]; P.w_ple = (const float*)d_in[28]; P.w_pg = (const float*)d_in[29]; P.final_g = (const float*)d_in[30];
    P.out = (float*)d_out; P.ws = (unsigned char*)d_ws;
#if DBG_PHASES
    for (int k = 0; k < DBG_PHASES; ++k) { P.ph_lo = k; P.ph_hi = k + 1; hipLaunchKernelGGL(mk_fwd, dim3(grid), dim3(512), LDS_BYTES, stream, P); }
    hipLaunchKernelGGL(dbg_dump, dim3(2048), dim3(256), 0, stream, (const bf16_t*)((unsigned char*)d_ws + DBG_OFF), (float*)d_out);
#elif MK_MULTI
    for (int k = 0; k < NPHASE; ++k) { P.ph_lo = k; P.ph_hi = k + 1; P.sub = 0; hipLaunchKernelGGL(mk_fwd, dim3(grid), dim3(512), LDS_BYTES, stream, P);
        if (k == DUP_PHASE) for (int r = 0; r < DUP_REPS; ++r) { P.sub = DUP_SUB; hipLaunchKernelGGL(mk_fwd, dim3(grid), dim3(512), LDS_BYTES, stream, P); } }
#else
    P.ph_lo = 0; P.ph_hi = NPHASE; hipLaunchKernelGGL(mk_fwd, dim3(grid), dim3(512), LDS_BYTES, stream, P);
#endif
}
```

```cpp
#include <hip/hip_runtime.h>
#include <cstdio>
#include <cstdint>

#ifndef MK_MULTI
#define MK_MULTI 0
#endif

typedef unsigned short bf16_t;
typedef short bf16x8 __attribute__((ext_vector_type(8)));
typedef short s16x4 __attribute__((ext_vector_type(4)));
typedef float f32x4 __attribute__((ext_vector_type(4)));
typedef float f32x16 __attribute__((ext_vector_type(16)));
typedef unsigned u32x4 __attribute__((ext_vector_type(4)));
typedef unsigned u32x2 __attribute__((ext_vector_type(2)));
#define LAS __attribute__((address_space(3)))
typedef LAS const char* lds_cptr;
typedef short v4i16_t __attribute__((ext_vector_type(4)));

constexpr int T_TOK = 32768, DM = 1024, SEQ = 8192, NB = 4;
constexpr int INW = 1448, INWP = 1536;
constexpr int C_CQ = 0, C_CKV = 256, C_KR = 384, C_XM = 416, C_Z = 928, C_IG = 1440;
constexpr int QW = 768, KW = 768, VW = 512;
constexpr int NEXP = 32, DEXP = 256;
constexpr int PROWS = 65536 + 32 * 256;
constexpr float EPS = 1e-6f;
constexpr float QSCALE = 0.10206207261596577f * 1.4426950408889634f;

constexpr size_t MiB = 1ull << 20;
constexpr size_t OFF_BAR = 0;
constexpr size_t OFF_CNT = 16384;
constexpr size_t CTL_BYTES = 32768;
constexpr size_t OFF_WIN = 1 * MiB;
constexpr size_t OFF_WUQ = OFF_WIN + (size_t)INWP * 1024 * 2;
constexpr size_t OFF_WUKV = OFF_WUQ + 768 * 256 * 2;
constexpr size_t OFF_WM = OFF_WUKV + 1024 * 128 * 2;
constexpr size_t OFF_WO = OFF_WM + 12 * 128 * 128 * 2;
constexpr size_t OFF_WR = OFF_WO + 1024 * 1024 * 2;
constexpr size_t OFF_WGU = OFF_WR + 128 * 1024 * 2;
constexpr size_t OFF_WD = OFF_WGU + (size_t)32 * 512 * 1024 * 2;
constexpr size_t OFF_WPLE = OFF_WD + (size_t)32 * 1024 * 256 * 2;
constexpr size_t OFF_WPG = OFF_WPLE + 1024 * 256 * 2;
constexpr size_t OFF_ROPE = OFF_WPG + 1024 * 1024 * 2;
constexpr size_t OFF_PB = OFF_ROPE + (size_t)T_TOK * 32 * 4;
constexpr size_t OFF_GATES = OFF_PB + (size_t)T_TOK * 256 * 2;
constexpr size_t OFF_CSTAT = OFF_GATES + (size_t)T_TOK * 8 * 4;
constexpr size_t OFF_NST = OFF_CSTAT + 2048 * 2 * 4;
constexpr size_t OFF_MST = OFF_NST + 256 * 8 * 128 * 4;
constexpr size_t OFF_TOKREC = OFF_MST + 256 * 8 * 4;
constexpr size_t OFF_LIST = OFF_TOKREC + (size_t)T_TOK * 16;
constexpr size_t OFF_STATIC_END = OFF_LIST + (size_t)32 * T_TOK * 4;
static_assert(OFF_STATIC_END <= 88 * MiB, "static region");
constexpr size_t OFF_PROJ = 88 * MiB;
constexpr size_t OFF_XC = OFF_PROJ + 96 * MiB;
constexpr size_t OFF_MQ = OFF_XC + 32 * MiB;
constexpr size_t OFF_MK = OFF_MQ + 32 * MiB;
constexpr size_t OFF_MV = OFF_MK + 32 * MiB;
constexpr size_t OFF_MIX = OFF_MV + 32 * MiB;
constexpr size_t OFF_XN = OFF_MIX + 64 * MiB;
constexpr size_t OFF_STATE = OFF_XN + 64 * MiB;
constexpr size_t WS_END = OFF_STATE + 64 * MiB;
static_assert(WS_END <= 512 * MiB, "workspace");
constexpr size_t OFF_ACT = OFF_PROJ;
constexpr size_t OFF_Y = OFF_XC;
static_assert(OFF_Y + (size_t)PROWS * 1024 * 2 <= OFF_XN, "y overlay");
constexpr size_t OFF_RES = OFF_STATE;
constexpr size_t OFF_PE = OFF_PROJ;

#define XB_TMO      128
#define XB_XCNT(j)  (256  + 64 * (j))
#define XB_XSUB(j)  (1280 + 64 * (j))
#define XB_XGEN(j)  (2304 + 64 * (j))
#define XB_TOP      3328
#define XB_TOPGEN   3392
#define XCD_BAR_WORDS 3456
#define XB_SPIN_CAP (1u << 18)

__device__ __forceinline__ unsigned xb_ld(unsigned* p)              { return __hip_atomic_load(p, __ATOMIC_RELAXED, __HIP_MEMORY_SCOPE_AGENT); }
__device__ __forceinline__ unsigned xb_add(unsigned* p, unsigned v) { return __hip_atomic_fetch_add(p, v, __ATOMIC_RELAXED, __HIP_MEMORY_SCOPE_AGENT); }
__device__ __forceinline__ unsigned xb_xcc_id() { return (unsigned)__builtin_amdgcn_s_getreg((3 << 11) | 20) & 0xFu; }
#define XB_SPIN(cond, bar) do { unsigned _sp = 0; while (cond) { __builtin_amdgcn_s_sleep(1); \
    if ((++_sp & 255u) == 0u) { if (xb_ld(&(bar)[XB_TMO])) break; if (_sp > XB_SPIN_CAP) { atomicAdd(&(bar)[XB_TMO], 1u); break; } } } } while (0)

struct XcdBarrier { unsigned* bar; unsigned x; volatile LAS unsigned* st; };

__device__ __forceinline__ XcdBarrier xcd_barrier_post(unsigned* bar, volatile LAS unsigned* st) {
    XcdBarrier b; b.bar = bar; b.x = xb_xcc_id(); b.st = st;
    if (threadIdx.x == 0) (void)xb_add(&bar[XB_XCNT(b.x)], 1u);
    return b;
}
__device__ __forceinline__ void xcd_barrier_complete(unsigned* bar, unsigned x, unsigned& nloc, unsigned& nx) {
    const unsigned G = gridDim.x * gridDim.y * gridDim.z;
    unsigned sum, cnt, mine, sp = 0u;
    for (;;) {
        sum = 0u; cnt = 0u; mine = 0u;
#pragma unroll
        for (unsigned j = 0; j < 16; ++j) { const unsigned c = xb_ld(&bar[XB_XCNT(j)]); sum += c; cnt += (c > 0u) ? 1u : 0u; mine = (j == x) ? c : mine; }
        if (sum == G) break;
        __builtin_amdgcn_s_sleep(1);
        if ((++sp & 255u) == 0u) { if (xb_ld(&bar[XB_TMO])) break; if (sp > XB_SPIN_CAP) { atomicAdd(&bar[XB_TMO], 1u); break; } }
    }
    nloc = mine > 0u ? mine : 1u; nx = cnt > 0u ? cnt : 1u;
}
__device__ __forceinline__ void xcd_barrier(const XcdBarrier& b) {
    asm volatile("s_waitcnt vmcnt(0)" ::: "memory");
    __syncthreads();
    if (threadIdx.x == 0) {
        unsigned* bar = b.bar;
        __builtin_amdgcn_s_waitcnt(0);
        unsigned nloc = b.st[0], nx = b.st[1];
        if (nloc == 0u) { xcd_barrier_complete(bar, b.x, nloc, nx); b.st[0] = nloc; b.st[1] = nx; }
        const unsigned old = xb_add(&bar[XB_XSUB(b.x)], 1u);
        const unsigned gen = old / nloc;
        if (old + 1u == (gen + 1u) * nloc) {
            __builtin_amdgcn_fence(__ATOMIC_RELEASE, "agent");
            asm volatile("s_waitcnt vmcnt(0)" ::: "memory");
            const unsigned og = xb_add(&bar[XB_TOP], 1u);
            const unsigned tg = og / nx;
            if (og + 1u == (tg + 1u) * nx) xb_add(&bar[XB_TOPGEN], 1u);
            else XB_SPIN(xb_ld(&bar[XB_TOPGEN]) == tg, bar);
            __builtin_amdgcn_fence(__ATOMIC_ACQUIRE, "agent");
            xb_add(&bar[XB_XGEN(b.x)], 1u);
            asm volatile("s_waitcnt vmcnt(0)" ::: "memory");
        } else {
            XB_SPIN(xb_ld(&bar[XB_XGEN(b.x)]) == gen, bar);
            __builtin_amdgcn_fence(__ATOMIC_ACQUIRE, "agent");
            asm volatile("s_waitcnt vmcnt(0)" ::: "memory");
        }
    }
    __syncthreads();
}

typedef __bf16 bf16x2_t __attribute__((ext_vector_type(2)));
typedef float f32x2 __attribute__((ext_vector_type(2)));
__device__ __forceinline__ unsigned cvtpk(float lo, float hi) { f32x2 v = {lo, hi}; bf16x2_t b = __builtin_convertvector(v, bf16x2_t); return __builtin_bit_cast(unsigned, b); }
__device__ __forceinline__ float bf2f(unsigned short v) { return __uint_as_float((unsigned)v << 16); }
__device__ __forceinline__ float bflo(unsigned w) { return __uint_as_float(w << 16); }
__device__ __forceinline__ float bfhi(unsigned w) { return __uint_as_float(w & 0xffff0000u); }
__device__ __forceinline__ void st4bf(bf16_t* p, f32x4 v) { u32x2 w; w.x = cvtpk(v[0], v[1]); w.y = cvtpk(v[2], v[3]); *(u32x2*)p = w; }
__device__ __forceinline__ float wsum(float v) {
#pragma unroll
    for (int o = 32; o > 0; o >>= 1) v += __shfl_xor(v, o);
    return v; }
__device__ __forceinline__ float wmax(float v) {
#pragma unroll
    for (int o = 32; o > 0; o >>= 1) v = fmaxf(v, __shfl_xor(v, o));
    return v; }
__device__ __forceinline__ float siluf(float v) { return v / (1.f + __expf(-v)); }
__device__ __forceinline__ float sigmf(float v) { return 1.f / (1.f + __expf(-v)); }
__device__ __forceinline__ void glds16(const void* g, unsigned lds_base) {
    unsigned sv; asm volatile("s_mov_b32 %0, m0\n\ts_mov_b32 m0, %2\n\ts_nop 0\n\tglobal_load_lds_dwordx4 %1, off\n\ts_mov_b32 m0, %0" : "=&s"(sv) : "v"(g), "s"(lds_base) : "memory"); }
__device__ __forceinline__ const void* rfl_ptr(const void* p) { const unsigned long long v = (unsigned long long)p; const unsigned lo = __builtin_amdgcn_readfirstlane((unsigned)v), hi = __builtin_amdgcn_readfirstlane((unsigned)(v >> 32)); return (const void*)(((unsigned long long)hi << 32) | lo); }
__device__ __forceinline__ void glds16s(const void* sbase, unsigned voff, unsigned lds_base) {
    unsigned sv; asm volatile("s_mov_b32 %0, m0\n\ts_mov_b32 m0, %3\n\ts_nop 0\n\tglobal_load_lds_dwordx4 %1, %2\n\ts_mov_b32 m0, %0" : "=&s"(sv) : "v"(voff), "s"(sbase), "s"(lds_base) : "memory"); }
#define RFL(x) __builtin_amdgcn_readfirstlane(x)
#define MFMA16(a, b, c) __builtin_amdgcn_mfma_f32_16x16x32_bf16(a, b, c, 0, 0, 0)
#define MFMA32(a, b, c) __builtin_amdgcn_mfma_f32_32x32x16_bf16(a, b, c, 0, 0, 0)
#define WAITVM0() asm volatile("s_waitcnt vmcnt(0)" ::: "memory")
#define WAITLGKM0() asm volatile("s_waitcnt lgkmcnt(0)" ::: "memory")
__device__ __forceinline__ int crow(int r, int hi) { return (r & 3) + 8 * (r >> 2) + 4 * hi; }
__device__ __forceinline__ s16x4 vtr(lds_cptr p) { return __builtin_bit_cast(s16x4, __builtin_amdgcn_ds_read_tr16_b64_v4i16((LAS v4i16_t*)p)); }
__device__ __forceinline__ bf16x8 cat8(s16x4 a, s16x4 b) { return (bf16x8){a[0], a[1], a[2], a[3], b[0], b[1], b[2], b[3]}; }

__device__ __forceinline__ int xcd_slot() { const int G = gridDim.x, b = blockIdx.x; return (G & 7) ? b : (b & 7) * (G >> 3) + (b >> 3); }
struct Params {
    const float* x; const float* p; const int* pos;
    const float *norm_mix_g, *w_in, *q_norm_g, *w_uq, *kv_norm_g, *w_ukv, *conv_w, *conv_b, *w_mq, *w_mk, *w_mv, *b_igate, *b_fgate,
                *mh_norm_g, *ml_skip, *w_o, *norm_ffn_g, *w_rg, *b_rg, *w_re, *b_re, *w_gate_e, *w_up_e, *w_down_e, *norm_ple_g, *w_ple, *w_pg, *final_g;
    float* out; unsigned char* ws; int ph_lo, ph_hi, sub, pad;
};

constexpr int G_STAGE = 49152;
constexpr int LDS_GEMM = 2 * G_STAGE;
struct GDesc { const bf16_t* a0; const bf16_t* a1; const int* gather; const bf16_t* bt; int ld0, ld1, ksplit, m0, nvalid, ldb, nk; };
__device__ __forceinline__ GDesc gdesc(const bf16_t* a, int lda, int m0, const bf16_t* bt, int ldb, int nk) {
    GDesc d; d.a0 = a; d.a1 = a; d.gather = nullptr; d.bt = bt; d.ld0 = lda; d.ld1 = lda; d.ksplit = 1 << 30; d.m0 = m0; d.nvalid = 0; d.ldb = ldb; d.nk = nk; return d; }
template <int MT> __device__ __forceinline__ void g_rows(const GDesc& d, int (&rows)[MT]) {
    const int lane = threadIdx.x & 63, wid = RFL(threadIdx.x >> 6);
#pragma unroll
    for (int i = 0; i < MT; ++i) { const int r = i * 64 + wid * 8 + (lane >> 3); rows[i] = d.gather ? (r < d.nvalid ? d.gather[r] : 0) : d.m0 + r; }
}
template <int MT> __device__ __forceinline__ void g_stage(const GDesc& d, const int (&rows)[MT], int kt, int buf, unsigned lds0) {
    const int lane = threadIdx.x & 63, wid = RFL(threadIdx.x >> 6); const int cch = (lane & 7) ^ (lane >> 3);
    const bf16_t* ab = d.a0; int ld = d.ld0, kk = kt;
    if (kt >= d.ksplit) { ab = d.a1; ld = d.ld1; kk = kt - d.ksplit; }
#pragma unroll
    for (int i = 0; i < MT; ++i) glds16(ab + (size_t)rows[i] * ld + kk * 64 + cch * 8, RFL(lds0 + buf * G_STAGE + i * 8192 + wid * 1024));
    const bf16_t* bp = d.bt + (size_t)(wid * 8 + (lane >> 3)) * d.ldb + cch * 8 + kt * 64;
    glds16(bp, RFL(lds0 + buf * G_STAGE + 32768 + wid * 1024));
    glds16(bp + (size_t)64 * d.ldb, RFL(lds0 + buf * G_STAGE + 32768 + 8192 + wid * 1024));
}
template <int MT> __device__ __forceinline__ void g_compute(f32x4 (&acc)[MT][4], const char* sa) {
    const int lane = threadIdx.x & 63, wid = RFL(threadIdx.x >> 6), wr = wid >> 1, wc = wid & 1, fr = lane & 15, fq = lane >> 4;
    const char* sb = sa + 32768;
#pragma unroll
    for (int kk = 0; kk < 2; ++kk) {
        bf16x8 af[MT], bfr[4];
        const int sw = ((4 * kk + fq) ^ (fr & 7)) << 4;
#pragma unroll
        for (int m = 0; m < MT; ++m) af[m] = *(const bf16x8*)(sa + (wr * 16 * MT + 16 * m + fr) * 128 + sw);
#pragma unroll
        for (int n = 0; n < 4; ++n) bfr[n] = *(const bf16x8*)(sb + (wc * 64 + 16 * n + fr) * 128 + sw);
#pragma unroll
        for (int m = 0; m < MT; ++m)
#pragma unroll
            for (int n = 0; n < 4; ++n) acc[m][n] = MFMA16(bfr[n], af[m], acc[m][n]);
    }
}
template <int MT, class DescFn, class EpiFn>
__device__ __forceinline__ void gemm_tiles(int ntiles, DescFn df, EpiFn ef, char* lds) {
    if (ntiles <= 0) return;
    const unsigned lds0 = (unsigned)(uintptr_t)lds;
    GDesc d = df(0); int rows[MT]; g_rows<MT>(d, rows);
    int cur = 0;
    __syncthreads();
    g_stage<MT>(d, rows, 0, 0, lds0);
    for (int t = 0; t < ntiles; ++t) {
        const bool hn = t + 1 < ntiles; GDesc dn = d; int rowsn[MT];
#pragma unroll
        for (int i = 0; i < MT; ++i) rowsn[i] = rows[i];
        if (hn) { dn = df(t + 1); g_rows<MT>(dn, rowsn); }
        f32x4 acc[MT][4];
#pragma unroll
        for (int m = 0; m < MT; ++m)
#pragma unroll
            for (int n = 0; n < 4; ++n) acc[m][n] = (f32x4){0.f, 0.f, 0.f, 0.f};
        for (int kt = 0; kt < d.nk; ++kt) {
            WAITVM0(); __syncthreads();
            if (kt + 1 < d.nk) g_stage<MT>(d, rows, kt + 1, cur ^ 1, lds0); else if (hn) g_stage<MT>(dn, rowsn, 0, cur ^ 1, lds0);
            g_compute<MT>(acc, lds + cur * G_STAGE); cur ^= 1;
        }
        ef(t, acc);
        d = dn;
#pragma unroll
        for (int i = 0; i < MT; ++i) rows[i] = rowsn[i];
    }
}
template <int NF> struct G2C { static constexpr int BN = 64 * NF, A_BYTES = 16384, B_BYTES = BN * 64, STAGE = A_BYTES + B_BYTES, DPS = 2 + NF / 2; };
template <int NF> __device__ __forceinline__ void g2_offs(const GDesc& d, unsigned (&ao)[2], unsigned (&bo)[NF / 2]) {
    const int lane = threadIdx.x & 63, wid = RFL(threadIdx.x >> 6); const unsigned cch = (unsigned)((lane & 3) ^ ((0 - (lane >> 4)) & 3)) * 16u;
#pragma unroll
    for (int i = 0; i < 2; ++i) { const int r = 16 * (i * 8 + wid) + (lane >> 2); const int gr = d.gather ? (r < d.nvalid ? d.gather[r] : 0) : d.m0 + r; ao[i] = (unsigned)gr * (unsigned)(d.ld0 * 2) + cch; }
#pragma unroll
    for (int i = 0; i < NF / 2; ++i) bo[i] = (unsigned)(16 * (i * 8 + wid) + (lane >> 2)) * (unsigned)(d.ldb * 2) + cch;
}
template <int NF> __device__ __forceinline__ void g2_piece(const GDesc& d, const unsigned (&ao)[2], const unsigned (&bo)[NF / 2], int kt, int slot, unsigned lds0, int p) {
    const int wid = RFL(threadIdx.x >> 6);
    const unsigned sb = lds0 + slot * G2C<NF>::STAGE;
    if (p < 2) { const bf16_t* ab = d.a0; int kk = kt;
        if (kt >= d.ksplit) { ab = d.a1; kk = kt - d.ksplit; }
        glds16s(rfl_ptr(ab + kk * 32), ao[p], RFL(sb + (p * 8 + wid) * 1024));
    } else { const int i = p - 2; glds16s(rfl_ptr(d.bt + kt * 32), bo[i], RFL(sb + 16384 + (i * 8 + wid) * 1024)); }
}
template <int N> __device__ __forceinline__ void waitvm() { asm volatile("s_waitcnt vmcnt(%0)" :: "n"(N) : "memory"); }
template <int NF, class DescFn, class EpiFn>
__device__ __forceinline__ void gemm2_tiles(int ntiles, DescFn df, EpiFn ef, char* lds, int dbg = 0) {
    if (ntiles <= 0) return;
    constexpr int DPS = G2C<NF>::DPS, STG = G2C<NF>::STAGE;
    const unsigned lds0 = (unsigned)(uintptr_t)lds;
    const int lane = threadIdx.x & 63, wid = RFL(threadIdx.x >> 6), wr2 = wid >> 2, wc4 = wid & 3, fr = lane & 15, fq = lane >> 4;
    const int sw = (fq ^ ((0 - (fr >> 2)) & 3)) << 4;
    const int aoff = (wr2 * 128 + fr) * 64 + sw, boff = 16384 + (wc4 * 16 * NF + fr) * 64 + sw;
    GDesc dc = df(0), di = dc; unsigned ao[2], bo[NF / 2]; g2_offs<NF>(di, ao, bo);
    int ti = 0, ki = 0, issued = 0, done = 0;
    auto advance = [&]() { ++issued; ++ki; if (ki == di.nk) { ++ti; ki = 0; if (ti < ntiles) { di = df(ti); g2_offs<NF>(di, ao, bo); } } };
#define G2_BAR() do { if (!(dbg & 16)) asm volatile("s_waitcnt lgkmcnt(0)\n\ts_barrier" ::: "memory"); } while (0)
#define G2_WAIT(need) do { const int fly_ = issued - (need) - 1; if (fly_ >= 2) waitvm<2 * DPS>(); else if (fly_ == 1) waitvm<DPS>(); else waitvm<0>(); } while (0)
    __syncthreads();
    for (int q = 0; q < 3; ++q) if (ti < ntiles) {
#pragma unroll
        for (int p = 0; p < DPS; ++p) g2_piece<NF>(di, ao, bo, ki, issued & 3, lds0, p);
        advance(); }
    if (wr2) { G2_WAIT(0); G2_BAR(); }
    bf16x8 fa[8], fb[NF];
    for (int t = 0; t < ntiles; ++t) {
        f32x4 acc[8][NF];
#pragma unroll
        for (int m = 0; m < 8; ++m)
#pragma unroll
            for (int n = 0; n < NF; ++n) acc[m][n] = (f32x4){0.f, 0.f, 0.f, 0.f};
        const int nk = dc.nk;
        for (int kt = 0; kt < nk; ++kt) {
            if (!wr2) G2_WAIT(done);
            G2_BAR();
            { const char* sc = lds + (done & 3) * STG; const bool doi = ti < ntiles && !(dbg & 2); const int islot = issued & 3;
#pragma unroll
              for (int n = 0; n < NF; ++n) fb[n] = *(const bf16x8*)(sc + boff + n * 1024);
#pragma unroll
              for (int m = 0; m < 8; ++m) { fa[m] = *(const bf16x8*)(sc + aoff + m * 1024);
                  if ((m & 1) && (m >> 1) < DPS) { if (doi) g2_piece<NF>(di, ao, bo, ki, islot, lds0, m >> 1); } }
              if (ti < ntiles) advance(); }
            if (wr2) G2_WAIT(done + 1);
            G2_BAR();
            __builtin_amdgcn_s_setprio(1);
            if (!(dbg & 1)) {
#pragma unroll
            for (int m = 0; m < 8; ++m)
#pragma unroll
                for (int n = 0; n < NF; ++n) acc[m][n] = MFMA16(fb[n], fa[m], acc[m][n]); }
            __builtin_amdgcn_s_setprio(0);
            ++done;
        }
        if (!(dbg & 4)) ef(t, acc);
        if (t + 1 < ntiles) dc = (ti == t + 1) ? di : df(t + 1);
    }
    if (!wr2) G2_BAR();
#undef G2_BAR
#undef G2_WAIT
}

namespace g8 {
constexpr int BM = 256, BK = 64, HALF = 128, HTB = HALF * BK * 2;
__device__ __forceinline__ int lds_byte(int r, int c) { const int st = (r >> 4) * 2 + (c >> 5), rr = r & 15, cc = c & 31, ob = rr * 64 + cc * 2; return st * 1024 + (ob ^ (((ob >> 9) & 1) << 5)); }
__device__ __forceinline__ void stage_rc(int b, int& R, int& C) { const int st = b / 1024, sb = b % 1024, swz = sb ^ (((sb >> 9) & 1) << 5); R = (st >> 1) * 16 + swz / 64; C = (st & 1) * 32 + (swz % 64) / 2; }
struct Unit { const char* A; const char* B; const int* gather; int nvalid, K, i0, i1, i2; };
__device__ __forceinline__ void offs(const Unit& u, unsigned (&va)[2][2], unsigned (&vb)[2]) {
#pragma unroll
    for (int i = 0; i < 2; ++i) { int R, C; stage_rc(threadIdx.x * 16 + i * 8192, R, C);
        vb[i] = (unsigned)(R * u.K + C) * 2u;
#pragma unroll
        for (int h = 0; h < 2; ++h) { const int r = h * HALF + R; const int gr = u.gather ? (r < u.nvalid ? u.gather[r] : 0) : r; va[h][i] = (unsigned)(gr * u.K + C) * 2u; } }
}
template <class NextFn, class EpiFn>
__device__ __forceinline__ void phase(LAS unsigned char* lds, NextFn next, EpiFn epi) {
    const int tid = threadIdx.x, wid = __builtin_amdgcn_readfirstlane(tid >> 6), lane = tid & 63, wr = wid >> 2, wc = wid & 3, fr = lane & 15, fq = lane >> 4;
    const unsigned ldsw = (unsigned)wid * 1024u;
    const int aoff = lds_byte(wr * 64 + fr, fq * 8), boff = lds_byte(wc * 32 + fr, fq * 8);
#define G8_SA(b, h) (((b) * 2 + (h)) * HTB)
#define G8_SB(b, h) ((4 + (b) * 2 + (h)) * HTB)
#define G8_STAGE(bufoff, gbase, voff) do { _Pragma("unroll") for (int _i = 0; _i < 2; ++_i) \
        __builtin_amdgcn_global_load_lds((const unsigned*)((const char*)(gbase) + (voff)[_i]), (LAS unsigned*)(lds + (bufoff) + ldsw + _i * 8192), 16, 0, 0); } while (0)
#define G8_LDA(dst, b, h) do { _Pragma("unroll") for (int m = 0; m < 4; ++m) _Pragma("unroll") for (int k = 0; k < 2; ++k) dst[m][k] = *(const LAS bf16x8*)(lds + G8_SA(b, h) + aoff + m * 2048 + k * 1024); } while (0)
#define G8_LDB(dst, b, h) do { _Pragma("unroll") for (int n = 0; n < 2; ++n) _Pragma("unroll") for (int k = 0; k < 2; ++k) dst[n][k] = *(const LAS bf16x8*)(lds + G8_SB(b, h) + boff + n * 2048 + k * 1024); } while (0)
#define G8_MMA(ai, bj, At, Bt) do { __builtin_amdgcn_s_setprio(1); _Pragma("unroll") for (int m = 0; m < 4; ++m) _Pragma("unroll") for (int n = 0; n < 2; ++n) _Pragma("unroll") for (int k = 0; k < 2; ++k) \
        acc[ai][bj][m][n] = __builtin_amdgcn_mfma_f32_16x16x32_bf16(Bt[n][k], At[m][k], acc[ai][bj][m][n], 0, 0, 0); __builtin_amdgcn_s_setprio(0); } while (0)
#define G8_WAIT_V(n) asm volatile("s_waitcnt vmcnt(" #n ")" ::: "memory")
#define G8_WAIT_L(n) asm volatile("s_waitcnt lgkmcnt(" #n ")" ::: "memory")
#define G8_BAR __builtin_amdgcn_s_barrier()
#define G8_SCHED __builtin_amdgcn_sched_barrier(0)
    Unit cur, nxt; int ui = 0;
    if (!next(0, cur)) return;
    f32x4 acc[2][2][4][2];
#pragma unroll
    for (int a = 0; a < 2; ++a)
#pragma unroll
        for (int b = 0; b < 2; ++b)
#pragma unroll
            for (int m = 0; m < 4; ++m)
#pragma unroll
                for (int n = 0; n < 2; ++n) acc[a][b][m][n] = (f32x4){0.f, 0.f, 0.f, 0.f};
    bf16x8 At[4][2], B0[2][2], B1[2][2];
    unsigned vaC[2][2], vbC[2], vaN[2][2], vbN[2];
    offs(cur, vaC, vbC);
    const size_t kstep = (size_t)(BK * 2);
    __syncthreads();
    { const char* cA = cur.A; const char* cB = cur.B; const size_t hsB = (size_t)HALF * cur.K * 2;
      G8_STAGE(G8_SB(0, 0), cB, vbC); G8_STAGE(G8_SA(0, 0), cA, vaC[0]); G8_STAGE(G8_SB(0, 1), cB + hsB, vbC); G8_STAGE(G8_SA(0, 1), cA, vaC[1]);
      if (wr == 1) G8_BAR;
      G8_WAIT_V(4); G8_BAR;
      G8_STAGE(G8_SB(1, 0), cB + kstep, vbC); G8_STAGE(G8_SA(1, 0), cA + kstep, vaC[0]); G8_STAGE(G8_SB(1, 1), cB + hsB + kstep, vbC);
      G8_WAIT_V(6); G8_BAR; }
    for (;;) {
        const bool has_next = next(ui + 1, nxt);
        if (has_next) offs(nxt, vaN, vbN);
        else {
#pragma unroll
            for (int i = 0; i < 2; ++i) { vbN[i] = vbC[i]; vaN[0][i] = vaC[0][i]; vaN[1][i] = vaC[1][i]; } }
        const char* cA = cur.A; const char* cB = cur.B; const size_t hsB = (size_t)HALF * cur.K * 2;
        const char* nA = has_next ? nxt.A : cA; const char* nB = has_next ? nxt.B : cB; const size_t hsN = has_next ? (size_t)HALF * nxt.K * 2 : hsB;
        const int nt = cur.K / BK;
        for (int t = 0; t < nt; t += 2) {
            const bool last = (t == nt - 2);
            const char* a1 = cA + (size_t)(t + 1) * kstep;
            const char* a2 = last ? nA : cA + (size_t)(t + 2) * kstep; const char* b2 = last ? nB : cB + (size_t)(t + 2) * kstep;
            const char* a3 = a2 + kstep; const char* b3 = b2 + kstep; const size_t hs2 = last ? hsN : hsB;
            unsigned va2[2][2], vb2[2];
#pragma unroll
            for (int i = 0; i < 2; ++i) { vb2[i] = last ? vbN[i] : vbC[i]; va2[0][i] = last ? vaN[0][i] : vaC[0][i]; va2[1][i] = last ? vaN[1][i] : vaC[1][i]; }
            G8_LDB(B0, 0, 0); G8_SCHED; G8_LDA(At, 0, 0); G8_STAGE(G8_SA(1, 1), a1, vaC[1]);
            G8_WAIT_L(8); G8_BAR; G8_WAIT_L(0); G8_MMA(0, 0, At, B0); G8_BAR; G8_SCHED;
            G8_LDB(B1, 0, 1); G8_STAGE(G8_SB(0, 0), b2, vb2);
            G8_BAR; G8_WAIT_L(0); G8_MMA(0, 1, At, B1); G8_BAR;
            G8_LDA(At, 0, 1); G8_STAGE(G8_SA(0, 0), a2, va2[0]);
            G8_BAR; G8_WAIT_L(0); G8_MMA(1, 0, At, B0); G8_BAR; G8_SCHED;
            G8_STAGE(G8_SB(0, 1), b2 + hs2, vb2);
            G8_WAIT_V(6); G8_BAR; G8_MMA(1, 1, At, B1); G8_BAR;
            G8_LDB(B0, 1, 0); G8_SCHED; G8_LDA(At, 1, 0); G8_STAGE(G8_SA(0, 1), a2, va2[1]);
            G8_WAIT_L(8); G8_BAR; G8_WAIT_L(0); G8_MMA(0, 0, At, B0); G8_BAR; G8_SCHED;
            G8_LDB(B1, 1, 1); G8_STAGE(G8_SB(1, 0), b3, vb2);
            G8_BAR; G8_WAIT_L(0); G8_MMA(0, 1, At, B1); G8_BAR;
            G8_LDA(At, 1, 1); G8_STAGE(G8_SA(1, 0), a3, va2[0]);
            G8_BAR; G8_WAIT_L(0); G8_MMA(1, 0, At, B0); G8_BAR; G8_SCHED;
            G8_STAGE(G8_SB(1, 1), b3 + hs2, vb2);
            G8_WAIT_V(6); G8_BAR; G8_MMA(1, 1, At, B1); G8_BAR;
        }
        epi(acc, cur, wr, wc, fr, fq);
        if (!has_next) break;
#pragma unroll
        for (int a = 0; a < 2; ++a)
#pragma unroll
            for (int b = 0; b < 2; ++b)
#pragma unroll
                for (int m = 0; m < 4; ++m)
#pragma unroll
                    for (int n = 0; n < 2; ++n) acc[a][b][m][n] = (f32x4){0.f, 0.f, 0.f, 0.f};
        cur = nxt; ++ui;
#pragma unroll
        for (int i = 0; i < 2; ++i) { vbC[i] = vbN[i]; vaC[0][i] = vaN[0][i]; vaC[1][i] = vaN[1][i]; }
    }
    G8_WAIT_V(0);
    if (wr == 0) G8_BAR;
    G8_BAR;
#undef G8_SA
#undef G8_SB
#undef G8_STAGE
#undef G8_LDA
#undef G8_LDB
#undef G8_MMA
#undef G8_WAIT_V
#undef G8_WAIT_L
#undef G8_BAR
#undef G8_SCHED
}
}


__device__ __forceinline__ void ld_row_bf16(const bf16_t* r, int lane, f32x4 (&a)[4]) {
    const u32x4 lo = *(const u32x4*)(r + lane * 8), hi = *(const u32x4*)(r + 512 + lane * 8);
    a[0] = (f32x4){bflo(lo[0]), bfhi(lo[0]), bflo(lo[1]), bfhi(lo[1])}; a[1] = (f32x4){bflo(lo[2]), bfhi(lo[2]), bflo(lo[3]), bfhi(lo[3])};
    a[2] = (f32x4){bflo(hi[0]), bfhi(hi[0]), bflo(hi[1]), bfhi(hi[1])}; a[3] = (f32x4){bflo(hi[2]), bfhi(hi[2]), bflo(hi[3]), bfhi(hi[3])}; }
__device__ __forceinline__ void st_row_bf16(bf16_t* r, int lane, const f32x4 (&a)[4]) {
    u32x4 lo, hi; lo[0] = cvtpk(a[0][0], a[0][1]); lo[1] = cvtpk(a[0][2], a[0][3]); lo[2] = cvtpk(a[1][0], a[1][1]); lo[3] = cvtpk(a[1][2], a[1][3]);
    hi[0] = cvtpk(a[2][0], a[2][1]); hi[1] = cvtpk(a[2][2], a[2][3]); hi[2] = cvtpk(a[3][0], a[3][1]); hi[3] = cvtpk(a[3][2], a[3][3]);
    *(u32x4*)(r + lane * 8) = lo; *(u32x4*)(r + 512 + lane * 8) = hi; }
__device__ __forceinline__ void norm_row_store(const f32x4& a0, const f32x4& a1, const f32x4& a2, const f32x4& a3, const float* g, int lane, bf16_t* dst) {
    float ss = 0.f;
#pragma unroll
    for (int e = 0; e < 4; ++e) ss += a0[e] * a0[e] + a1[e] * a1[e] + a2[e] * a2[e] + a3[e] * a3[e];
    ss = wsum(ss); const float r = rsqrtf(ss * (1.0f / DM) + EPS);
    const f32x4 g0 = *(const f32x4*)(g + lane * 8), g1 = *(const f32x4*)(g + lane * 8 + 4), g2 = *(const f32x4*)(g + 512 + lane * 8), g3 = *(const f32x4*)(g + 512 + lane * 8 + 4);
    u32x4 w0, w1;
    w0.x = cvtpk(a0[0] * r * g0[0], a0[1] * r * g0[1]); w0.y = cvtpk(a0[2] * r * g0[2], a0[3] * r * g0[3]); w0.z = cvtpk(a1[0] * r * g1[0], a1[1] * r * g1[1]); w0.w = cvtpk(a1[2] * r * g1[2], a1[3] * r * g1[3]);
    w1.x = cvtpk(a2[0] * r * g2[0], a2[1] * r * g2[1]); w1.y = cvtpk(a2[2] * r * g2[2], a2[3] * r * g2[3]); w1.z = cvtpk(a3[0] * r * g3[0], a3[1] * r * g3[1]); w1.w = cvtpk(a3[2] * r * g3[2], a3[3] * r * g3[3]);
    *(u32x4*)(dst + lane * 8) = w0; *(u32x4*)(dst + 512 + lane * 8) = w1;
}

__device__ __forceinline__ void tr_tile(const float* src, int N, int k0, int n0, bf16_t* dst, int ldd, int mode, float scale, const float* kgain, float* tile) {
    const int tid = threadIdx.x;
    __syncthreads();
#pragma unroll
    for (int i = 0; i < 8; ++i) { const int idx = tid + 512 * i, kk = idx >> 6, nn = idx & 63;
        float v = 0.f; if (n0 + nn < N) v = src[(size_t)(k0 + kk) * N + n0 + nn];
        if (kgain) v *= kgain[k0 + kk];
        tile[kk * 65 + nn] = v * scale; }
    __syncthreads();
#pragma unroll
    for (int i = 0; i < 8; ++i) { const int idx = tid + 512 * i, nn = idx >> 6, kk = idx & 63; const int n = n0 + nn;
        if (n < N) { int r = n; if (mode) r = (n >> 7) * 256 + (mode - 1) * 128 + (n & 127);
            dst[(size_t)r * ldd + k0 + kk] = (bf16_t)(cvtpk(tile[kk * 65 + nn], 0.f) & 0xffffu); } }
}

__device__ __forceinline__ void phase_prep(const Params& P, char* lds) {
    unsigned char* ws = P.ws; float* tile = (float*)lds;
    const int bid = blockIdx.x, nb = gridDim.x, tid = threadIdx.x;
    const int NJ = 12;
    const int cnt[NJ] = {16 * 23, 4 * 12, 2 * 16, 12 * 4, 256, 2048, 2048, 2048, 64, 256, 16, 16};
    int total = 0;
#pragma unroll
    for (int j = 0; j < NJ; ++j) total += cnt[j];
    for (int u = bid; u < total; u += nb) {
        int j = 0, r = u;
#pragma unroll
        for (int jj = 0; jj < NJ - 1; ++jj) if (j == jj && r >= cnt[jj]) { r -= cnt[jj]; j = jj + 1; }
        switch (j) {
        case 0: tr_tile(P.w_in, INW, (r / 23) * 64, (r % 23) * 64, (bf16_t*)(ws + OFF_WIN), 1024, 0, 1.f, nullptr, tile); break;
        case 1: tr_tile(P.w_uq, 768, (r / 12) * 64, (r % 12) * 64, (bf16_t*)(ws + OFF_WUQ), 256, 0, 1.f, P.q_norm_g, tile); break;
        case 2: tr_tile(P.w_ukv, 1024, (r / 16) * 64, (r % 16) * 64, (bf16_t*)(ws + OFF_WUKV), 128, 0, 1.f, P.kv_norm_g, tile); break;
        case 3: { const int mat = r >> 2, t4 = r & 3, kind = mat >> 2, h = mat & 3; const float* s = (kind == 0 ? P.w_mq : kind == 1 ? P.w_mk : P.w_mv) + h * 16384;
                  tr_tile(s, 128, (t4 >> 1) * 64, (t4 & 1) * 64, (bf16_t*)(ws + OFF_WM) + mat * 16384, 128, 0, kind == 1 ? 0.08838834764831845f : 1.f, nullptr, tile); } break;
        case 4: tr_tile(P.w_o, 1024, (r >> 4) * 64, (r & 15) * 64, (bf16_t*)(ws + OFF_WO), 1024, 0, 1.f, nullptr, tile); break;
        case 5: { const int e = r >> 6, t6 = r & 63; tr_tile(P.w_gate_e + (size_t)e * 1024 * 256, 256, (t6 >> 2) * 64, (t6 & 3) * 64, (bf16_t*)(ws + OFF_WGU) + (size_t)e * 512 * 1024, 1024, 1, 1.f, nullptr, tile); } break;
        case 6: { const int e = r >> 6, t6 = r & 63; tr_tile(P.w_up_e + (size_t)e * 1024 * 256, 256, (t6 >> 2) * 64, (t6 & 3) * 64, (bf16_t*)(ws + OFF_WGU) + (size_t)e * 512 * 1024, 1024, 2, 1.f, nullptr, tile); } break;
        case 7: { const int e = r >> 6, t6 = r & 63; tr_tile(P.w_down_e + (size_t)e * 256 * 1024, 1024, (t6 >> 4) * 64, (t6 & 15) * 64, (bf16_t*)(ws + OFF_WD) + (size_t)e * 1024 * 256, 256, 0, 1.f, nullptr, tile); } break;
        case 8: tr_tile(P.w_ple, 1024, (r >> 4) * 64, (r & 15) * 64, (bf16_t*)(ws + OFF_WPLE), 256, 0, 1.f, nullptr, tile); break;
        case 9: tr_tile(P.w_pg, 1024, (r >> 4) * 64, (r & 15) * 64, (bf16_t*)(ws + OFF_WPG), 1024, 0, 1.f, nullptr, tile); break;
        case 10: tr_tile(P.w_rg, 4, r * 64, 0, (bf16_t*)(ws + OFF_WR), 1024, 0, 1.f, nullptr, tile); break;
        default: tr_tile(P.w_re, 32, r * 64, 0, (bf16_t*)(ws + OFF_WR) + 4 * 1024, 1024, 0, 1.f, nullptr, tile); break;
        }
    }
    { u32x4 z = (u32x4){0u, 0u, 0u, 0u};
      u32x4* a = (u32x4*)((bf16_t*)(ws + OFF_WIN) + (size_t)INW * 1024); const int na = (INWP - INW) * 1024 / 8;
      for (int i = bid * 512 + tid; i < na; i += nb * 512) a[i] = z;
      u32x4* b = (u32x4*)((bf16_t*)(ws + OFF_WR) + 36 * 1024); const int nbz = (128 - 36) * 1024 / 8;
      for (int i = bid * 512 + tid; i < nbz; i += nb * 512) b[i] = z; }
    { float2* rt = (float2*)(ws + OFF_ROPE);
      for (int i = bid * 512 + tid; i < T_TOK * 16; i += nb * 512) { const int t = i >> 4, j = i & 15;
          const float inv = 1.0f / powf(10000.0f, (float)(2 * j) / 32.0f); const float ang = (float)P.pos[t] * inv; float s, c; sincosf(ang, &s, &c); rt[i] = make_float2(c, s); } }
    { const f32x4* src = (const f32x4*)P.p; u32x2* dst = (u32x2*)(ws + OFF_PB);
      for (int i = bid * 512 + tid; i < T_TOK * 256 / 4; i += nb * 512) { const f32x4 v = src[i]; u32x2 w; w.x = cvtpk(v[0], v[1]); w.y = cvtpk(v[2], v[3]); dst[i] = w; } }
    { const int lane = tid & 63, wv = tid >> 6; bf16_t* xn = (bf16_t*)(ws + OFF_XN);
      for (int r0 = (bid * 8 + wv) * 4; r0 < T_TOK; r0 += nb * 8 * 4) {
          f32x4 a[4][4];
#pragma unroll
          for (int q = 0; q < 4; ++q) { const float* xr = P.x + (size_t)(r0 + q) * DM;
              a[q][0] = *(const f32x4*)(xr + lane * 8); a[q][1] = *(const f32x4*)(xr + lane * 8 + 4); a[q][2] = *(const f32x4*)(xr + 512 + lane * 8); a[q][3] = *(const f32x4*)(xr + 512 + lane * 8 + 4); }
#pragma unroll
          for (int q = 0; q < 4; ++q) norm_row_store(a[q][0], a[q][1], a[q][2], a[q][3], P.norm_mix_g, lane, xn + (size_t)(r0 + q) * DM); } }
}

__device__ __forceinline__ void phase_inproj(const Params& P, char* lds) {
    unsigned char* ws = P.ws; const bf16_t* xn = (const bf16_t*)(ws + OFF_XN); const bf16_t* Wt = (const bf16_t*)(ws + OFF_WIN);
    bf16_t* proj = (bf16_t*)(ws + OFF_PROJ); bf16_t* Kb = (bf16_t*)P.out + (size_t)T_TOK * QW; float* gates = (float*)(ws + OFF_GATES); const float2* rope = (const float2*)(ws + OFF_ROPE);
    const int G = gridDim.x, xs = xcd_slot();
    g8::phase((LAS unsigned char*)lds,
      [&](int i, g8::Unit& u) { const int id = xs + i * G; if (id >= 128 * 6) return false; const int mt = id / 6, nt = id % 6;
          u.A = (const char*)(xn + (size_t)mt * 256 * DM); u.B = (const char*)(Wt + (size_t)nt * 256 * DM); u.gather = nullptr; u.nvalid = 0; u.K = DM; u.i0 = mt; u.i1 = nt; u.i2 = 0; return true; },
      [&](const f32x4 (&acc)[2][2][4][2], const g8::Unit& u, int wr, int wc, int fr, int fq) {
        const int m0 = u.i0 * 256, n0 = u.i1 * 256;
#pragma unroll
        for (int ai = 0; ai < 2; ++ai)
#pragma unroll
          for (int m = 0; m < 4; ++m) { const int row = m0 + 128 * ai + 64 * wr + 16 * m + fr;
#pragma unroll
            for (int bj = 0; bj < 2; ++bj)
#pragma unroll
              for (int n = 0; n < 2; ++n) { const int c16 = n0 + 128 * bj + 32 * wc + 16 * n, col = c16 + 4 * fq;
                if (c16 == C_KR) {
                    const f32x4 x1 = acc[ai][bj][m][0], x2 = acc[ai][bj][m][1]; f32x4 o1, o2;
#pragma unroll
                    for (int e = 0; e < 4; ++e) { const float2 cs = rope[(size_t)row * 16 + 4 * fq + e]; o1[e] = x1[e] * cs.x - x2[e] * cs.y; o2[e] = x1[e] * cs.y + x2[e] * cs.x; }
#pragma unroll
                    for (int h = 0; h < 8; ++h) { st4bf(Kb + (size_t)row * KW + h * 96 + 64 + 4 * fq, o1); st4bf(Kb + (size_t)row * KW + h * 96 + 80 + 4 * fq, o2); }
                } else if (c16 == C_KR + 16) {   }
                else if (c16 == C_IG) { if (fq < 2) *(f32x4*)(gates + (size_t)row * 8 + 4 * fq) = acc[ai][bj][m][n]; }
                else if (c16 < C_IG) st4bf(proj + (size_t)row * INWP + col, acc[ai][bj][m][n]);
              } }
      });
}

constexpr int LDS_RS = LDS_GEMM;
__device__ __forceinline__ void mla_unit(const Params& P, int mt, int part, char* lds) {
    unsigned char* ws = P.ws; const bf16_t* proj = (const bf16_t*)(ws + OFF_PROJ);
    bf16_t* Qb = (bf16_t*)P.out; bf16_t* Kb = Qb + (size_t)T_TOK * QW; bf16_t* Vb = Kb + (size_t)T_TOK * KW; const float2* rope = (const float2*)(ws + OFF_ROPE);
    const int tid = threadIdx.x, lane = tid & 63, wid = RFL(tid >> 6), wr = wid >> 1, wc = wid & 1, fr = lane & 15, fq = lane >> 4;
    float* rs = (float*)(lds + LDS_RS);
    const int m0 = mt * 256;
    __syncthreads();
    { const int row = tid >> 1, half = tid & 1; const int cw = part == 0 ? 256 : 128, c0 = part == 0 ? C_CQ : C_CKV; const int per = cw / 2;
      const bf16_t* src = proj + (size_t)(m0 + row) * INWP + c0 + half * per; float ss = 0.f;
      for (int i = 0; i < per / 8; ++i) { const u32x4 v = *(const u32x4*)(src + i * 8);
#pragma unroll
          for (int e = 0; e < 4; ++e) { const float a = bflo(v[e]), b = bfhi(v[e]); ss += a * a + b * b; } }
      ss += __shfl_xor(ss, 1);
      if (half == 0) rs[row] = rsqrtf(ss / (float)cw + EPS); }
    __syncthreads();
    if (part == 0) {
        const bf16_t* Wt = (const bf16_t*)(ws + OFF_WUQ);
        gemm_tiles<4>(6, [&](int nt) { return gdesc(proj + C_CQ, INWP, m0, Wt + (size_t)nt * 128 * 256, 256, 4); },
          [&](int nt, f32x4 (&acc)[4][4]) {
#pragma unroll
            for (int m = 0; m < 4; ++m) { const int lr = wr * 64 + 16 * m + fr, row = m0 + lr; const float r = rs[lr] * QSCALE;
#pragma unroll
                for (int n = 0; n < 4; n += 2) { const int g16 = nt * 8 + wc * 4 + n, h = g16 / 6, jj = g16 % 6;
                    if (jj == 4) { const f32x4 x1 = acc[m][n] * r, x2 = acc[m][n + 1] * r; f32x4 o1, o2;
#pragma unroll
                        for (int e = 0; e < 4; ++e) { const float2 cs = rope[(size_t)row * 16 + 4 * fq + e]; o1[e] = x1[e] * cs.x - x2[e] * cs.y; o2[e] = x1[e] * cs.y + x2[e] * cs.x; }
                        st4bf(Qb + (size_t)row * QW + h * 96 + 64 + 4 * fq, o1); st4bf(Qb + (size_t)row * QW + h * 96 + 80 + 4 * fq, o2);
                    } else { st4bf(Qb + (size_t)row * QW + g16 * 16 + 4 * fq, acc[m][n] * r); st4bf(Qb + (size_t)row * QW + (g16 + 1) * 16 + 4 * fq, acc[m][n + 1] * r); } } }
          }, lds);
    } else {
        const bf16_t* Wt = (const bf16_t*)(ws + OFF_WUKV);
        gemm_tiles<4>(8, [&](int nt) { return gdesc(proj + C_CKV, INWP, m0, Wt + (size_t)nt * 128 * 128, 128, 2); },
          [&](int nt, f32x4 (&acc)[4][4]) {
#pragma unroll
            for (int m = 0; m < 4; ++m) { const int lr = wr * 64 + 16 * m + fr, row = m0 + lr; const float r = rs[lr];
#pragma unroll
                for (int n = 0; n < 4; ++n) { const int jj = wc * 4 + n;
                    if (jj < 4) st4bf(Kb + (size_t)row * KW + nt * 96 + jj * 16 + 4 * fq, acc[m][n] * r);
                    else st4bf(Vb + (size_t)row * VW + nt * 64 + (jj - 4) * 16 + 4 * fq, acc[m][n] * r); } }
          }, lds);
    }
}

__device__ __forceinline__ void gate_prep(const Params& P, int tok0, int h, float* sb, float* sgs, float* spm, float* sbl, float* sa) {
    const float* gates = (const float*)(P.ws + OFF_GATES);
    const int tid = threadIdx.x, lane = tid & 63, w = tid >> 6;
    const float fpre = gates[(size_t)(tok0 + tid) * 8 + 4 + h] + P.b_fgate[h], ig = gates[(size_t)(tok0 + tid) * 8 + h] + P.b_igate[h];
    const float logf = fminf(fpre, 0.f) - log1pf(__expf(-fabsf(fpre)));
    float b = logf;
#pragma unroll
    for (int o = 1; o < 64; o <<= 1) { const float t = __shfl_up(b, o); if (lane >= o) b += t; }
    const float gs = ig - b; float pm = gs;
#pragma unroll
    for (int o = 1; o < 64; o <<= 1) { const float t = __shfl_up(pm, o); if (lane >= o) pm = fmaxf(pm, t); }
    const float bl = __shfl(b, 63), mx = __shfl(pm, 63);
    sb[tid] = b; sgs[tid] = gs; spm[tid] = pm;
    if (lane == 0) { sbl[w] = bl; sa[w] = bl + mx; }
}

constexpr int LDS_M1_G = LDS_GEMM + 1024;
__device__ __forceinline__ void mlstm_unit1(const Params& P, int u, char* lds) {
    unsigned char* ws = P.ws; const bf16_t* proj = (const bf16_t*)(ws + OFF_PROJ);
    bf16_t* xc = (bf16_t*)(ws + OFF_XC); bf16_t* mq = (bf16_t*)(ws + OFF_MQ); bf16_t* mk = (bf16_t*)(ws + OFF_MK); bf16_t* mv = (bf16_t*)(ws + OFF_MV);
    const int b = u >> 6, h = (u >> 4) & 3, g = u & 15, tok0 = b * SEQ + g * 512;
    const int tid = threadIdx.x, lane = tid & 63, wid = RFL(tid >> 6), wr = wid >> 1, wc = wid & 1, fr = lane & 15, fq = lane >> 4, r32 = lane & 31, hi = lane >> 5;
    { const int ch = h * 128 + (tid & 15) * 8, sl = tid >> 4;
      float wv[4][8], bias[8];
#pragma unroll
      for (int k = 0; k < 4; ++k)
#pragma unroll
          for (int e = 0; e < 8; ++e) wv[k][e] = P.conv_w[k * 512 + ch + e];
#pragma unroll
      for (int e = 0; e < 8; ++e) bias[e] = P.conv_b[ch + e];
      const int tin0 = g * 512 + sl * 16; const bf16_t* src = proj + (size_t)(b * SEQ + tin0) * INWP + C_XM + ch;
      u32x4 xr[19];
#pragma unroll
      for (int i = 0; i < 19; ++i) { const int tt = tin0 - 3 + i; xr[i] = (u32x4){0u, 0u, 0u, 0u}; if (tt >= 0) xr[i] = *(const u32x4*)(src + (ptrdiff_t)(i - 3) * INWP); }
#pragma unroll
      for (int i = 0; i < 16; ++i) { float a[8];
#pragma unroll
          for (int e = 0; e < 8; ++e) a[e] = bias[e];
#pragma unroll
          for (int k = 0; k < 4; ++k) { const u32x4 v = xr[i + k];
#pragma unroll
              for (int e = 0; e < 4; ++e) { a[2 * e] += wv[k][2 * e] * bflo(v[e]); a[2 * e + 1] += wv[k][2 * e + 1] * bfhi(v[e]); } }
          u32x4 o;
#pragma unroll
          for (int e = 0; e < 4; ++e) o[e] = cvtpk(siluf(a[2 * e]), siluf(a[2 * e + 1]));
          *(u32x4*)(xc + (size_t)(tok0 + sl * 16 + i) * 512 + ch) = o; } }
    WAITVM0(); __syncthreads();
    gemm_tiles<4>(6, [&](int t) { const int kind = t >> 1, rt = t & 1; const bf16_t* A = kind < 2 ? xc + h * 128 : proj + C_XM + h * 128;
                                  return gdesc(A, kind < 2 ? 512 : INWP, tok0 + rt * 256, (const bf16_t*)(ws + OFF_WM) + (kind * 4 + h) * 16384, 128, 2); },
      [&](int t, f32x4 (&acc)[4][4]) { const int kind = t >> 1, rt = t & 1, m0 = tok0 + rt * 256; bf16_t* dst = kind == 0 ? mq : kind == 1 ? mk : mv;
#pragma unroll
        for (int m = 0; m < 4; ++m) { const int row = m0 + wr * 64 + 16 * m + fr;
#pragma unroll
            for (int n = 0; n < 4; ++n) st4bf(dst + (size_t)row * 512 + h * 128 + wc * 64 + 16 * n + 4 * fq, acc[m][n]); }
      }, lds);
    WAITVM0(); __syncthreads();
    float* sb = (float*)(lds + LDS_M1_G); float* sgs = sb + 512; float* spm = sgs + 512; float* sbl = spm + 512; float* sa = sbl + 8;
    gate_prep(P, tok0, h, sb, sgs, spm, sbl, sa);
    __syncthreads();
    if (tid < 8) { float* cs = (float*)(ws + OFF_CSTAT) + ((size_t)(b * 4 + h) * 128 + g * 8 + tid) * 2; cs[0] = sbl[tid]; cs[1] = sa[tid]; }
    float tail[8]; float mend = -INFINITY;
    { float acc = 0.f;
#pragma unroll
      for (int j = 7; j >= 0; --j) { tail[j] = acc; mend = fmaxf(mend, acc + sa[j]); acc += sbl[j]; } }
    f32x16 cacc[2], nacc; cacc[0] = f32x16{}; cacc[1] = f32x16{}; nacc = f32x16{};
    const bf16x8 ones = (bf16x8){0x3f80, 0x3f80, 0x3f80, 0x3f80, 0x3f80, 0x3f80, 0x3f80, 0x3f80};
    const int s0 = tid >> 4, c8 = tid & 15; const size_t gbase = (size_t)(tok0 + s0) * 512 + h * 128 + c8 * 8;
    u32x4 kq0 = *(const u32x4*)(mk + gbase), kq1 = *(const u32x4*)(mk + gbase + 32 * 512), vq0 = *(const u32x4*)(mv + gbase), vq1 = *(const u32x4*)(mv + gbase + 32 * 512);
#pragma unroll 1
    for (int j = 0; j < 8; ++j) {
        char* img = lds + (j & 1) * 32768;
        { const float e0 = tail[j] + sbl[j] - mend; const float w0 = __expf(e0 + sgs[j * 64 + s0]), w1 = __expf(e0 + sgs[j * 64 + s0 + 32]);
          u32x4 k0, k1;
#pragma unroll
          for (int e = 0; e < 4; ++e) { k0[e] = cvtpk(bflo(kq0[e]) * w0, bfhi(kq0[e]) * w0); k1[e] = cvtpk(bflo(kq1[e]) * w1, bfhi(kq1[e]) * w1); }
          const int off = (c8 >> 2) * 4096 + s0 * 64 + (c8 & 3) * 16;
          *(u32x4*)(img + off) = k0; *(u32x4*)(img + off + 32 * 64) = k1; *(u32x4*)(img + 16384 + off) = vq0; *(u32x4*)(img + 16384 + off + 32 * 64) = vq1; }
        if (j < 7) { const size_t gn = gbase + (size_t)(j + 1) * 64 * 512; kq0 = *(const u32x4*)(mk + gn); kq1 = *(const u32x4*)(mk + gn + 32 * 512); vq0 = *(const u32x4*)(mv + gn); vq1 = *(const u32x4*)(mv + gn + 32 * 512); }
        __syncthreads();
        { const int q = (lane & 15) >> 2, p = lane & 3, cb = (lane >> 4) & 1;
          const lds_cptr kp = (lds_cptr)img + wr * 4096 + (4 * hi + q) * 64 + cb * 32 + p * 8;
          const lds_cptr vp = (lds_cptr)img + 16384 + (2 * wc) * 4096 + (4 * hi + q) * 64 + cb * 32 + p * 8;
#pragma unroll
          for (int ks = 0; ks < 4; ++ks) { const bf16x8 af = cat8(vtr(kp + ks * 1024), vtr(kp + ks * 1024 + 512));
              const bf16x8 b0 = cat8(vtr(vp + ks * 1024), vtr(vp + ks * 1024 + 512)), b1 = cat8(vtr(vp + 4096 + ks * 1024), vtr(vp + 4096 + ks * 1024 + 512));
              cacc[0] = MFMA32(af, b0, cacc[0]); cacc[1] = MFMA32(af, b1, cacc[1]);
              if (wc == 0) nacc = MFMA32(af, ones, nacc); } }
    }
    bf16_t* st = (bf16_t*)(ws + OFF_STATE) + (size_t)u * 16384; float* nst = (float*)(ws + OFF_NST) + (size_t)u * 128; float* mst = (float*)(ws + OFF_MST) + u;
#pragma unroll
    for (int nb2 = 0; nb2 < 2; ++nb2)
#pragma unroll
        for (int r = 0; r < 16; ++r) st[(wr * 32 + crow(r, hi)) * 128 + wc * 64 + nb2 * 32 + r32] = (bf16_t)(cvtpk(cacc[nb2][r], 0.f) & 0xffffu);
    if (wc == 0 && r32 == 0) {
#pragma unroll
        for (int r = 0; r < 16; ++r) nst[wr * 32 + crow(r, hi)] = nacc[r]; }
    if (tid == 0) mst[0] = mend;
    __syncthreads();
}

constexpr int LDS_AK = 0, LDS_AV = 2 * 12288, LDS_AW = LDS_AV + 2 * 8192;
#ifndef ATT_THR
#define ATT_THR 8.0f
#endif
__device__ __forceinline__ void attn_unit(const Params& P, int b, int h, int qb, char* lds) {
    const bf16_t* Qb = (const bf16_t*)P.out; const bf16_t* Kb = Qb + (size_t)T_TOK * QW; const bf16_t* Vb = Kb + (size_t)T_TOK * KW; bf16_t* att = (bf16_t*)(P.ws + OFF_MIX);
    const int tid = threadIdx.x, lane = tid & 63, r32 = lane & 31, hi = lane >> 5; const int wid = RFL(tid >> 6);
    const unsigned lds0 = (unsigned)(uintptr_t)lds;
    const size_t rowbase = (size_t)b * SEQ; const int q0 = qb * 256, NT = 4 * qb + 4, mynt = 4 * qb + (wid >> 1) + 1;
    const bf16_t* Qw = Qb + (rowbase + q0 + wid * 32 + r32) * QW + h * 96;
    bf16x8 qr[6];
#pragma unroll
    for (int d0 = 0; d0 < 6; ++d0) qr[d0] = *(const bf16x8*)(Qw + d0 * 16 + hi * 8);
    const bf16_t* ksrc0 = Kb + (rowbase + lane) * KW + h * 96 + wid * 8;
    const bf16_t* ksrc1 = Kb + (rowbase + lane) * KW + h * 96 + (8 + (wid & 3)) * 8;
    const bf16_t* vsrc = Vb + (rowbase + 16 * (wid & 3) + (lane >> 2)) * VW + h * 64 + (wid >> 2) * 32 + (lane & 3) * 8;
    float* wsf = (float*)(lds + LDS_AW) + wid * 64;
    float mhat = 0.f, l_reg = 0.f; f32x16 o0 = f32x16{}, o1 = f32x16{};
    const lds_cptr vp0 = (lds_cptr)lds + LDS_AV + ((lane >> 4) & 1) * 32 + (lane & 3) * 8 + (4 * hi + ((lane & 15) >> 2)) * 64;
    const char* kp0 = lds + LDS_AK + hi * 1024 + r32 * 16;
    auto dma = [&](int t, int slot) {
        glds16(ksrc0 + (size_t)t * 64 * KW, RFL(lds0 + LDS_AK + slot * 12288 + wid * 1024));
        if (wid < 4) glds16(ksrc1 + (size_t)t * 64 * KW, RFL(lds0 + LDS_AK + slot * 12288 + (8 + wid) * 1024));
        glds16(vsrc + (size_t)t * 64 * VW, RFL(lds0 + LDS_AV + slot * 8192 + wid * 1024));
    };
    __syncthreads();
    dma(0, 0);
    for (int t = 0; t < NT; ++t) {
        asm volatile("s_waitcnt vmcnt(0) lgkmcnt(0)" ::: "memory"); __syncthreads();
        if (t + 1 < NT) dma(t + 1, (t + 1) & 1);
        if (t < mynt) {
            const char* kp = kp0 + (t & 1) * 12288;
            f32x16 s0 = f32x16{}, s1 = f32x16{};
#pragma unroll
            for (int d0 = 0; d0 < 6; ++d0) { const bf16x8 k0 = *(const bf16x8*)(kp + d0 * 2048), k1 = *(const bf16x8*)(kp + d0 * 2048 + 512);
                s0 = MFMA32(k0, qr[d0], s0); s1 = MFMA32(k1, qr[d0], s1); }
            float rm = s0[0];
#pragma unroll
            for (int r = 1; r < 16; ++r) rm = fmaxf(rm, s0[r]);
#pragma unroll
            for (int r = 0; r < 16; ++r) rm = fmaxf(rm, s1[r]);
            rm = fmaxf(rm, __shfl_xor(rm, 32));
            if (t == 0) mhat = rm;
            else { const float d = rm - mhat;
                if (__any(d > ATT_THR)) { const float dl = fmaxf(d, 0.f); mhat += dl; const float f = __builtin_amdgcn_exp2f(-dl); l_reg *= f;
                    if (hi == 0) wsf[r32] = f; WAITLGKM0();
#pragma unroll
                    for (int r = 0; r < 16; ++r) { const float fr_ = wsf[crow(r, hi)]; o0[r] *= fr_; o1[r] *= fr_; }
                    WAITLGKM0(); } }
            float sacc = 0.f;
#pragma unroll
            for (int r = 0; r < 16; ++r) { s0[r] = __builtin_amdgcn_exp2f(s0[r] - mhat); s1[r] = __builtin_amdgcn_exp2f(s1[r] - mhat); sacc += s0[r] + s1[r]; }
            l_reg += sacc;
            u32x4 pw[4];
#pragma unroll
            for (int i = 0; i < 4; ++i) { pw[0][i] = cvtpk(s0[2 * i], s0[2 * i + 1]); pw[1][i] = cvtpk(s0[8 + 2 * i], s0[8 + 2 * i + 1]); pw[2][i] = cvtpk(s1[2 * i], s1[2 * i + 1]); pw[3][i] = cvtpk(s1[8 + 2 * i], s1[8 + 2 * i + 1]); }
            const lds_cptr vp = vp0 + (t & 1) * 8192;
#pragma unroll
            for (int ks = 0; ks < 4; ++ks) { const bf16x8 pa = __builtin_bit_cast(bf16x8, pw[ks]);
                const bf16x8 v0 = cat8(vtr(vp + ks * 1024), vtr(vp + ks * 1024 + 512)), v1 = cat8(vtr(vp + 4096 + ks * 1024), vtr(vp + 4096 + ks * 1024 + 512));
                o0 = MFMA32(pa, v0, o0); o1 = MFMA32(pa, v1, o1); }
        }
    }
    l_reg += __shfl_xor(l_reg, 32);
    WAITLGKM0();
    if (hi == 0) wsf[32 + r32] = l_reg;
    WAITLGKM0();
    bf16_t* Ow = att + (rowbase + q0 + wid * 32) * 1024 + h * 64;
#pragma unroll
    for (int r = 0; r < 16; ++r) { const int orow = crow(r, hi); const float rl = 1.0f / wsf[32 + orow];
        Ow[(size_t)orow * 1024 + r32] = (bf16_t)(cvtpk(o0[r] * rl, 0.f) & 0xffffu); Ow[(size_t)orow * 1024 + 32 + r32] = (bf16_t)(cvtpk(o1[r] * rl, 0.f) & 0xffffu); }
    WAITLGKM0();
}

constexpr int LDS_M2_C = 0, LDS_M2_Q = 32768, LDS_M2_K = 49152, LDS_M2_V = 65536, LDS_M2_KS = 81920, LDS_M2_NUM = 98304  , LDS_M2_MISC = 98304 + 33792;
__device__ __forceinline__ void mlstm_unit2(const Params& P, int u, char* lds) {
    unsigned char* ws = P.ws; const bf16_t* proj = (const bf16_t*)(ws + OFF_PROJ);
    const bf16_t* xc = (const bf16_t*)(ws + OFF_XC); const bf16_t* mq = (const bf16_t*)(ws + OFF_MQ); const bf16_t* mk = (const bf16_t*)(ws + OFF_MK); const bf16_t* mv = (const bf16_t*)(ws + OFF_MV);
    bf16_t* mlo = (bf16_t*)(ws + OFF_MIX) + 512;
    const int b = u >> 6, h = (u >> 4) & 3, g = u & 15, tok0 = b * SEQ + g * 512, seq = b * 4 + h;
    const int tid = threadIdx.x, lane = tid & 63, wid = RFL(tid >> 6), r32 = lane & 31, hi = lane >> 5, wr = wid >> 1, wc = wid & 1;
    float* misc = (float*)(lds + LDS_M2_MISC);
    float* sb = misc; float* sgs = sb + 512; float* spm = sgs + 512; float* sbl = spm + 512; float* sa = sbl + 8;
    float* marr = sa + 8; float* fbarr = marr + 136; float* cst = fbarr + 136;
    float* nfull = cst + 256; float* nseg = nfull + 128; float* sden = nseg + 128; float* swi = sden + 64; float* coef = swi + 64;
    __syncthreads();
    gate_prep(P, tok0, h, sb, sgs, spm, sbl, sa);
    if (tid < 256) cst[tid] = ((const float*)(ws + OFF_CSTAT))[(size_t)seq * 256 + tid];
    __syncthreads();
    if (tid == 0) { float m = 0.f, F = 0.f; const int nc = 8 * g + 8;
        for (int c = 0; c < nc; ++c) { marr[c] = m; fbarr[c] = F; const float bl = cst[2 * c], a = cst[2 * c + 1]; m = fmaxf(bl + m, a); F += bl; }
        marr[nc] = m; fbarr[nc] = F; }
    __syncthreads();
    const float* mstg = (const float*)(ws + OFF_MST);
    if (tid < 16) { float c = 0.f; if (tid < g) c = __expf(mstg[u - g + tid] + (fbarr[8 * g] - fbarr[8 * (tid + 1)]) - marr[8 * g]); coef[tid] = c; }
    __syncthreads();
    f32x16 cacc[2];
    { float cseg[32];
#pragma unroll
      for (int i = 0; i < 32; ++i) cseg[i] = 0.f;
      float nsg = 0.f;
      const bf16_t* stall = (const bf16_t*)(ws + OFF_STATE); const float* nstall = (const float*)(ws + OFF_NST);
#pragma unroll 2
      for (int gp = 0; gp < g; ++gp) { const float c = coef[gp]; const bf16_t* st = stall + (size_t)(u - g + gp) * 16384;
#pragma unroll
          for (int i = 0; i < 4; ++i) { const u32x4 v = *(const u32x4*)(st + (i * 512 + tid) * 8);
#pragma unroll
              for (int e = 0; e < 4; ++e) { cseg[i * 8 + 2 * e] += c * bflo(v[e]); cseg[i * 8 + 2 * e + 1] += c * bfhi(v[e]); } }
          if (tid < 128) nsg += c * nstall[(size_t)(u - g + gp) * 128 + tid]; }
      if (tid < 128) nseg[tid] = nsg;
      float* tmp = (float*)lds;
#pragma unroll
      for (int i = 0; i < 4; ++i) { *(f32x4*)(tmp + (i * 512 + tid) * 8) = (f32x4){cseg[i * 8], cseg[i * 8 + 1], cseg[i * 8 + 2], cseg[i * 8 + 3]}; *(f32x4*)(tmp + (i * 512 + tid) * 8 + 4) = (f32x4){cseg[i * 8 + 4], cseg[i * 8 + 5], cseg[i * 8 + 6], cseg[i * 8 + 7]}; }
      __syncthreads();
#pragma unroll
      for (int nb2 = 0; nb2 < 2; ++nb2)
#pragma unroll
          for (int r = 0; r < 16; ++r) cacc[nb2][r] = tmp[(wr * 32 + crow(r, hi)) * 128 + wc * 64 + nb2 * 32 + r32];
    }
    const int tb = wid & 1, db = wid >> 1;
    const int s0 = tid >> 4, c8 = tid & 15; const size_t gbase = (size_t)(tok0 + s0) * 512 + h * 128 + c8 * 8;
    u32x4 qa0 = *(const u32x4*)(mq + gbase), qa1 = *(const u32x4*)(mq + gbase + 32 * 512), ka0 = *(const u32x4*)(mk + gbase), ka1 = *(const u32x4*)(mk + gbase + 32 * 512),
          va0 = *(const u32x4*)(mv + gbase), va1 = *(const u32x4*)(mv + gbase + 32 * 512);
#pragma unroll 1
    for (int j = 0; j < 8; ++j) {
        int tz = threadIdx.x; asm volatile("" : "+v"(tz));
        const int tid = tz, lane = tz & 63, r32 = lane & 31, hi = lane >> 5; const int wid = RFL(tz >> 6), wr = wid >> 1, wc = wid & 1, tb = wid & 1, db = wid >> 1, s0 = tz >> 4, c8 = tz & 15;
        const int c = 8 * g + j; const float mc = marr[c], mn = marr[c + 1], bl = sbl[j]; const float decay = __expf(bl + mc - mn);
        __syncthreads();
#pragma unroll
        for (int nb2 = 0; nb2 < 2; ++nb2)
#pragma unroll
            for (int r = 0; r < 16; ++r) *(bf16_t*)(lds + LDS_M2_C + (2 * wc + nb2) * 8192 + (wr * 32 + crow(r, hi)) * 64 + r32 * 2) = (bf16_t)(cvtpk(cacc[nb2][r], 0.f) & 0xffffu);
        float* ncur = (j & 1) ? nfull : nseg; float* nnxt = (j & 1) ? nseg : nfull;
        { const float w0 = __expf(bl + sgs[j * 64 + s0] - mn), w1 = __expf(bl + sgs[j * 64 + s0 + 32] - mn);
          u32x4 k0, k1;
#pragma unroll
          for (int e = 0; e < 4; ++e) { k0[e] = cvtpk(bflo(ka0[e]) * w0, bfhi(ka0[e]) * w0); k1[e] = cvtpk(bflo(ka1[e]) * w1, bfhi(ka1[e]) * w1); }
          const int so0 = s0 * 256 + ((c8 ^ (s0 & 15)) << 4), so1 = (s0 + 32) * 256 + ((c8 ^ (s0 & 15)) << 4);
          *(u32x4*)(lds + LDS_M2_Q + so0) = qa0; *(u32x4*)(lds + LDS_M2_Q + so1) = qa1; *(u32x4*)(lds + LDS_M2_K + so0) = ka0; *(u32x4*)(lds + LDS_M2_K + so1) = ka1;
          const int off = (c8 >> 2) * 4096 + s0 * 64 + (c8 & 3) * 16;
          *(u32x4*)(lds + LDS_M2_V + off) = va0; *(u32x4*)(lds + LDS_M2_V + off + 32 * 64) = va1; *(u32x4*)(lds + LDS_M2_KS + off) = k0; *(u32x4*)(lds + LDS_M2_KS + off + 32 * 64) = k1; }
        if (tid < 64) swi[tid] = __expf(mc - fmaxf(spm[j * 64 + tid], mc));
        const int ft = tid >> 3, pp = tid & 7; const size_t ftok = (size_t)tok0 + j * 64 + ft; const int fch = h * 128 + 16 * pp;
        u32x4 xa, xb, za, zb;
        __syncthreads();
        { const int t = 32 * tb + r32; const float mt = fmaxf(spm[j * 64 + t], mc);
          const char* qrow = lds + LDS_M2_Q + t * 256;
          f32x16 sT[2]; sT[0] = f32x16{}; sT[1] = f32x16{};
#pragma unroll
          for (int ks = 0; ks < 8; ++ks) { const bf16x8 qf = *(const bf16x8*)(qrow + (((2 * ks + hi) ^ (t & 15)) << 4));
              { const int s = r32; const bf16x8 kf = *(const bf16x8*)(lds + LDS_M2_K + s * 256 + (((2 * ks + hi) ^ (s & 15)) << 4)); sT[0] = MFMA32(kf, qf, sT[0]); }
              if (tb) { const int s = 32 + r32; const bf16x8 kf = *(const bf16x8*)(lds + LDS_M2_K + s * 256 + (((2 * ks + hi) ^ (s & 15)) << 4)); sT[1] = MFMA32(kf, qf, sT[1]); } }
          float dsum = 0.f;
#pragma unroll
          for (int sbk = 0; sbk < 2; ++sbk)
#pragma unroll
              for (int r = 0; r < 16; ++r) { const int s = 32 * sbk + crow(r, hi); const float w = (s <= t) ? __expf(sgs[j * 64 + s] - mt) : 0.f; const float v = sT[sbk][r] * w; sT[sbk][r] = v; dsum += v; }
          dsum += __shfl_xor(dsum, 32);
          if (db == 0 && hi == 0) sden[t] = dsum;
          u32x4 pw[4];
#pragma unroll
          for (int i = 0; i < 4; ++i) { pw[0][i] = cvtpk(sT[0][2 * i], sT[0][2 * i + 1]); pw[1][i] = cvtpk(sT[0][8 + 2 * i], sT[0][8 + 2 * i + 1]); pw[2][i] = cvtpk(sT[1][2 * i], sT[1][2 * i + 1]); pw[3][i] = cvtpk(sT[1][8 + 2 * i], sT[1][8 + 2 * i + 1]); }
          const int q = (lane & 15) >> 2, p = lane & 3, cb = (lane >> 4) & 1;
          const lds_cptr vp = (lds_cptr)lds + LDS_M2_V + db * 4096 + (4 * hi + q) * 64 + cb * 32 + p * 8;
          f32x16 o1 = f32x16{}, o2 = f32x16{};
#pragma unroll
          for (int ks = 0; ks < 4; ++ks) { if (ks < 2 * (tb + 1)) { const bf16x8 vf = cat8(vtr(vp + ks * 1024), vtr(vp + ks * 1024 + 512)); o1 = MFMA32(__builtin_bit_cast(bf16x8, pw[ks]), vf, o1); } }
          const lds_cptr cp = (lds_cptr)lds + LDS_M2_C + db * 8192 + (8 * hi + q) * 64 + cb * 32 + p * 8;
#pragma unroll
          for (int ks = 0; ks < 8; ++ks) { const bf16x8 qf = *(const bf16x8*)(qrow + (((2 * ks + hi) ^ (t & 15)) << 4)); const bf16x8 cf = cat8(vtr(cp + ks * 1024), vtr(cp + ks * 1024 + 256)); o2 = MFMA32(qf, cf, o2); }
          float* num = (float*)(lds + LDS_M2_NUM);
#pragma unroll
          for (int r = 0; r < 16; ++r) { const int tr_ = 32 * tb + crow(r, hi); num[tr_ * 132 + db * 32 + r32] = o1[r] + swi[tr_] * o2[r]; }
          if (j < 7) { const size_t gn = gbase + (size_t)(j + 1) * 64 * 512; qa0 = *(const u32x4*)(mq + gn); qa1 = *(const u32x4*)(mq + gn + 32 * 512); ka0 = *(const u32x4*)(mk + gn); ka1 = *(const u32x4*)(mk + gn + 32 * 512);
              va0 = *(const u32x4*)(mv + gn); va1 = *(const u32x4*)(mv + gn + 32 * 512); }
#pragma unroll
          for (int r = 0; r < 16; ++r) { cacc[0][r] *= decay; cacc[1][r] *= decay; }
          const lds_cptr kp = (lds_cptr)lds + LDS_M2_KS + wr * 4096 + (4 * hi + q) * 64 + cb * 32 + p * 8;
          const lds_cptr vp2 = (lds_cptr)lds + LDS_M2_V + (2 * wc) * 4096 + (4 * hi + q) * 64 + cb * 32 + p * 8;
#pragma unroll
          for (int ks = 0; ks < 4; ++ks) { const bf16x8 af = cat8(vtr(kp + ks * 1024), vtr(kp + ks * 1024 + 512));
              const bf16x8 b0 = cat8(vtr(vp2 + ks * 1024), vtr(vp2 + ks * 1024 + 512)), b1 = cat8(vtr(vp2 + 4096 + ks * 1024), vtr(vp2 + 4096 + ks * 1024 + 512));
              cacc[0] = MFMA32(af, b0, cacc[0]); cacc[1] = MFMA32(af, b1, cacc[1]); }
          if (tid < 128) { float a = 0.f; const char* kcol = lds + LDS_M2_KS + (tid >> 5) * 4096 + (tid & 31) * 2;
#pragma unroll 8
              for (int s2 = 0; s2 < 64; ++s2) a += bf2f(*(const bf16_t*)(kcol + s2 * 64));
              nnxt[tid] = decay * ncur[tid] + a; } }
        xa = *(const u32x4*)(xc + ftok * 512 + fch); xb = *(const u32x4*)(xc + ftok * 512 + fch + 8);
        za = *(const u32x4*)(proj + ftok * INWP + C_Z + fch); zb = *(const u32x4*)(proj + ftok * INWP + C_Z + fch + 8);
        __syncthreads();
        { const int t = ft; const float* num = (const float*)(lds + LDS_M2_NUM);
          float qn = 0.f;
#pragma unroll
          for (int cc = 0; cc < 2; ++cc) { const u32x4 qv = *(const u32x4*)(lds + LDS_M2_Q + t * 256 + (((2 * pp + cc) ^ (t & 15)) << 4));
#pragma unroll
              for (int e = 0; e < 4; ++e) qn += bflo(qv[e]) * ncur[16 * pp + 8 * cc + 2 * e] + bfhi(qv[e]) * ncur[16 * pp + 8 * cc + 2 * e + 1]; }
          qn += __shfl_xor(qn, 1); qn += __shfl_xor(qn, 2); qn += __shfl_xor(qn, 4);
          const float mt = sb[j * 64 + t] + fmaxf(spm[j * 64 + t], mc);
          float den = sden[t] + swi[t] * qn; den = fmaxf(fabsf(den), __expf(-mt)); const float rden = 1.0f / den;
          float hv[16]; float s1 = 0.f;
#pragma unroll
          for (int e = 0; e < 16; ++e) { hv[e] = num[t * 132 + 16 * pp + e] * rden; s1 += hv[e]; }
          s1 += __shfl_xor(s1, 1); s1 += __shfl_xor(s1, 2); s1 += __shfl_xor(s1, 4);
          const float mu = s1 * (1.0f / 128.0f); float s2 = 0.f;
#pragma unroll
          for (int e = 0; e < 16; ++e) { const float d = hv[e] - mu; s2 += d * d; }
          s2 += __shfl_xor(s2, 1); s2 += __shfl_xor(s2, 2); s2 += __shfl_xor(s2, 4);
          const float rstd = rsqrtf(s2 * (1.0f / 128.0f) + EPS);
          float ov[16];
#pragma unroll
          for (int e = 0; e < 16; ++e) { const unsigned xw = e < 8 ? xa[e >> 1] : xb[(e - 8) >> 1], zw = e < 8 ? za[e >> 1] : zb[(e - 8) >> 1];
              const float xcv = (e & 1) ? bfhi(xw) : bflo(xw), zv = (e & 1) ? bfhi(zw) : bflo(zw);
              const float hn = (hv[e] - mu) * rstd * P.mh_norm_g[fch + e];
              ov[e] = (hn + P.ml_skip[fch + e] * xcv) * siluf(zv); }
          u32x4 oa, ob;
#pragma unroll
          for (int e = 0; e < 4; ++e) { oa[e] = cvtpk(ov[2 * e], ov[2 * e + 1]); ob[e] = cvtpk(ov[8 + 2 * e], ov[8 + 2 * e + 1]); }
          *(u32x4*)(mlo + ftok * 1024 + fch) = oa; *(u32x4*)(mlo + ftok * 1024 + fch + 8) = ob; }
    }
}

__device__ __forceinline__ void phase_outproj(const Params& P, char* lds) {
    unsigned char* ws = P.ws; const bf16_t* mix = (const bf16_t*)(ws + OFF_MIX); const bf16_t* Wt = (const bf16_t*)(ws + OFF_WO);
    const int G = gridDim.x, xs = xcd_slot();
    g8::phase((LAS unsigned char*)lds,
      [&](int i, g8::Unit& u) { const int id = xs + i * G; if (id >= 128 * 4) return false; const int mt = id >> 2, nt = id & 3;
          u.A = (const char*)(mix + (size_t)mt * 256 * DM); u.B = (const char*)(Wt + (size_t)nt * 256 * DM); u.gather = nullptr; u.nvalid = 0; u.K = DM; u.i0 = mt; u.i1 = nt; u.i2 = 0; return true; },
      [&](const f32x4 (&acc)[2][2][4][2], const g8::Unit& u, int wr, int wc, int fr, int fq) {
        const int m0 = u.i0 * 256, n0 = u.i1 * 256;
#pragma unroll
        for (int ai = 0; ai < 2; ++ai)
#pragma unroll
          for (int m = 0; m < 4; ++m) { const size_t row = m0 + 128 * ai + 64 * wr + 16 * m + fr;
#pragma unroll
            for (int bj = 0; bj < 2; ++bj)
#pragma unroll
              for (int n = 0; n < 2; ++n) { const int col = n0 + 128 * bj + 32 * wc + 16 * n + 4 * fq; const f32x4 xv = *(const f32x4*)(P.x + row * DM + col); st4bf((bf16_t*)(P.ws + OFF_RES) + row * DM + col, xv + acc[ai][bj][m][n]); } }
      });
}

constexpr int LDS_LOGIT = LDS_GEMM;
__device__ __forceinline__ void phase_router(const Params& P, char* lds) {
    unsigned char* ws = P.ws; const bool shd = (P.sub & 256) != 0; bf16_t* hn = (bf16_t*)(ws + (shd ? OFF_PROJ : OFF_XN)); const bf16_t* Wr = (const bf16_t*)(ws + OFF_WR);
    unsigned* cnt = (unsigned*)(ws + OFF_CNT + (shd ? 8192 : 0)); int* list = (int*)(ws + (shd ? OFF_PROJ + 64 * MiB : OFF_LIST)); float* tokrec = (float*)(ws + (shd ? OFF_PROJ + 72 * MiB : OFF_TOKREC));
    const int tid = threadIdx.x, lane = tid & 63, wid = RFL(tid >> 6), wr = wid >> 1, wc = wid & 1, fr = lane & 15, fq = lane >> 4;
    float* logit = (float*)(lds + LDS_LOGIT);
    for (int u = blockIdx.x; u < 256; u += gridDim.x) {
        const int m0 = u * 128;
        for (int i = 0; i < 16; i += 4) { f32x4 a[4][4];
#pragma unroll
            for (int q = 0; q < 4; ++q) ld_row_bf16((const bf16_t*)(P.ws + OFF_RES) + (size_t)(m0 + wid * 16 + i + q) * DM, lane, a[q]);
#pragma unroll
            for (int q = 0; q < 4; ++q) norm_row_store(a[q][0], a[q][1], a[q][2], a[q][3], P.norm_ffn_g, lane, hn + (size_t)(m0 + wid * 16 + i + q) * DM); }
        WAITVM0(); __syncthreads();
        gemm_tiles<2>(1, [&](int) { return gdesc(hn, DM, m0, Wr, DM, 16); },
          [&](int, f32x4 (&acc)[2][4]) {
            if (wc == 0) {
#pragma unroll
                for (int m = 0; m < 2; ++m) { const int lr = wr * 32 + 16 * m + fr;
#pragma unroll
                    for (int n = 0; n < 3; ++n) { const int col = 16 * n + 4 * fq; if (col < 36) *(f32x4*)(logit + lr * 40 + col) = acc[m][n]; } } }
          }, lds);
        __syncthreads();
        if (tid < 128) { const int tok = m0 + tid; const float* lg = logit + tid * 40;
            float gl[4]; float gm = -INFINITY; int gi = 0;
#pragma unroll
            for (int k = 0; k < 4; ++k) { gl[k] = lg[k] + P.b_rg[k]; if (gl[k] > gm) { gm = gl[k]; gi = k; } }
            float gsum = 0.f;
#pragma unroll
            for (int k = 0; k < 4; ++k) gsum += __expf(gl[k] - gm);
            const float gtop = 1.0f / gsum;
            float el[8]; float e1 = -INFINITY, e2 = -INFINITY; int i1 = 0, i2 = 0;
#pragma unroll
            for (int k = 0; k < 8; ++k) { el[k] = lg[4 + gi * 8 + k] + P.b_re[gi * 8 + k]; }
#pragma unroll
            for (int k = 0; k < 8; ++k) { if (el[k] > e1) { e2 = e1; i2 = i1; e1 = el[k]; i1 = k; } else if (el[k] > e2) { e2 = el[k]; i2 = k; } }
            const float rr = __expf(e2 - e1); const float w1 = gtop / (1.f + rr), w2 = gtop * rr / (1.f + rr);
            const int ex1 = gi * 8 + i1, ex2 = gi * 8 + i2;
            const unsigned p1 = __hip_atomic_fetch_add(cnt + ex1 * 64, 1u, __ATOMIC_RELAXED, __HIP_MEMORY_SCOPE_AGENT);
            const unsigned p2 = __hip_atomic_fetch_add(cnt + ex2 * 64, 1u, __ATOMIC_RELAXED, __HIP_MEMORY_SCOPE_AGENT);
            list[(size_t)ex1 * T_TOK + p1] = tok; list[(size_t)ex2 * T_TOK + p2] = tok;
            f32x4 rec; rec[0] = __uint_as_float((unsigned)(ex1 << 16) | 0u); rec[1] = w1; rec[2] = __uint_as_float(p1); rec[3] = w2;
            rec[0] = __uint_as_float((unsigned)ex1 | ((unsigned)ex2 << 8));
            *(f32x4*)(tokrec + (size_t)tok * 4) = rec;
            ((unsigned*)(ws + (shd ? OFF_PROJ + 80 * MiB : OFF_GATES)))[tok] = p2;
        }
        __syncthreads();
    }
}

__device__ __forceinline__ int moe_bases(const Params& P, int* sbase, int* stile) {
    const unsigned* cnt = (const unsigned*)(P.ws + OFF_CNT);
    __syncthreads();
    if (threadIdx.x == 0) { int acc = 0, tt = 0; for (int e = 0; e < NEXP; ++e) { const int c = (int)__hip_atomic_load(cnt + e * 64, __ATOMIC_RELAXED, __HIP_MEMORY_SCOPE_AGENT); const int nt = (c + 255) >> 8; sbase[e] = acc; stile[e] = tt; acc += nt * 256; tt += nt; } sbase[NEXP] = acc; stile[NEXP] = tt; }
    __syncthreads();
    return stile[NEXP];
}

constexpr int LDS_MOE = 4 * 32768 + 1024;
__device__ __forceinline__ void phase_moe_gu(const Params& P, char* lds) {
    unsigned char* ws = P.ws; const bf16_t* hn = (const bf16_t*)(ws + OFF_XN); bf16_t* act = (bf16_t*)(ws + OFF_ACT); const int* list = (const int*)(ws + OFF_LIST);
    const unsigned* cnt = (const unsigned*)(ws + OFF_CNT);
    int* sbase = (int*)(lds + LDS_MOE); int* stile = sbase + 40;
    const int ntiles = moe_bases(P, sbase, stile);
    const int G = gridDim.x, xs = xcd_slot();
    g8::phase((LAS unsigned char*)lds,
      [&](int i, g8::Unit& u) { const int id = xs + i * G; if (id >= ntiles * 2) return false; const int ti = id >> 1, nt = id & 1; int e = 0; for (int k = 1; k < NEXP; ++k) if (stile[k] <= ti) e = k;
          const int it = ti - stile[e]; const int ce = (int)cnt[e * 64];
          u.A = (const char*)hn; u.B = (const char*)((const bf16_t*)(ws + OFF_WGU) + ((size_t)e * 512 + nt * 256) * 1024); u.gather = list + (size_t)e * T_TOK + it * 256; u.nvalid = ce - it * 256; u.K = DM;
          u.i0 = sbase[e] + it * 256; u.i1 = nt; u.i2 = e; return true; },
      [&](const f32x4 (&acc)[2][2][4][2], const g8::Unit& u, int wr, int wc, int fr, int fq) {
#pragma unroll
        for (int ai = 0; ai < 2; ++ai)
#pragma unroll
          for (int m = 0; m < 4; ++m) { const size_t row = (size_t)u.i0 + 128 * ai + 64 * wr + 16 * m + fr;
#pragma unroll
            for (int n = 0; n < 2; ++n) { f32x4 v;
#pragma unroll
                for (int q = 0; q < 4; ++q) v[q] = siluf(acc[ai][0][m][n][q]) * acc[ai][1][m][n][q];
                st4bf(act + row * DEXP + u.i1 * 128 + 32 * wc + 16 * n + 4 * fq, v); } }
      });
}
__device__ __forceinline__ void phase_moe_down(const Params& P, char* lds) {
    unsigned char* ws = P.ws; const bf16_t* act = (const bf16_t*)(ws + OFF_ACT); bf16_t* y = (bf16_t*)(ws + OFF_Y);
    int* sbase = (int*)(lds + LDS_MOE); int* stile = sbase + 40;
    const int ntiles = moe_bases(P, sbase, stile);
    const int G = gridDim.x, xs = xcd_slot();
    g8::phase((LAS unsigned char*)lds,
      [&](int i, g8::Unit& u) { const int id = xs + i * G; if (id >= ntiles * 4) return false; const int ti = id >> 2, nt = id & 3; int e = 0; for (int k = 1; k < NEXP; ++k) if (stile[k] <= ti) e = k;
          const int rbase = sbase[e] + (ti - stile[e]) * 256;
          u.A = (const char*)(act + (size_t)rbase * DEXP); u.B = (const char*)((const bf16_t*)(ws + OFF_WD) + ((size_t)e * 1024 + nt * 256) * 256); u.gather = nullptr; u.nvalid = 0; u.K = DEXP; u.i0 = rbase; u.i1 = nt; u.i2 = e; return true; },
      [&](const f32x4 (&acc)[2][2][4][2], const g8::Unit& u, int wr, int wc, int fr, int fq) {
#pragma unroll
        for (int ai = 0; ai < 2; ++ai)
#pragma unroll
          for (int m = 0; m < 4; ++m) { const size_t row = (size_t)u.i0 + 128 * ai + 64 * wr + 16 * m + fr;
#pragma unroll
            for (int bj = 0; bj < 2; ++bj)
#pragma unroll
              for (int n = 0; n < 2; ++n) st4bf(y + row * DM + u.i1 * 256 + 128 * bj + 32 * wc + 16 * n + 4 * fq, acc[ai][bj][m][n]); }
      });
}
__device__ __forceinline__ void phase_combine(const Params& P, char* lds) {
    unsigned char* ws = P.ws; const bf16_t* y = (const bf16_t*)(ws + OFF_Y); bf16_t* hp = (bf16_t*)(ws + OFF_XN); const float* tokrec = (const float*)(ws + OFF_TOKREC);
    int* sbase = (int*)(lds + LDS_MOE); int* stile = sbase + 40;
    (void)moe_bases(P, sbase, stile);
    const int tid = threadIdx.x, lane = tid & 63, wv = tid >> 6;
    for (int r0 = (blockIdx.x * 8 + wv) * 4; r0 < T_TOK; r0 += gridDim.x * 8 * 4) {
        f32x4 rec[4]; unsigned p2[4];
#pragma unroll
        for (int q = 0; q < 4; ++q) { rec[q] = *(const f32x4*)(tokrec + (size_t)(r0 + q) * 4); p2[q] = ((const unsigned*)(ws + OFF_GATES))[r0 + q]; }
        f32x4 a[4][4]; u32x4 ya[4][4];
#pragma unroll
        for (int q = 0; q < 4; ++q) { const unsigned ee = __float_as_uint(rec[q][0]); const int e1 = ee & 255, e2 = (ee >> 8) & 255; const unsigned p1 = __float_as_uint(rec[q][2]);
            const bf16_t* y1 = y + ((size_t)sbase[e1] + p1) * DM; const bf16_t* y2 = y + ((size_t)sbase[e2] + p2[q]) * DM;
            ld_row_bf16((const bf16_t*)(P.ws + OFF_RES) + (size_t)(r0 + q) * DM, lane, a[q]);
            ya[q][0] = *(const u32x4*)(y1 + lane * 8); ya[q][1] = *(const u32x4*)(y1 + 512 + lane * 8); ya[q][2] = *(const u32x4*)(y2 + lane * 8); ya[q][3] = *(const u32x4*)(y2 + 512 + lane * 8); }
#pragma unroll
        for (int q = 0; q < 4; ++q) { const float w1 = rec[q][1], w2 = rec[q][3]; bf16_t* xr = (bf16_t*)(P.ws + ((P.sub & 256) ? OFF_PROJ : OFF_RES)) + (size_t)(r0 + q) * DM;
#pragma unroll
            for (int e = 0; e < 2; ++e) { a[q][0][2 * e] += w1 * bflo(ya[q][0][e]) + w2 * bflo(ya[q][2][e]); a[q][0][2 * e + 1] += w1 * bfhi(ya[q][0][e]) + w2 * bfhi(ya[q][2][e]);
                a[q][1][2 * e] += w1 * bflo(ya[q][0][2 + e]) + w2 * bflo(ya[q][2][2 + e]); a[q][1][2 * e + 1] += w1 * bfhi(ya[q][0][2 + e]) + w2 * bfhi(ya[q][2][2 + e]);
                a[q][2][2 * e] += w1 * bflo(ya[q][1][e]) + w2 * bflo(ya[q][3][e]); a[q][2][2 * e + 1] += w1 * bfhi(ya[q][1][e]) + w2 * bfhi(ya[q][3][e]);
                a[q][3][2 * e] += w1 * bflo(ya[q][1][2 + e]) + w2 * bflo(ya[q][3][2 + e]); a[q][3][2 * e + 1] += w1 * bfhi(ya[q][1][2 + e]) + w2 * bfhi(ya[q][3][2 + e]); }
            st_row_bf16(xr, lane, a[q]);
            norm_row_store(a[q][0], a[q][1], a[q][2], a[q][3], P.norm_ple_g, lane, ((P.sub & 256) ? (bf16_t*)(P.ws + OFF_STATE) : hp) + (size_t)(r0 + q) * DM); }
    }
}
__device__ __forceinline__ void phase_ple(const Params& P, char* lds) {
    unsigned char* ws = P.ws; const bf16_t* hp = (const bf16_t*)(ws + OFF_XN); const bf16_t* pb = (const bf16_t*)(ws + OFF_PB); bf16_t* pe = (bf16_t*)(ws + ((P.sub & 256) ? OFF_STATE : OFF_PE)); bf16_t* res = (bf16_t*)(ws + OFF_RES); bf16_t* xout = (bf16_t*)(ws + ((P.sub & 256) ? OFF_XC : OFF_RES));
    const int G = gridDim.x, xs = xcd_slot();
    g8::phase((LAS unsigned char*)lds,
      [&](int i, g8::Unit& u) { const int id = xs + (i >> 1) * G; if (id >= 128 * 4) return false; const int mt = id >> 2, nt = id & 3; u.gather = nullptr; u.nvalid = 0; u.i0 = mt; u.i1 = nt; u.i2 = i & 1;
          if (i & 1) { u.A = (const char*)(hp + (size_t)mt * 256 * DM); u.B = (const char*)((const bf16_t*)(ws + OFF_WPG) + (size_t)nt * 256 * DM); u.K = DM; }
          else { u.A = (const char*)(pb + (size_t)mt * 256 * 256); u.B = (const char*)((const bf16_t*)(ws + OFF_WPLE) + (size_t)nt * 256 * 256); u.K = 256; }
          return true; },
      [&](const f32x4 (&acc)[2][2][4][2], const g8::Unit& u, int wr, int wc, int fr, int fq) {
        const int m0 = u.i0 * 256, n0 = u.i1 * 256;
#pragma unroll
        for (int ai = 0; ai < 2; ++ai)
#pragma unroll
          for (int m = 0; m < 4; ++m) { const size_t row = m0 + 128 * ai + 64 * wr + 16 * m + fr;
#pragma unroll
            for (int bj = 0; bj < 2; ++bj)
#pragma unroll
              for (int n = 0; n < 2; ++n) { const int col = n0 + 128 * bj + 32 * wc + 16 * n + 4 * fq;
                if (!u.i2) st4bf(pe + row * DM + col, acc[ai][bj][m][n]);
                else { const u32x2 pw = *(const u32x2*)(pe + row * DM + col); const u32x2 xw = *(const u32x2*)(res + row * DM + col); f32x4 xv = (f32x4){bflo(xw.x), bfhi(xw.x), bflo(xw.y), bfhi(xw.y)}; const f32x4 a = acc[ai][bj][m][n];
                    xv[0] += bflo(pw.x) * sigmf(a[0]); xv[1] += bfhi(pw.x) * sigmf(a[1]); xv[2] += bflo(pw.y) * sigmf(a[2]); xv[3] += bfhi(pw.y) * sigmf(a[3]);
                    st4bf(xout + row * DM + col, xv); } } }
      });
}
__device__ __forceinline__ void phase_final(const Params& P) {
    const int tid = threadIdx.x, lane = tid & 63, wv = tid >> 6; const float* g = P.final_g;
    const f32x4 g0 = *(const f32x4*)(g + lane * 8), g1 = *(const f32x4*)(g + lane * 8 + 4), g2 = *(const f32x4*)(g + 512 + lane * 8), g3 = *(const f32x4*)(g + 512 + lane * 8 + 4);
    for (int r0 = (blockIdx.x * 8 + wv) * 4; r0 < T_TOK; r0 += gridDim.x * 8 * 4) {
        f32x4 a[4][4];
#pragma unroll
        for (int q = 0; q < 4; ++q) ld_row_bf16((const bf16_t*)(P.ws + OFF_RES) + (size_t)(r0 + q) * DM, lane, a[q]);
#pragma unroll
        for (int q = 0; q < 4; ++q) { float* xr = ((P.sub & 256) ? (float*)(P.ws + OFF_XC) : P.out) + (size_t)(r0 + q) * DM; float ss = 0.f;
#pragma unroll
            for (int e = 0; e < 4; ++e) ss += a[q][0][e] * a[q][0][e] + a[q][1][e] * a[q][1][e] + a[q][2][e] * a[q][2][e] + a[q][3][e] * a[q][3][e];
            ss = wsum(ss); const float r = rsqrtf(ss * (1.0f / DM) + EPS);
            *(f32x4*)(xr + lane * 8) = a[q][0] * r * g0; *(f32x4*)(xr + lane * 8 + 4) = a[q][1] * r * g1; *(f32x4*)(xr + 512 + lane * 8) = a[q][2] * r * g2; *(f32x4*)(xr + 512 + lane * 8 + 4) = a[q][3] * r * g3; } }
}
constexpr int NPHASE = 11;
constexpr int LDS_BYTES = 144 * 1024;
__global__ void __launch_bounds__(512, 2) mk_fwd(Params P) {
    extern __shared__ __attribute__((aligned(16))) char lds[];
    volatile LAS unsigned* xbw = (volatile LAS unsigned*)(LAS char*)(lds + LDS_BYTES - 16);
    if (threadIdx.x == 0) { xbw[0] = 0u; xbw[1] = 0u; xbw[2] = 0u; xbw[3] = 0u; }
    __syncthreads();
    XcdBarrier bar = xcd_barrier_post((unsigned*)(P.ws + OFF_BAR), xbw);
    const int lo = P.ph_lo, hi = P.ph_hi;
#define PH(k) (lo <= (k) && (k) < hi)
#define SEAM(k) if (lo <= (k) && (k) + 1 < hi) xcd_barrier(bar)
    if (PH(0)) phase_prep(P, lds);
    SEAM(0);
    if (PH(1) && !(P.sub & 8)) phase_inproj(P, lds);
    SEAM(1);
    if (PH(2)) { for (int u = blockIdx.x; u < 256; u += gridDim.x) { mla_unit(P, u >> 1, u & 1, lds); mlstm_unit1(P, u, lds); } }
    SEAM(2);
    if (PH(3)) {
        if (!(P.sub & 1)) for (int u = blockIdx.x; u < 512; u += gridDim.x) { const int x = u & 7, kk = u >> 3, bh = x + 8 * (kk >> 4), j = kk & 15;
#pragma unroll 1
            for (int hf = 0; hf < 2; ++hf) attn_unit(P, bh >> 3, bh & 7, hf ? 31 - j : j, lds); }
        if (!(P.sub & 2)) for (int u = blockIdx.x; u < 256; u += gridDim.x) mlstm_unit2(P, u, lds);
    }
    SEAM(3);
    if (PH(4)) phase_outproj(P, lds);
    SEAM(4);
    if (PH(5)) phase_router(P, lds);
    SEAM(5);
    if (PH(6)) phase_moe_gu(P, lds);
    SEAM(6);
    if (PH(7)) phase_moe_down(P, lds);
    SEAM(7);
    if (PH(8)) phase_combine(P, lds);
    SEAM(8);
    if (PH(9)) phase_ple(P, lds);
    SEAM(9);
    if (PH(10)) phase_final(P);
}

#ifndef DUP_PHASE
#define DUP_PHASE -1
#endif
#ifndef DUP_REPS
#define DUP_REPS 2
#endif
#ifndef DUP_SUB
#define DUP_SUB 0
#endif
#ifndef DBG_PHASES
#define DBG_PHASES 0
#endif
#ifndef DBG_OFF
#define DBG_OFF OFF_MQ
#endif
#ifndef DBG_LD
#define DBG_LD 512
#endif
#ifndef DBG_C0
#define DBG_C0 0
#endif
#ifndef DBG_NC
#define DBG_NC 512
#endif
#ifndef DBG_ROWS
#define DBG_ROWS T_TOK
#endif
__global__ void __launch_bounds__(256) dbg_dump(const bf16_t* src, float* out) {
    for (size_t i = (size_t)blockIdx.x * 256 + threadIdx.x; i < (size_t)T_TOK * DM; i += (size_t)gridDim.x * 256) { const size_t r = i / DM; const int c = (int)(i % DM); float a = 0.f;
        for (size_t rr = r; rr < (size_t)DBG_ROWS; rr += T_TOK) for (int cc = c; cc < DBG_NC; cc += DM) a += bf2f(src[rr * DBG_LD + DBG_C0 + cc]);
        out[i] = a; }
}
extern "C" void kernel_launch(void* const* d_in, const int* in_sizes, int n_in, void* d_out, int out_size, void* d_ws, size_t ws_size, hipStream_t stream) {
    static int grid = 0;
    if (grid == 0) {
        if (n_in != 31 || in_sizes[0] != T_TOK * DM || out_size != T_TOK * DM || ws_size < WS_END) { fprintf(stderr, "kernel_launch: unexpected shapes (n_in %d, ws %zu < %zu)\n", n_in, ws_size, (size_t)WS_END); grid = -1; return; }
        int dev = 0, cus = 0, per_cu = 0;
        if (hipGetDevice(&dev) != hipSuccess || hipDeviceGetAttribute(&cus, hipDeviceAttributeMultiprocessorCount, dev) != hipSuccess) { grid = -1; return; }
        if (hipFuncSetAttribute((const void*)mk_fwd, hipFuncAttributeMaxDynamicSharedMemorySize, LDS_BYTES) != hipSuccess) { fprintf(stderr, "kernel_launch: hipFuncSetAttribute failed\n"); grid = -1; return; }
        if (hipOccupancyMaxActiveBlocksPerMultiprocessor(&per_cu, (const void*)mk_fwd, 512, LDS_BYTES) != hipSuccess || per_cu < 1) fprintf(stderr, "kernel_launch: occupancy query reports %d\n", per_cu);
        (void)hipGetLastError();
        grid = cus;
    }
    if (grid < 0) return;
    (void)hipMemsetAsync(d_ws, 0, CTL_BYTES, stream);
    Params P{};
    P.x = (const float*)d_in[0]; P.p = (const float*)d_in[1]; P.pos = (const int*)d_in[2];
    P.norm_mix_g = (const float*)d_in[3]; P.w_in = (const float*)d_in[4]; P.q_norm_g = (const float*)d_in[5]; P.w_uq = (const float*)d_in[6]; P.kv_norm_g = (const float*)d_in[7]; P.w_ukv = (const float*)d_in[8];
    P.conv_w = (const float*)d_in[9]; P.conv_b = (const float*)d_in[10]; P.w_mq = (const float*)d_in[11]; P.w_mk = (const float*)d_in[12]; P.w_mv = (const float*)d_in[13];
    P.b_igate = (const float*)d_in[14]; P.b_fgate = (const float*)d_in[15]; P.mh_norm_g = (const float*)d_in[16]; P.ml_skip = (const float*)d_in[17]; P.w_o = (const float*)d_in[18];
    P.norm_ffn_g = (const float*)d_in[19]; P.w_rg = (const float*)d_in[20]; P.b_rg = (const float*)d_in[21]; P.w_re = (const float*)d_in[22]; P.b_re = (const float*)d_in[23];
    P.w_gate_e = (const float*)d_in[24]; P.w_up_e = (const float*)d_in[25]; P.w_down_e = (const float*)d_in[26]; P.norm_ple_g = (const float*)d_in[27]; P.w_ple = (const float*)d_in[28]; P.w_pg = (const float*)d_in[29]; P.final_g = (const float*)d_in[30];
    P.out = (float*)d_out; P.ws = (unsigned char*)d_ws;
#if DBG_PHASES
    for (int k = 0; k < DBG_PHASES; ++k) { P.ph_lo = k; P.ph_hi = k + 1; hipLaunchKernelGGL(mk_fwd, dim3(grid), dim3(512), LDS_BYTES, stream, P); }
    hipLaunchKernelGGL(dbg_dump, dim3(2048), dim3(256), 0, stream, (const bf16_t*)((unsigned char*)d_ws + DBG_OFF), (float*)d_out);
#elif MK_MULTI
    for (int k = 0; k < NPHASE; ++k) { P.ph_lo = k; P.ph_hi = k + 1;
        if (k == DUP_PHASE) for (int r = 0; r < DUP_REPS; ++r) { P.sub = DUP_SUB; hipLaunchKernelGGL(mk_fwd, dim3(grid), dim3(512), LDS_BYTES, stream, P); }
        P.sub = 0; hipLaunchKernelGGL(mk_fwd, dim3(grid), dim3(512), LDS_BYTES, stream, P); }
#else
    P.ph_lo = 0; P.ph_hi = NPHASE; hipLaunchKernelGGL(mk_fwd, dim3(grid), dim3(512), LDS_BYTES, stream, P);
#endif
}
```

```cpp
#include <hip/hip_runtime.h>
#include <cstdio>
#include <cstdint>

#ifndef MK_MULTI
#define MK_MULTI 0
#endif

typedef unsigned short bf16_t;
typedef short bf16x8 __attribute__((ext_vector_type(8)));
typedef short s16x4 __attribute__((ext_vector_type(4)));
typedef float f32x4 __attribute__((ext_vector_type(4)));
typedef float f32x16 __attribute__((ext_vector_type(16)));
typedef unsigned u32x4 __attribute__((ext_vector_type(4)));
typedef unsigned u32x2 __attribute__((ext_vector_type(2)));
#define LAS __attribute__((address_space(3)))
typedef LAS const char* lds_cptr;
typedef short v4i16_t __attribute__((ext_vector_type(4)));

constexpr int T_TOK = 32768, DM = 1024, SEQ = 8192, NB = 4;
constexpr int INW = 1448, INWP = 1536;
constexpr int C_CQ = 0, C_CKV = 256, C_KR = 384, C_XM = 416, C_Z = 928, C_IG = 1440;
constexpr int QW = 768, KW = 768, VW = 512;
constexpr int NEXP = 32, DEXP = 256;
constexpr int PROWS = 65536 + 32 * 256;
constexpr float EPS = 1e-6f;
constexpr float QSCALE = 0.10206207261596577f * 1.4426950408889634f;

constexpr size_t MiB = 1ull << 20;
constexpr size_t OFF_BAR = 0;
constexpr size_t OFF_CNT = 16384;
constexpr size_t CTL_BYTES = 32768;
constexpr size_t OFF_WIN = 1 * MiB;
constexpr size_t OFF_WUQ = OFF_WIN + (size_t)INWP * 1024 * 2;
constexpr size_t OFF_WUKV = OFF_WUQ + 768 * 256 * 2;
constexpr size_t OFF_WM = OFF_WUKV + 1024 * 128 * 2;
constexpr size_t OFF_WO = OFF_WM + 12 * 128 * 128 * 2;
constexpr size_t OFF_WR = OFF_WO + 1024 * 1024 * 2;
constexpr size_t OFF_WGU = OFF_WR + 128 * 1024 * 2;
constexpr size_t OFF_WD = OFF_WGU + (size_t)32 * 512 * 1024 * 2;
constexpr size_t OFF_WPLE = OFF_WD + (size_t)32 * 1024 * 256 * 2;
constexpr size_t OFF_WPG = OFF_WPLE + 1024 * 256 * 2;
constexpr size_t OFF_ROPE = OFF_WPG + 1024 * 1024 * 2;
constexpr size_t OFF_PB = OFF_ROPE + (size_t)T_TOK * 32 * 4;
constexpr size_t OFF_GATES = OFF_PB + (size_t)T_TOK * 256 * 2;
constexpr size_t OFF_CSTAT = OFF_GATES + (size_t)T_TOK * 8 * 4;
constexpr size_t OFF_NST = OFF_CSTAT + 2048 * 2 * 4;
constexpr size_t OFF_MST = OFF_NST + 256 * 8 * 128 * 4;
constexpr size_t OFF_TOKREC = OFF_MST + 256 * 8 * 4;
constexpr size_t OFF_LIST = OFF_TOKREC + (size_t)T_TOK * 16;
constexpr size_t OFF_STATIC_END = OFF_LIST + (size_t)32 * T_TOK * 4;
static_assert(OFF_STATIC_END <= 88 * MiB, "static region");
constexpr size_t OFF_PROJ = 88 * MiB;
constexpr size_t OFF_XC = OFF_PROJ + 96 * MiB;
constexpr size_t OFF_MQ = OFF_XC + 32 * MiB;
constexpr size_t OFF_MK = OFF_MQ + 32 * MiB;
constexpr size_t OFF_MV = OFF_MK + 32 * MiB;
constexpr size_t OFF_MIX = OFF_MV + 32 * MiB;
constexpr size_t OFF_XN = OFF_MIX + 64 * MiB;
constexpr size_t OFF_STATE = OFF_XN + 64 * MiB;
constexpr size_t WS_END = OFF_STATE + 64 * MiB;
static_assert(WS_END <= 512 * MiB, "workspace");
constexpr size_t OFF_ACT = OFF_PROJ;
constexpr size_t OFF_Y = OFF_XC;
static_assert(OFF_Y + (size_t)PROWS * 1024 * 2 <= OFF_XN, "y overlay");
constexpr size_t OFF_RES = OFF_STATE;
constexpr size_t OFF_PE = OFF_PROJ;

#define XB_TMO      128
#define XB_XCNT(j)  (256  + 64 * (j))
#define XB_XSUB(j)  (1280 + 64 * (j))
#define XB_XGEN(j)  (2304 + 64 * (j))
#define XB_TOP      3328
#define XB_TOPGEN   3392
#define XCD_BAR_WORDS 3456
#define XB_SPIN_CAP (1u << 18)

__device__ __forceinline__ unsigned xb_ld(unsigned* p)              { return __hip_atomic_load(p, __ATOMIC_RELAXED, __HIP_MEMORY_SCOPE_AGENT); }
__device__ __forceinline__ unsigned xb_add(unsigned* p, unsigned v) { return __hip_atomic_fetch_add(p, v, __ATOMIC_RELAXED, __HIP_MEMORY_SCOPE_AGENT); }
__device__ __forceinline__ unsigned xb_xcc_id() { return (unsigned)__builtin_amdgcn_s_getreg((3 << 11) | 20) & 0xFu; }
#define XB_SPIN(cond, bar) do { unsigned _sp = 0; while (cond) { __builtin_amdgcn_s_sleep(1); \
    if ((++_sp & 255u) == 0u) { if (xb_ld(&(bar)[XB_TMO])) break; if (_sp > XB_SPIN_CAP) { atomicAdd(&(bar)[XB_TMO], 1u); break; } } } } while (0)

struct XcdBarrier { unsigned* bar; unsigned x; volatile LAS unsigned* st; };

__device__ __forceinline__ XcdBarrier xcd_barrier_post(unsigned* bar, volatile LAS unsigned* st) {
    XcdBarrier b; b.bar = bar; b.x = xb_xcc_id(); b.st = st;
    if (threadIdx.x == 0) (void)xb_add(&bar[XB_XCNT(b.x)], 1u);
    return b;
}
__device__ __forceinline__ void xcd_barrier_complete(unsigned* bar, unsigned x, unsigned& nloc, unsigned& nx) {
    const unsigned G = gridDim.x * gridDim.y * gridDim.z;
    unsigned sum, cnt, mine, sp = 0u;
    for (;;) {
        sum = 0u; cnt = 0u; mine = 0u;
#pragma unroll
        for (unsigned j = 0; j < 16; ++j) { const unsigned c = xb_ld(&bar[XB_XCNT(j)]); sum += c; cnt += (c > 0u) ? 1u : 0u; mine = (j == x) ? c : mine; }
        if (sum == G) break;
        __builtin_amdgcn_s_sleep(1);
        if ((++sp & 255u) == 0u) { if (xb_ld(&bar[XB_TMO])) break; if (sp > XB_SPIN_CAP) { atomicAdd(&bar[XB_TMO], 1u); break; } }
    }
    nloc = mine > 0u ? mine : 1u; nx = cnt > 0u ? cnt : 1u;
}
__device__ __forceinline__ void xcd_barrier(const XcdBarrier& b) {
    asm volatile("s_waitcnt vmcnt(0)" ::: "memory");
    __syncthreads();
    if (threadIdx.x == 0) {
        unsigned* bar = b.bar;
        __builtin_amdgcn_s_waitcnt(0);
        unsigned nloc = b.st[0], nx = b.st[1];
        if (nloc == 0u) { xcd_barrier_complete(bar, b.x, nloc, nx); b.st[0] = nloc; b.st[1] = nx; }
        const unsigned old = xb_add(&bar[XB_XSUB(b.x)], 1u);
        const unsigned gen = old / nloc;
        if (old + 1u == (gen + 1u) * nloc) {
            __builtin_amdgcn_fence(__ATOMIC_RELEASE, "agent");
            asm volatile("s_waitcnt vmcnt(0)" ::: "memory");
            const unsigned og = xb_add(&bar[XB_TOP], 1u);
            const unsigned tg = og / nx;
            if (og + 1u == (tg + 1u) * nx) xb_add(&bar[XB_TOPGEN], 1u);
            else XB_SPIN(xb_ld(&bar[XB_TOPGEN]) == tg, bar);
            __builtin_amdgcn_fence(__ATOMIC_ACQUIRE, "agent");
            xb_add(&bar[XB_XGEN(b.x)], 1u);
            asm volatile("s_waitcnt vmcnt(0)" ::: "memory");
        } else {
            XB_SPIN(xb_ld(&bar[XB_XGEN(b.x)]) == gen, bar);
            __builtin_amdgcn_fence(__ATOMIC_ACQUIRE, "agent");
            asm volatile("s_waitcnt vmcnt(0)" ::: "memory");
        }
    }
    __syncthreads();
}

typedef __bf16 bf16x2_t __attribute__((ext_vector_type(2)));
typedef float f32x2 __attribute__((ext_vector_type(2)));
__device__ __forceinline__ unsigned cvtpk(float lo, float hi) { f32x2 v = {lo, hi}; bf16x2_t b = __builtin_convertvector(v, bf16x2_t); return __builtin_bit_cast(unsigned, b); }
__device__ __forceinline__ float bf2f(unsigned short v) { return __uint_as_float((unsigned)v << 16); }
__device__ __forceinline__ float bflo(unsigned w) { return __uint_as_float(w << 16); }
__device__ __forceinline__ float bfhi(unsigned w) { return __uint_as_float(w & 0xffff0000u); }
__device__ __forceinline__ void st4bf(bf16_t* p, f32x4 v) { u32x2 w; w.x = cvtpk(v[0], v[1]); w.y = cvtpk(v[2], v[3]); *(u32x2*)p = w; }
__device__ __forceinline__ float wsum(float v) {
#pragma unroll
    for (int o = 32; o > 0; o >>= 1) v += __shfl_xor(v, o);
    return v; }
__device__ __forceinline__ float wmax(float v) {
#pragma unroll
    for (int o = 32; o > 0; o >>= 1) v = fmaxf(v, __shfl_xor(v, o));
    return v; }
__device__ __forceinline__ float siluf(float v) { return v / (1.f + __expf(-v)); }
__device__ __forceinline__ float sigmf(float v) { return 1.f / (1.f + __expf(-v)); }
__device__ __forceinline__ void glds16(const void* g, unsigned lds_base) {
    unsigned sv; asm volatile("s_mov_b32 %0, m0\n\ts_mov_b32 m0, %2\n\ts_nop 0\n\tglobal_load_lds_dwordx4 %1, off\n\ts_mov_b32 m0, %0" : "=&s"(sv) : "v"(g), "s"(lds_base) : "memory"); }
__device__ __forceinline__ const void* rfl_ptr(const void* p) { const unsigned long long v = (unsigned long long)p; const unsigned lo = __builtin_amdgcn_readfirstlane((unsigned)v), hi = __builtin_amdgcn_readfirstlane((unsigned)(v >> 32)); return (const void*)(((unsigned long long)hi << 32) | lo); }
__device__ __forceinline__ void glds16s(const void* sbase, unsigned voff, unsigned lds_base) {
    unsigned sv; asm volatile("s_mov_b32 %0, m0\n\ts_mov_b32 m0, %3\n\ts_nop 0\n\tglobal_load_lds_dwordx4 %1, %2\n\ts_mov_b32 m0, %0" : "=&s"(sv) : "v"(voff), "s"(sbase), "s"(lds_base) : "memory"); }
#define RFL(x) __builtin_amdgcn_readfirstlane(x)
#define MFMA16(a, b, c) __builtin_amdgcn_mfma_f32_16x16x32_bf16(a, b, c, 0, 0, 0)
#define MFMA32(a, b, c) __builtin_amdgcn_mfma_f32_32x32x16_bf16(a, b, c, 0, 0, 0)
#define WAITVM0() asm volatile("s_waitcnt vmcnt(0)" ::: "memory")
#define WAITLGKM0() asm volatile("s_waitcnt lgkmcnt(0)" ::: "memory")
__device__ __forceinline__ int crow(int r, int hi) { return (r & 3) + 8 * (r >> 2) + 4 * hi; }
__device__ __forceinline__ s16x4 vtr(lds_cptr p) { return __builtin_bit_cast(s16x4, __builtin_amdgcn_ds_read_tr16_b64_v4i16((LAS v4i16_t*)p)); }
__device__ __forceinline__ bf16x8 cat8(s16x4 a, s16x4 b) { return (bf16x8){a[0], a[1], a[2], a[3], b[0], b[1], b[2], b[3]}; }

__device__ __forceinline__ int xcd_slot() { const int G = gridDim.x, b = blockIdx.x; return (G & 7) ? b : (b & 7) * (G >> 3) + (b >> 3); }
struct Params {
    const float* x; const float* p; const int* pos;
    const float *norm_mix_g, *w_in, *q_norm_g, *w_uq, *kv_norm_g, *w_ukv, *conv_w, *conv_b, *w_mq, *w_mk, *w_mv, *b_igate, *b_fgate,
                *mh_norm_g, *ml_skip, *w_o, *norm_ffn_g, *w_rg, *b_rg, *w_re, *b_re, *w_gate_e, *w_up_e, *w_down_e, *norm_ple_g, *w_ple, *w_pg, *final_g;
    float* out; unsigned char* ws; int ph_lo, ph_hi, sub, pad;
};

constexpr int G_STAGE = 49152;
constexpr int LDS_GEMM = 2 * G_STAGE;
struct GDesc { const bf16_t* a0; const bf16_t* a1; const int* gather; const bf16_t* bt; int ld0, ld1, ksplit, m0, nvalid, ldb, nk; };
__device__ __forceinline__ GDesc gdesc(const bf16_t* a, int lda, int m0, const bf16_t* bt, int ldb, int nk) {
    GDesc d; d.a0 = a; d.a1 = a; d.gather = nullptr; d.bt = bt; d.ld0 = lda; d.ld1 = lda; d.ksplit = 1 << 30; d.m0 = m0; d.nvalid = 0; d.ldb = ldb; d.nk = nk; return d; }
template <int MT> __device__ __forceinline__ void g_rows(const GDesc& d, int (&rows)[MT]) {
    const int lane = threadIdx.x & 63, wid = RFL(threadIdx.x >> 6);
#pragma unroll
    for (int i = 0; i < MT; ++i) { const int r = i * 64 + wid * 8 + (lane >> 3); rows[i] = d.gather ? (r < d.nvalid ? d.gather[r] : 0) : d.m0 + r; }
}
template <int MT> __device__ __forceinline__ void g_stage(const GDesc& d, const int (&rows)[MT], int kt, int buf, unsigned lds0) {
    const int lane = threadIdx.x & 63, wid = RFL(threadIdx.x >> 6); const int cch = (lane & 7) ^ (lane >> 3);
    const bf16_t* ab = d.a0; int ld = d.ld0, kk = kt;
    if (kt >= d.ksplit) { ab = d.a1; ld = d.ld1; kk = kt - d.ksplit; }
#pragma unroll
    for (int i = 0; i < MT; ++i) glds16(ab + (size_t)rows[i] * ld + kk * 64 + cch * 8, RFL(lds0 + buf * G_STAGE + i * 8192 + wid * 1024));
    const bf16_t* bp = d.bt + (size_t)(wid * 8 + (lane >> 3)) * d.ldb + cch * 8 + kt * 64;
    glds16(bp, RFL(lds0 + buf * G_STAGE + 32768 + wid * 1024));
    glds16(bp + (size_t)64 * d.ldb, RFL(lds0 + buf * G_STAGE + 32768 + 8192 + wid * 1024));
}
template <int MT> __device__ __forceinline__ void g_compute(f32x4 (&acc)[MT][4], const char* sa) {
    const int lane = threadIdx.x & 63, wid = RFL(threadIdx.x >> 6), wr = wid >> 1, wc = wid & 1, fr = lane & 15, fq = lane >> 4;
    const char* sb = sa + 32768;
#pragma unroll
    for (int kk = 0; kk < 2; ++kk) {
        bf16x8 af[MT], bfr[4];
        const int sw = ((4 * kk + fq) ^ (fr & 7)) << 4;
#pragma unroll
        for (int m = 0; m < MT; ++m) af[m] = *(const bf16x8*)(sa + (wr * 16 * MT + 16 * m + fr) * 128 + sw);
#pragma unroll
        for (int n = 0; n < 4; ++n) bfr[n] = *(const bf16x8*)(sb + (wc * 64 + 16 * n + fr) * 128 + sw);
#pragma unroll
        for (int m = 0; m < MT; ++m)
#pragma unroll
            for (int n = 0; n < 4; ++n) acc[m][n] = MFMA16(bfr[n], af[m], acc[m][n]);
    }
}
template <int MT, class DescFn, class EpiFn>
__device__ __forceinline__ void gemm_tiles(int ntiles, DescFn df, EpiFn ef, char* lds) {
    if (ntiles <= 0) return;
    const unsigned lds0 = (unsigned)(uintptr_t)lds;
    GDesc d = df(0); int rows[MT]; g_rows<MT>(d, rows);
    int cur = 0;
    __syncthreads();
    g_stage<MT>(d, rows, 0, 0, lds0);
    for (int t = 0; t < ntiles; ++t) {
        const bool hn = t + 1 < ntiles; GDesc dn = d; int rowsn[MT];
#pragma unroll
        for (int i = 0; i < MT; ++i) rowsn[i] = rows[i];
        if (hn) { dn = df(t + 1); g_rows<MT>(dn, rowsn); }
        f32x4 acc[MT][4];
#pragma unroll
        for (int m = 0; m < MT; ++m)
#pragma unroll
            for (int n = 0; n < 4; ++n) acc[m][n] = (f32x4){0.f, 0.f, 0.f, 0.f};
        for (int kt = 0; kt < d.nk; ++kt) {
            WAITVM0(); __syncthreads();
            if (kt + 1 < d.nk) g_stage<MT>(d, rows, kt + 1, cur ^ 1, lds0); else if (hn) g_stage<MT>(dn, rowsn, 0, cur ^ 1, lds0);
            g_compute<MT>(acc, lds + cur * G_STAGE); cur ^= 1;
        }
        ef(t, acc);
        d = dn;
#pragma unroll
        for (int i = 0; i < MT; ++i) rows[i] = rowsn[i];
    }
}
template <int NF> struct G2C { static constexpr int BN = 64 * NF, A_BYTES = 16384, B_BYTES = BN * 64, STAGE = A_BYTES + B_BYTES, DPS = 2 + NF / 2; };
template <int NF> __device__ __forceinline__ void g2_offs(const GDesc& d, unsigned (&ao)[2], unsigned (&bo)[NF / 2]) {
    const int lane = threadIdx.x & 63, wid = RFL(threadIdx.x >> 6); const unsigned cch = (unsigned)((lane & 3) ^ ((0 - (lane >> 4)) & 3)) * 16u;
#pragma unroll
    for (int i = 0; i < 2; ++i) { const int r = 16 * (i * 8 + wid) + (lane >> 2); const int gr = d.gather ? (r < d.nvalid ? d.gather[r] : 0) : d.m0 + r; ao[i] = (unsigned)gr * (unsigned)(d.ld0 * 2) + cch; }
#pragma unroll
    for (int i = 0; i < NF / 2; ++i) bo[i] = (unsigned)(16 * (i * 8 + wid) + (lane >> 2)) * (unsigned)(d.ldb * 2) + cch;
}
template <int NF> __device__ __forceinline__ void g2_piece(const GDesc& d, const unsigned (&ao)[2], const unsigned (&bo)[NF / 2], int kt, int slot, unsigned lds0, int p) {
    const int wid = RFL(threadIdx.x >> 6);
    const unsigned sb = lds0 + slot * G2C<NF>::STAGE;
    if (p < 2) { const bf16_t* ab = d.a0; int kk = kt;
        if (kt >= d.ksplit) { ab = d.a1; kk = kt - d.ksplit; }
        glds16s(rfl_ptr(ab + kk * 32), ao[p], RFL(sb + (p * 8 + wid) * 1024));
    } else { const int i = p - 2; glds16s(rfl_ptr(d.bt + kt * 32), bo[i], RFL(sb + 16384 + (i * 8 + wid) * 1024)); }
}
template <int N> __device__ __forceinline__ void waitvm() { asm volatile("s_waitcnt vmcnt(%0)" :: "n"(N) : "memory"); }
template <int NF, class DescFn, class EpiFn>
__device__ __forceinline__ void gemm2_tiles(int ntiles, DescFn df, EpiFn ef, char* lds, int dbg = 0) {
    if (ntiles <= 0) return;
    constexpr int DPS = G2C<NF>::DPS, STG = G2C<NF>::STAGE;
    const unsigned lds0 = (unsigned)(uintptr_t)lds;
    const int lane = threadIdx.x & 63, wid = RFL(threadIdx.x >> 6), wr2 = wid >> 2, wc4 = wid & 3, fr = lane & 15, fq = lane >> 4;
    const int sw = (fq ^ ((0 - (fr >> 2)) & 3)) << 4;
    const int aoff = (wr2 * 128 + fr) * 64 + sw, boff = 16384 + (wc4 * 16 * NF + fr) * 64 + sw;
    GDesc dc = df(0), di = dc; unsigned ao[2], bo[NF / 2]; g2_offs<NF>(di, ao, bo);
    int ti = 0, ki = 0, issued = 0, done = 0;
    auto advance = [&]() { ++issued; ++ki; if (ki == di.nk) { ++ti; ki = 0; if (ti < ntiles) { di = df(ti); g2_offs<NF>(di, ao, bo); } } };
#define G2_BAR() do { if (!(dbg & 16)) asm volatile("s_waitcnt lgkmcnt(0)\n\ts_barrier" ::: "memory"); } while (0)
#define G2_WAIT(need) do { const int fly_ = issued - (need) - 1; if (fly_ >= 2) waitvm<2 * DPS>(); else if (fly_ == 1) waitvm<DPS>(); else waitvm<0>(); } while (0)
    __syncthreads();
    for (int q = 0; q < 3; ++q) if (ti < ntiles) {
#pragma unroll
        for (int p = 0; p < DPS; ++p) g2_piece<NF>(di, ao, bo, ki, issued & 3, lds0, p);
        advance(); }
    if (wr2) { G2_WAIT(0); G2_BAR(); }
    bf16x8 fa[8], fb[NF];
    for (int t = 0; t < ntiles; ++t) {
        f32x4 acc[8][NF];
#pragma unroll
        for (int m = 0; m < 8; ++m)
#pragma unroll
            for (int n = 0; n < NF; ++n) acc[m][n] = (f32x4){0.f, 0.f, 0.f, 0.f};
        const int nk = dc.nk;
        for (int kt = 0; kt < nk; ++kt) {
            if (!wr2) G2_WAIT(done);
            G2_BAR();
            { const char* sc = lds + (done & 3) * STG; const bool doi = ti < ntiles && !(dbg & 2); const int islot = issued & 3;
#pragma unroll
              for (int n = 0; n < NF; ++n) fb[n] = *(const bf16x8*)(sc + boff + n * 1024);
#pragma unroll
              for (int m = 0; m < 8; ++m) { fa[m] = *(const bf16x8*)(sc + aoff + m * 1024);
                  if ((m & 1) && (m >> 1) < DPS) { if (doi) g2_piece<NF>(di, ao, bo, ki, islot, lds0, m >> 1); } }
              if (ti < ntiles) advance(); }
            if (wr2) G2_WAIT(done + 1);
            G2_BAR();
            __builtin_amdgcn_s_setprio(1);
            if (!(dbg & 1)) {
#pragma unroll
            for (int m = 0; m < 8; ++m)
#pragma unroll
                for (int n = 0; n < NF; ++n) acc[m][n] = MFMA16(fb[n], fa[m], acc[m][n]); }
            __builtin_amdgcn_s_setprio(0);
            ++done;
        }
        if (!(dbg & 4)) ef(t, acc);
        if (t + 1 < ntiles) dc = (ti == t + 1) ? di : df(t + 1);
    }
    if (!wr2) G2_BAR();
#undef G2_BAR
#undef G2_WAIT
}

namespace g8 {
constexpr int BM = 256, BK = 64, HALF = 128, HTB = HALF * BK * 2;
__device__ __forceinline__ int lds_byte(int r, int c) { const int st = (r >> 4) * 2 + (c >> 5), rr = r & 15, cc = c & 31, ob = rr * 64 + cc * 2; return st * 1024 + (ob ^ (((ob >> 9) & 1) << 5)); }
__device__ __forceinline__ void stage_rc(int b, int& R, int& C) { const int st = b / 1024, sb = b % 1024, swz = sb ^ (((sb >> 9) & 1) << 5); R = (st >> 1) * 16 + swz / 64; C = (st & 1) * 32 + (swz % 64) / 2; }
struct Unit { const char* A; const char* B; const int* gather; int nvalid, K, i0, i1, i2; };
__device__ __forceinline__ void offs(const Unit& u, unsigned (&va)[2][2], unsigned (&vb)[2]) {
#pragma unroll
    for (int i = 0; i < 2; ++i) { int R, C; stage_rc(threadIdx.x * 16 + i * 8192, R, C);
        vb[i] = (unsigned)(R * u.K + C) * 2u;
#pragma unroll
        for (int h = 0; h < 2; ++h) { const int r = h * HALF + R; const int gr = u.gather ? (r < u.nvalid ? u.gather[r] : 0) : r; va[h][i] = (unsigned)(gr * u.K + C) * 2u; } }
}
template <class NextFn, class EpiFn>
__device__ __forceinline__ void phase(LAS unsigned char* lds, NextFn next, EpiFn epi) {
    const int tid = threadIdx.x, wid = __builtin_amdgcn_readfirstlane(tid >> 6), lane = tid & 63, wr = wid >> 2, wc = wid & 3, fr = lane & 15, fq = lane >> 4;
    const unsigned ldsw = (unsigned)wid * 1024u;
    const int aoff = lds_byte(wr * 64 + fr, fq * 8), boff = lds_byte(wc * 32 + fr, fq * 8);
#define G8_SA(b, h) (((b) * 2 + (h)) * HTB)
#define G8_SB(b, h) ((4 + (b) * 2 + (h)) * HTB)
#define G8_STAGE(bufoff, gbase, voff) do { _Pragma("unroll") for (int _i = 0; _i < 2; ++_i) \
        __builtin_amdgcn_global_load_lds((const unsigned*)((const char*)(gbase) + (voff)[_i]), (LAS unsigned*)(lds + (bufoff) + ldsw + _i * 8192), 16, 0, 0); } while (0)
#define G8_LDA(dst, b, h) do { _Pragma("unroll") for (int m = 0; m < 4; ++m) _Pragma("unroll") for (int k = 0; k < 2; ++k) dst[m][k] = *(const LAS bf16x8*)(lds + G8_SA(b, h) + aoff + m * 2048 + k * 1024); } while (0)
#define G8_LDB(dst, b, h) do { _Pragma("unroll") for (int n = 0; n < 2; ++n) _Pragma("unroll") for (int k = 0; k < 2; ++k) dst[n][k] = *(const LAS bf16x8*)(lds + G8_SB(b, h) + boff + n * 2048 + k * 1024); } while (0)
#define G8_MMA(ai, bj, At, Bt) do { __builtin_amdgcn_s_setprio(1); _Pragma("unroll") for (int m = 0; m < 4; ++m) _Pragma("unroll") for (int n = 0; n < 2; ++n) _Pragma("unroll") for (int k = 0; k < 2; ++k) \
        acc[ai][bj][m][n] = __builtin_amdgcn_mfma_f32_16x16x32_bf16(Bt[n][k], At[m][k], acc[ai][bj][m][n], 0, 0, 0); __builtin_amdgcn_s_setprio(0); } while (0)
#define G8_WAIT_V(n) asm volatile("s_waitcnt vmcnt(" #n ")" ::: "memory")
#define G8_WAIT_L(n) asm volatile("s_waitcnt lgkmcnt(" #n ")" ::: "memory")
#define G8_BAR __builtin_amdgcn_s_barrier()
#define G8_SCHED __builtin_amdgcn_sched_barrier(0)
    Unit cur, nxt; int ui = 0;
    if (!next(0, cur)) return;
    f32x4 acc[2][2][4][2];
#pragma unroll
    for (int a = 0; a < 2; ++a)
#pragma unroll
        for (int b = 0; b < 2; ++b)
#pragma unroll
            for (int m = 0; m < 4; ++m)
#pragma unroll
                for (int n = 0; n < 2; ++n) acc[a][b][m][n] = (f32x4){0.f, 0.f, 0.f, 0.f};
    bf16x8 At[4][2], B0[2][2], B1[2][2];
    unsigned vaC[2][2], vbC[2], vaN[2][2], vbN[2];
    offs(cur, vaC, vbC);
    const size_t kstep = (size_t)(BK * 2);
    __syncthreads();
    { const char* cA = cur.A; const char* cB = cur.B; const size_t hsB = (size_t)HALF * cur.K * 2;
      G8_STAGE(G8_SB(0, 0), cB, vbC); G8_STAGE(G8_SA(0, 0), cA, vaC[0]); G8_STAGE(G8_SB(0, 1), cB + hsB, vbC); G8_STAGE(G8_SA(0, 1), cA, vaC[1]);
      if (wr == 1) G8_BAR;
      G8_WAIT_V(4); G8_BAR;
      G8_STAGE(G8_SB(1, 0), cB + kstep, vbC); G8_STAGE(G8_SA(1, 0), cA + kstep, vaC[0]); G8_STAGE(G8_SB(1, 1), cB + hsB + kstep, vbC);
      G8_WAIT_V(6); G8_BAR; }
    for (;;) {
        const bool has_next = next(ui + 1, nxt);
        if (has_next) offs(nxt, vaN, vbN);
        else {
#pragma unroll
            for (int i = 0; i < 2; ++i) { vbN[i] = vbC[i]; vaN[0][i] = vaC[0][i]; vaN[1][i] = vaC[1][i]; } }
        const char* cA = cur.A; const char* cB = cur.B; const size_t hsB = (size_t)HALF * cur.K * 2;
        const char* nA = has_next ? nxt.A : cA; const char* nB = has_next ? nxt.B : cB; const size_t hsN = has_next ? (size_t)HALF * nxt.K * 2 : hsB;
        const int nt = cur.K / BK;
        for (int t = 0; t < nt; t += 2) {
            const bool last = (t == nt - 2);
            const char* a1 = cA + (size_t)(t + 1) * kstep;
            const char* a2 = last ? nA : cA + (size_t)(t + 2) * kstep; const char* b2 = last ? nB : cB + (size_t)(t + 2) * kstep;
            const char* a3 = a2 + kstep; const char* b3 = b2 + kstep; const size_t hs2 = last ? hsN : hsB;
            unsigned va2[2][2], vb2[2];
#pragma unroll
            for (int i = 0; i < 2; ++i) { vb2[i] = last ? vbN[i] : vbC[i]; va2[0][i] = last ? vaN[0][i] : vaC[0][i]; va2[1][i] = last ? vaN[1][i] : vaC[1][i]; }
            G8_LDB(B0, 0, 0); G8_SCHED; G8_LDA(At, 0, 0); G8_STAGE(G8_SA(1, 1), a1, vaC[1]);
            G8_WAIT_L(8); G8_BAR; G8_WAIT_L(0); G8_MMA(0, 0, At, B0); G8_BAR; G8_SCHED;
            G8_LDB(B1, 0, 1); G8_STAGE(G8_SB(0, 0), b2, vb2);
            G8_BAR; G8_WAIT_L(0); G8_MMA(0, 1, At, B1); G8_BAR;
            G8_LDA(At, 0, 1); G8_STAGE(G8_SA(0, 0), a2, va2[0]);
            G8_BAR; G8_WAIT_L(0); G8_MMA(1, 0, At, B0); G8_BAR; G8_SCHED;
            G8_STAGE(G8_SB(0, 1), b2 + hs2, vb2);
            G8_WAIT_V(6); G8_BAR; G8_MMA(1, 1, At, B1); G8_BAR;
            G8_LDB(B0, 1, 0); G8_SCHED; G8_LDA(At, 1, 0); G8_STAGE(G8_SA(0, 1), a2, va2[1]);
            G8_WAIT_L(8); G8_BAR; G8_WAIT_L(0); G8_MMA(0, 0, At, B0); G8_BAR; G8_SCHED;
            G8_LDB(B1, 1, 1); G8_STAGE(G8_SB(1, 0), b3, vb2);
            G8_BAR; G8_WAIT_L(0); G8_MMA(0, 1, At, B1); G8_BAR;
            G8_LDA(At, 1, 1); G8_STAGE(G8_SA(1, 0), a3, va2[0]);
            G8_BAR; G8_WAIT_L(0); G8_MMA(1, 0, At, B0); G8_BAR; G8_SCHED;
            G8_STAGE(G8_SB(1, 1), b3 + hs2, vb2);
            G8_WAIT_V(6); G8_BAR; G8_MMA(1, 1, At, B1); G8_BAR;
        }
        epi(acc, cur, wr, wc, fr, fq);
        if (!has_next) break;
#pragma unroll
        for (int a = 0; a < 2; ++a)
#pragma unroll
            for (int b = 0; b < 2; ++b)
#pragma unroll
                for (int m = 0; m < 4; ++m)
#pragma unroll
                    for (int n = 0; n < 2; ++n) acc[a][b][m][n] = (f32x4){0.f, 0.f, 0.f, 0.f};
        cur = nxt; ++ui;
#pragma unroll
        for (int i = 0; i < 2; ++i) { vbC[i] = vbN[i]; vaC[0][i] = vaN[0][i]; vaC[1][i] = vaN[1][i]; }
    }
    G8_WAIT_V(0);
    if (wr == 0) G8_BAR;
    G8_BAR;
#undef G8_SA
#undef G8_SB
#undef G8_STAGE
#undef G8_LDA
#undef G8_LDB
#undef G8_MMA
#undef G8_WAIT_V
#undef G8_WAIT_L
#undef G8_BAR
#undef G8_SCHED
}
}


__device__ __forceinline__ void ld_row_bf16(const bf16_t* r, int lane, f32x4 (&a)[4]) {
    const u32x4 lo = *(const u32x4*)(r + lane * 8), hi = *(const u32x4*)(r + 512 + lane * 8);
    a[0] = (f32x4){bflo(lo[0]), bfhi(lo[0]), bflo(lo[1]), bfhi(lo[1])}; a[1] = (f32x4){bflo(lo[2]), bfhi(lo[2]), bflo(lo[3]), bfhi(lo[3])};
    a[2] = (f32x4){bflo(hi[0]), bfhi(hi[0]), bflo(hi[1]), bfhi(hi[1])}; a[3] = (f32x4){bflo(hi[2]), bfhi(hi[2]), bflo(hi[3]), bfhi(hi[3])}; }
__device__ __forceinline__ void st_row_bf16(bf16_t* r, int lane, const f32x4 (&a)[4]) {
    u32x4 lo, hi; lo[0] = cvtpk(a[0][0], a[0][1]); lo[1] = cvtpk(a[0][2], a[0][3]); lo[2] = cvtpk(a[1][0], a[1][1]); lo[3] = cvtpk(a[1][2], a[1][3]);
    hi[0] = cvtpk(a[2][0], a[2][1]); hi[1] = cvtpk(a[2][2], a[2][3]); hi[2] = cvtpk(a[3][0], a[3][1]); hi[3] = cvtpk(a[3][2], a[3][3]);
    *(u32x4*)(r + lane * 8) = lo; *(u32x4*)(r + 512 + lane * 8) = hi; }
__device__ __forceinline__ void norm_row_store_A(const f32x4 (&a)[4], const float* g, int lane, bf16_t* dst) {
    float ss = 0.f;
#pragma unroll
    for (int i = 0; i < 4; ++i)
#pragma unroll
        for (int e = 0; e < 4; ++e) ss += a[i][e] * a[i][e];
    ss = wsum(ss); const float r = rsqrtf(ss * (1.0f / DM) + EPS);
#pragma unroll
    for (int i = 0; i < 4; ++i) { const f32x4 gv = *(const f32x4*)(g + 256 * i + 4 * lane); st4bf(dst + 256 * i + 4 * lane, a[i] * r * gv); }
}
__device__ __forceinline__ void norm_row_store(const f32x4& a0, const f32x4& a1, const f32x4& a2, const f32x4& a3, const float* g, int lane, bf16_t* dst) {
    float ss = 0.f;
#pragma unroll
    for (int e = 0; e < 4; ++e) ss += a0[e] * a0[e] + a1[e] * a1[e] + a2[e] * a2[e] + a3[e] * a3[e];
    ss = wsum(ss); const float r = rsqrtf(ss * (1.0f / DM) + EPS);
    const f32x4 g0 = *(const f32x4*)(g + lane * 8), g1 = *(const f32x4*)(g + lane * 8 + 4), g2 = *(const f32x4*)(g + 512 + lane * 8), g3 = *(const f32x4*)(g + 512 + lane * 8 + 4);
    u32x4 w0, w1;
    w0.x = cvtpk(a0[0] * r * g0[0], a0[1] * r * g0[1]); w0.y = cvtpk(a0[2] * r * g0[2], a0[3] * r * g0[3]); w0.z = cvtpk(a1[0] * r * g1[0], a1[1] * r * g1[1]); w0.w = cvtpk(a1[2] * r * g1[2], a1[3] * r * g1[3]);
    w1.x = cvtpk(a2[0] * r * g2[0], a2[1] * r * g2[1]); w1.y = cvtpk(a2[2] * r * g2[2], a2[3] * r * g2[3]); w1.z = cvtpk(a3[0] * r * g3[0], a3[1] * r * g3[1]); w1.w = cvtpk(a3[2] * r * g3[2], a3[3] * r * g3[3]);
    *(u32x4*)(dst + lane * 8) = w0; *(u32x4*)(dst + 512 + lane * 8) = w1;
}

__device__ __forceinline__ void tr_tile(const float* src, int N, int k0, int n0, bf16_t* dst, int ldd, int mode, float scale, const float* kgain, float* tile) {
    const int tid = threadIdx.x;
    __syncthreads();
#pragma unroll
    for (int i = 0; i < 8; ++i) { const int idx = tid + 512 * i, kk = idx >> 6, nn = idx & 63;
        float v = 0.f; if (n0 + nn < N) v = src[(size_t)(k0 + kk) * N + n0 + nn];
        if (kgain) v *= kgain[k0 + kk];
        tile[kk * 65 + nn] = v * scale; }
    __syncthreads();
#pragma unroll
    for (int i = 0; i < 8; ++i) { const int idx = tid + 512 * i, nn = idx >> 6, kk = idx & 63; const int n = n0 + nn;
        if (n < N) { int r = n; if (mode) r = (n >> 7) * 256 + (mode - 1) * 128 + (n & 127);
            dst[(size_t)r * ldd + k0 + kk] = (bf16_t)(cvtpk(tile[kk * 65 + nn], 0.f) & 0xffffu); } }
}

__device__ __forceinline__ void phase_prep(const Params& P, char* lds) {
    unsigned char* ws = P.ws; float* tile = (float*)lds;
    const int bid = blockIdx.x, nb = gridDim.x, tid = threadIdx.x;
    const int NJ = 12;
    const int cnt[NJ] = {16 * 23, 4 * 12, 2 * 16, 12 * 4, 256, 2048, 2048, 2048, 64, 256, 16, 16};
    int total = 0;
#pragma unroll
    for (int j = 0; j < NJ; ++j) total += cnt[j];
    if (!(P.sub & 16)) for (int u = bid; u < total; u += nb) {
        int j = 0, r = u;
#pragma unroll
        for (int jj = 0; jj < NJ - 1; ++jj) if (j == jj && r >= cnt[jj]) { r -= cnt[jj]; j = jj + 1; }
        switch (j) {
        case 0: tr_tile(P.w_in, INW, (r / 23) * 64, (r % 23) * 64, (bf16_t*)(ws + OFF_WIN), 1024, 0, 1.f, nullptr, tile); break;
        case 1: tr_tile(P.w_uq, 768, (r / 12) * 64, (r % 12) * 64, (bf16_t*)(ws + OFF_WUQ), 256, 0, 1.f, P.q_norm_g, tile); break;
        case 2: tr_tile(P.w_ukv, 1024, (r / 16) * 64, (r % 16) * 64, (bf16_t*)(ws + OFF_WUKV), 128, 0, 1.f, P.kv_norm_g, tile); break;
        case 3: { const int mat = r >> 2, t4 = r & 3, kind = mat >> 2, h = mat & 3; const float* s = (kind == 0 ? P.w_mq : kind == 1 ? P.w_mk : P.w_mv) + h * 16384;
                  tr_tile(s, 128, (t4 >> 1) * 64, (t4 & 1) * 64, (bf16_t*)(ws + OFF_WM) + mat * 16384, 128, 0, kind == 1 ? 0.08838834764831845f : 1.f, nullptr, tile); } break;
        case 4: tr_tile(P.w_o, 1024, (r >> 4) * 64, (r & 15) * 64, (bf16_t*)(ws + OFF_WO), 1024, 0, 1.f, nullptr, tile); break;
        case 5: { const int e = r >> 6, t6 = r & 63; tr_tile(P.w_gate_e + (size_t)e * 1024 * 256, 256, (t6 >> 2) * 64, (t6 & 3) * 64, (bf16_t*)(ws + OFF_WGU) + (size_t)e * 512 * 1024, 1024, 1, 1.f, nullptr, tile); } break;
        case 6: { const int e = r >> 6, t6 = r & 63; tr_tile(P.w_up_e + (size_t)e * 1024 * 256, 256, (t6 >> 2) * 64, (t6 & 3) * 64, (bf16_t*)(ws + OFF_WGU) + (size_t)e * 512 * 1024, 1024, 2, 1.f, nullptr, tile); } break;
        case 7: { const int e = r >> 6, t6 = r & 63; tr_tile(P.w_down_e + (size_t)e * 256 * 1024, 1024, (t6 >> 4) * 64, (t6 & 15) * 64, (bf16_t*)(ws + OFF_WD) + (size_t)e * 1024 * 256, 256, 0, 1.f, nullptr, tile); } break;
        case 8: tr_tile(P.w_ple, 1024, (r >> 4) * 64, (r & 15) * 64, (bf16_t*)(ws + OFF_WPLE), 256, 0, 1.f, nullptr, tile); break;
        case 9: tr_tile(P.w_pg, 1024, (r >> 4) * 64, (r & 15) * 64, (bf16_t*)(ws + OFF_WPG), 1024, 0, 1.f, nullptr, tile); break;
        case 10: tr_tile(P.w_rg, 4, r * 64, 0, (bf16_t*)(ws + OFF_WR), 1024, 0, 1.f, nullptr, tile); break;
        default: tr_tile(P.w_re, 32, r * 64, 0, (bf16_t*)(ws + OFF_WR) + 4 * 1024, 1024, 0, 1.f, nullptr, tile); break;
        }
    }
    { u32x4 z = (u32x4){0u, 0u, 0u, 0u};
      u32x4* a = (u32x4*)((bf16_t*)(ws + OFF_WIN) + (size_t)INW * 1024); const int na = (INWP - INW) * 1024 / 8;
      for (int i = bid * 512 + tid; i < na; i += nb * 512) a[i] = z;
      u32x4* b = (u32x4*)((bf16_t*)(ws + OFF_WR) + 36 * 1024); const int nbz = (128 - 36) * 1024 / 8;
      for (int i = bid * 512 + tid; i < nbz; i += nb * 512) b[i] = z; }
    if (!(P.sub & 128)) { float2* rt = (float2*)(ws + OFF_ROPE);
      for (int i = bid * 512 + tid; i < T_TOK * 16; i += nb * 512) { const int t = i >> 4, j = i & 15;
          const float inv = 1.0f / powf(10000.0f, (float)(2 * j) / 32.0f); const float ang = (float)P.pos[t] * inv; float s, c; sincosf(ang, &s, &c); rt[i] = make_float2(c, s); } }
    if (!(P.sub & 64)) { const f32x4* src = (const f32x4*)P.p; u32x2* dst = (u32x2*)(ws + OFF_PB);
      for (int i = bid * 512 + tid; i < T_TOK * 256 / 4; i += nb * 512) { const f32x4 v = src[i]; u32x2 w; w.x = cvtpk(v[0], v[1]); w.y = cvtpk(v[2], v[3]); dst[i] = w; } }
    if (!(P.sub & 32)) { const int lane = tid & 63, wv = tid >> 6; bf16_t* xn = (bf16_t*)(ws + OFF_XN);
      for (int r0 = (bid * 8 + wv) * 4; r0 < T_TOK; r0 += nb * 8 * 4) {
          f32x4 a[4][4];
#pragma unroll
          for (int q = 0; q < 4; ++q) { const float* xr = P.x + (size_t)(r0 + q) * DM;
#pragma unroll
              for (int i = 0; i < 4; ++i) a[q][i] = *(const f32x4*)(xr + 256 * i + 4 * lane); }
#pragma unroll
          for (int q = 0; q < 4; ++q) norm_row_store_A(a[q], P.norm_mix_g, lane, xn + (size_t)(r0 + q) * DM); } }
}

__device__ __forceinline__ void phase_inproj(const Params& P, char* lds) {
    unsigned char* ws = P.ws; const bf16_t* xn = (const bf16_t*)(ws + OFF_XN); const bf16_t* Wt = (const bf16_t*)(ws + OFF_WIN);
    bf16_t* proj = (bf16_t*)(ws + OFF_PROJ); bf16_t* Kb = (bf16_t*)P.out + (size_t)T_TOK * QW; float* gates = (float*)(ws + OFF_GATES); const float2* rope = (const float2*)(ws + OFF_ROPE);
    const int G = gridDim.x, xs = xcd_slot();
    g8::phase((LAS unsigned char*)lds,
      [&](int i, g8::Unit& u) { const int id = xs + i * G; if (id >= 128 * 6) return false; const int mt = id / 6, nt = id % 6;
          u.A = (const char*)(xn + (size_t)mt * 256 * DM); u.B = (const char*)(Wt + (size_t)nt * 256 * DM); u.gather = nullptr; u.nvalid = 0; u.K = DM; u.i0 = mt; u.i1 = nt; u.i2 = 0; return true; },
      [&](const f32x4 (&acc)[2][2][4][2], const g8::Unit& u, int wr, int wc, int fr, int fq) {
        const int m0 = u.i0 * 256, n0 = u.i1 * 256;
#pragma unroll
        for (int ai = 0; ai < 2; ++ai)
#pragma unroll
          for (int m = 0; m < 4; ++m) { const int row = m0 + 128 * ai + 64 * wr + 16 * m + fr;
#pragma unroll
            for (int bj = 0; bj < 2; ++bj)
#pragma unroll
              for (int n = 0; n < 2; ++n) { const int c16 = n0 + 128 * bj + 32 * wc + 16 * n, col = c16 + 4 * fq;
                if (c16 == C_KR) {
                    const f32x4 x1 = acc[ai][bj][m][0], x2 = acc[ai][bj][m][1]; f32x4 o1, o2;
#pragma unroll
                    for (int e = 0; e < 4; ++e) { const float2 cs = rope[(size_t)row * 16 + 4 * fq + e]; o1[e] = x1[e] * cs.x - x2[e] * cs.y; o2[e] = x1[e] * cs.y + x2[e] * cs.x; }
#pragma unroll
                    for (int h = 0; h < 8; ++h) { st4bf(Kb + (size_t)row * KW + h * 96 + 64 + 4 * fq, o1); st4bf(Kb + (size_t)row * KW + h * 96 + 80 + 4 * fq, o2); }
                } else if (c16 == C_KR + 16) {   }
                else if (c16 == C_IG) { if (fq < 2) *(f32x4*)(gates + (size_t)row * 8 + 4 * fq) = acc[ai][bj][m][n]; }
                else if (c16 < C_IG) st4bf(proj + (size_t)row * INWP + col, acc[ai][bj][m][n]);
              } }
      });
}

constexpr int LDS_RS = LDS_GEMM;
__device__ __forceinline__ void mla_unit(const Params& P, int mt, int part, char* lds) {
    unsigned char* ws = P.ws; const bf16_t* proj = (const bf16_t*)(ws + OFF_PROJ);
    bf16_t* Qb = (bf16_t*)P.out; bf16_t* Kb = Qb + (size_t)T_TOK * QW; bf16_t* Vb = Kb + (size_t)T_TOK * KW; const float2* rope = (const float2*)(ws + OFF_ROPE);
    const int tid = threadIdx.x, lane = tid & 63, wid = RFL(tid >> 6), wr = wid >> 1, wc = wid & 1, fr = lane & 15, fq = lane >> 4;
    float* rs = (float*)(lds + LDS_RS);
    const int m0 = mt * 256;
    __syncthreads();
    { const int row = tid >> 1, half = tid & 1; const int cw = part == 0 ? 256 : 128, c0 = part == 0 ? C_CQ : C_CKV; const int per = cw / 2;
      const bf16_t* src = proj + (size_t)(m0 + row) * INWP + c0 + half * per; float ss = 0.f;
      for (int i = 0; i < per / 8; ++i) { const u32x4 v = *(const u32x4*)(src + i * 8);
#pragma unroll
          for (int e = 0; e < 4; ++e) { const float a = bflo(v[e]), b = bfhi(v[e]); ss += a * a + b * b; } }
      ss += __shfl_xor(ss, 1);
      if (half == 0) rs[row] = rsqrtf(ss / (float)cw + EPS); }
    __syncthreads();
    if (part == 0) {
        const bf16_t* Wt = (const bf16_t*)(ws + OFF_WUQ);
        gemm_tiles<4>(6, [&](int nt) { return gdesc(proj + C_CQ, INWP, m0, Wt + (size_t)nt * 128 * 256, 256, 4); },
          [&](int nt, f32x4 (&acc)[4][4]) {
#pragma unroll
            for (int m = 0; m < 4; ++m) { const int lr = wr * 64 + 16 * m + fr, row = m0 + lr; const float r = rs[lr] * QSCALE;
#pragma unroll
                for (int n = 0; n < 4; n += 2) { const int g16 = nt * 8 + wc * 4 + n, h = g16 / 6, jj = g16 % 6;
                    if (jj == 4) { const f32x4 x1 = acc[m][n] * r, x2 = acc[m][n + 1] * r; f32x4 o1, o2;
#pragma unroll
                        for (int e = 0; e < 4; ++e) { const float2 cs = rope[(size_t)row * 16 + 4 * fq + e]; o1[e] = x1[e] * cs.x - x2[e] * cs.y; o2[e] = x1[e] * cs.y + x2[e] * cs.x; }
                        st4bf(Qb + (size_t)row * QW + h * 96 + 64 + 4 * fq, o1); st4bf(Qb + (size_t)row * QW + h * 96 + 80 + 4 * fq, o2);
                    } else { st4bf(Qb + (size_t)row * QW + g16 * 16 + 4 * fq, acc[m][n] * r); st4bf(Qb + (size_t)row * QW + (g16 + 1) * 16 + 4 * fq, acc[m][n + 1] * r); } } }
          }, lds);
    } else {
        const bf16_t* Wt = (const bf16_t*)(ws + OFF_WUKV);
        gemm_tiles<4>(8, [&](int nt) { return gdesc(proj + C_CKV, INWP, m0, Wt + (size_t)nt * 128 * 128, 128, 2); },
          [&](int nt, f32x4 (&acc)[4][4]) {
#pragma unroll
            for (int m = 0; m < 4; ++m) { const int lr = wr * 64 + 16 * m + fr, row = m0 + lr; const float r = rs[lr];
#pragma unroll
                for (int n = 0; n < 4; ++n) { const int jj = wc * 4 + n;
                    if (jj < 4) st4bf(Kb + (size_t)row * KW + nt * 96 + jj * 16 + 4 * fq, acc[m][n] * r);
                    else st4bf(Vb + (size_t)row * VW + nt * 64 + (jj - 4) * 16 + 4 * fq, acc[m][n] * r); } }
          }, lds);
    }
}

__device__ __forceinline__ void gate_prep(const Params& P, int tok0, int h, float* sb, float* sgs, float* spm, float* sbl, float* sa) {
    const float* gates = (const float*)(P.ws + OFF_GATES);
    const int tid = threadIdx.x, lane = tid & 63, w = tid >> 6;
    const float fpre = gates[(size_t)(tok0 + tid) * 8 + 4 + h] + P.b_fgate[h], ig = gates[(size_t)(tok0 + tid) * 8 + h] + P.b_igate[h];
    const float logf = fminf(fpre, 0.f) - log1pf(__expf(-fabsf(fpre)));
    float b = logf;
#pragma unroll
    for (int o = 1; o < 64; o <<= 1) { const float t = __shfl_up(b, o); if (lane >= o) b += t; }
    const float gs = ig - b; float pm = gs;
#pragma unroll
    for (int o = 1; o < 64; o <<= 1) { const float t = __shfl_up(pm, o); if (lane >= o) pm = fmaxf(pm, t); }
    const float bl = __shfl(b, 63), mx = __shfl(pm, 63);
    sb[tid] = b; sgs[tid] = gs; spm[tid] = pm;
    if (lane == 0) { sbl[w] = bl; sa[w] = bl + mx; }
}

constexpr int LDS_M1_G = LDS_GEMM + 1024;
__device__ __forceinline__ void mlstm_unit1(const Params& P, int u, char* lds) {
    unsigned char* ws = P.ws; const bf16_t* proj = (const bf16_t*)(ws + OFF_PROJ);
    bf16_t* xc = (bf16_t*)(ws + OFF_XC); bf16_t* mq = (bf16_t*)(ws + OFF_MQ); bf16_t* mk = (bf16_t*)(ws + OFF_MK); bf16_t* mv = (bf16_t*)(ws + OFF_MV);
    const int b = u >> 6, h = (u >> 4) & 3, g = u & 15, tok0 = b * SEQ + g * 512;
    const int tid = threadIdx.x, lane = tid & 63, wid = RFL(tid >> 6), wr = wid >> 1, wc = wid & 1, fr = lane & 15, fq = lane >> 4, r32 = lane & 31, hi = lane >> 5;
    { const int ch = h * 128 + (tid & 15) * 8, sl = tid >> 4;
      float wv[4][8], bias[8];
#pragma unroll
      for (int k = 0; k < 4; ++k)
#pragma unroll
          for (int e = 0; e < 8; ++e) wv[k][e] = P.conv_w[k * 512 + ch + e];
#pragma unroll
      for (int e = 0; e < 8; ++e) bias[e] = P.conv_b[ch + e];
      const int tin0 = g * 512 + sl * 16; const bf16_t* src = proj + (size_t)(b * SEQ + tin0) * INWP + C_XM + ch;
      u32x4 xr[19];
#pragma unroll
      for (int i = 0; i < 19; ++i) { const int tt = tin0 - 3 + i; xr[i] = (u32x4){0u, 0u, 0u, 0u}; if (tt >= 0) xr[i] = *(const u32x4*)(src + (ptrdiff_t)(i - 3) * INWP); }
#pragma unroll
      for (int i = 0; i < 16; ++i) { float a[8];
#pragma unroll
          for (int e = 0; e < 8; ++e) a[e] = bias[e];
#pragma unroll
          for (int k = 0; k < 4; ++k) { const u32x4 v = xr[i + k];
#pragma unroll
              for (int e = 0; e < 4; ++e) { a[2 * e] += wv[k][2 * e] * bflo(v[e]); a[2 * e + 1] += wv[k][2 * e + 1] * bfhi(v[e]); } }
          u32x4 o;
#pragma unroll
          for (int e = 0; e < 4; ++e) o[e] = cvtpk(siluf(a[2 * e]), siluf(a[2 * e + 1]));
          *(u32x4*)(xc + (size_t)(tok0 + sl * 16 + i) * 512 + ch) = o; } }
    WAITVM0(); __syncthreads();
    gemm_tiles<4>(6, [&](int t) { const int kind = t >> 1, rt = t & 1; const bf16_t* A = kind < 2 ? xc + h * 128 : proj + C_XM + h * 128;
                                  return gdesc(A, kind < 2 ? 512 : INWP, tok0 + rt * 256, (const bf16_t*)(ws + OFF_WM) + (kind * 4 + h) * 16384, 128, 2); },
      [&](int t, f32x4 (&acc)[4][4]) { const int kind = t >> 1, rt = t & 1, m0 = tok0 + rt * 256; bf16_t* dst = kind == 0 ? mq : kind == 1 ? mk : mv;
#pragma unroll
        for (int m = 0; m < 4; ++m) { const int row = m0 + wr * 64 + 16 * m + fr;
#pragma unroll
            for (int n = 0; n < 4; ++n) st4bf(dst + (size_t)row * 512 + h * 128 + wc * 64 + 16 * n + 4 * fq, acc[m][n]); }
      }, lds);
    WAITVM0(); __syncthreads();
    float* sb = (float*)(lds + LDS_M1_G); float* sgs = sb + 512; float* spm = sgs + 512; float* sbl = spm + 512; float* sa = sbl + 8;
    gate_prep(P, tok0, h, sb, sgs, spm, sbl, sa);
    __syncthreads();
    if (tid < 8) { float* cs = (float*)(ws + OFF_CSTAT) + ((size_t)(b * 4 + h) * 128 + g * 8 + tid) * 2; cs[0] = sbl[tid]; cs[1] = sa[tid]; }
    float tail[8]; float mend = -INFINITY;
    { float acc = 0.f;
#pragma unroll
      for (int j = 7; j >= 0; --j) { tail[j] = acc; mend = fmaxf(mend, acc + sa[j]); acc += sbl[j]; } }
    f32x16 cacc[2], nacc; cacc[0] = f32x16{}; cacc[1] = f32x16{}; nacc = f32x16{};
    const bf16x8 ones = (bf16x8){0x3f80, 0x3f80, 0x3f80, 0x3f80, 0x3f80, 0x3f80, 0x3f80, 0x3f80};
    const int s0 = tid >> 4, c8 = tid & 15; const size_t gbase = (size_t)(tok0 + s0) * 512 + h * 128 + c8 * 8;
    u32x4 kq0 = *(const u32x4*)(mk + gbase), kq1 = *(const u32x4*)(mk + gbase + 32 * 512), vq0 = *(const u32x4*)(mv + gbase), vq1 = *(const u32x4*)(mv + gbase + 32 * 512);
#pragma unroll 1
    for (int j = 0; j < 8; ++j) {
        char* img = lds + (j & 1) * 32768;
        { const float e0 = tail[j] + sbl[j] - mend; const float w0 = __expf(e0 + sgs[j * 64 + s0]), w1 = __expf(e0 + sgs[j * 64 + s0 + 32]);
          u32x4 k0, k1;
#pragma unroll
          for (int e = 0; e < 4; ++e) { k0[e] = cvtpk(bflo(kq0[e]) * w0, bfhi(kq0[e]) * w0); k1[e] = cvtpk(bflo(kq1[e]) * w1, bfhi(kq1[e]) * w1); }
          const int off = (c8 >> 2) * 4096 + s0 * 64 + (c8 & 3) * 16;
          *(u32x4*)(img + off) = k0; *(u32x4*)(img + off + 32 * 64) = k1; *(u32x4*)(img + 16384 + off) = vq0; *(u32x4*)(img + 16384 + off + 32 * 64) = vq1; }
        if (j < 7) { const size_t gn = gbase + (size_t)(j + 1) * 64 * 512; kq0 = *(const u32x4*)(mk + gn); kq1 = *(const u32x4*)(mk + gn + 32 * 512); vq0 = *(const u32x4*)(mv + gn); vq1 = *(const u32x4*)(mv + gn + 32 * 512); }
        __syncthreads();
        { const int q = (lane & 15) >> 2, p = lane & 3, cb = (lane >> 4) & 1;
          const lds_cptr kp = (lds_cptr)img + wr * 4096 + (4 * hi + q) * 64 + cb * 32 + p * 8;
          const lds_cptr vp = (lds_cptr)img + 16384 + (2 * wc) * 4096 + (4 * hi + q) * 64 + cb * 32 + p * 8;
#pragma unroll
          for (int ks = 0; ks < 4; ++ks) { const bf16x8 af = cat8(vtr(kp + ks * 1024), vtr(kp + ks * 1024 + 512));
              const bf16x8 b0 = cat8(vtr(vp + ks * 1024), vtr(vp + ks * 1024 + 512)), b1 = cat8(vtr(vp + 4096 + ks * 1024), vtr(vp + 4096 + ks * 1024 + 512));
              cacc[0] = MFMA32(af, b0, cacc[0]); cacc[1] = MFMA32(af, b1, cacc[1]);
              if (wc == 0) nacc = MFMA32(af, ones, nacc); } }
    }
    bf16_t* st = (bf16_t*)(ws + OFF_STATE) + (size_t)u * 16384; float* nst = (float*)(ws + OFF_NST) + (size_t)u * 128; float* mst = (float*)(ws + OFF_MST) + u;
#pragma unroll
    for (int nb2 = 0; nb2 < 2; ++nb2)
#pragma unroll
        for (int r = 0; r < 16; ++r) st[(wr * 32 + crow(r, hi)) * 128 + wc * 64 + nb2 * 32 + r32] = (bf16_t)(cvtpk(cacc[nb2][r], 0.f) & 0xffffu);
    if (wc == 0 && r32 == 0) {
#pragma unroll
        for (int r = 0; r < 16; ++r) nst[wr * 32 + crow(r, hi)] = nacc[r]; }
    if (tid == 0) mst[0] = mend;
    __syncthreads();
}

constexpr int LDS_AK = 0, LDS_AV = 2 * 12288, LDS_AW = LDS_AV + 2 * 8192;
#ifndef ATT_THR
#define ATT_THR 8.0f
#endif
__device__ __forceinline__ void attn_unit(const Params& P, int b, int h, int qb, char* lds) {
    const bf16_t* Qb = (const bf16_t*)P.out; const bf16_t* Kb = Qb + (size_t)T_TOK * QW; const bf16_t* Vb = Kb + (size_t)T_TOK * KW; bf16_t* att = (bf16_t*)(P.ws + OFF_MIX);
    const int tid = threadIdx.x, lane = tid & 63, r32 = lane & 31, hi = lane >> 5; const int wid = RFL(tid >> 6);
    const unsigned lds0 = (unsigned)(uintptr_t)lds;
    const size_t rowbase = (size_t)b * SEQ; const int q0 = qb * 256, NT = 4 * qb + 4, mynt = 4 * qb + (wid >> 1) + 1;
    const bf16_t* Qw = Qb + (rowbase + q0 + wid * 32 + r32) * QW + h * 96;
    bf16x8 qr[6];
#pragma unroll
    for (int d0 = 0; d0 < 6; ++d0) qr[d0] = *(const bf16x8*)(Qw + d0 * 16 + hi * 8);
    const bf16_t* ksrc0 = Kb + (rowbase + lane) * KW + h * 96 + wid * 8;
    const bf16_t* ksrc1 = Kb + (rowbase + lane) * KW + h * 96 + (8 + (wid & 3)) * 8;
    const bf16_t* vsrc = Vb + (rowbase + 16 * (wid & 3) + (lane >> 2)) * VW + h * 64 + (wid >> 2) * 32 + (lane & 3) * 8;
    float* wsf = (float*)(lds + LDS_AW) + wid * 64;
    float mhat = 0.f, l_reg = 0.f; f32x16 o0 = f32x16{}, o1 = f32x16{};
    const lds_cptr vp0 = (lds_cptr)lds + LDS_AV + ((lane >> 4) & 1) * 32 + (lane & 3) * 8 + (4 * hi + ((lane & 15) >> 2)) * 64;
    const char* kp0 = lds + LDS_AK + hi * 1024 + r32 * 16;
    auto dma = [&](int t, int slot) {
        glds16(ksrc0 + (size_t)t * 64 * KW, RFL(lds0 + LDS_AK + slot * 12288 + wid * 1024));
        if (wid < 4) glds16(ksrc1 + (size_t)t * 64 * KW, RFL(lds0 + LDS_AK + slot * 12288 + (8 + wid) * 1024));
        glds16(vsrc + (size_t)t * 64 * VW, RFL(lds0 + LDS_AV + slot * 8192 + wid * 1024));
    };
    __syncthreads();
    dma(0, 0);
    for (int t = 0; t < NT; ++t) {
        asm volatile("s_waitcnt vmcnt(0) lgkmcnt(0)" ::: "memory"); __syncthreads();
        if (t + 1 < NT) dma(t + 1, (t + 1) & 1);
        if (t < mynt) {
            const char* kp = kp0 + (t & 1) * 12288;
            f32x16 s0 = f32x16{}, s1 = f32x16{};
#pragma unroll
            for (int d0 = 0; d0 < 6; ++d0) { const bf16x8 k0 = *(const bf16x8*)(kp + d0 * 2048), k1 = *(const bf16x8*)(kp + d0 * 2048 + 512);
                s0 = MFMA32(k0, qr[d0], s0); s1 = MFMA32(k1, qr[d0], s1); }
            float rm = s0[0];
#pragma unroll
            for (int r = 1; r < 16; ++r) rm = fmaxf(rm, s0[r]);
#pragma unroll
            for (int r = 0; r < 16; ++r) rm = fmaxf(rm, s1[r]);
            rm = fmaxf(rm, __shfl_xor(rm, 32));
            if (t == 0) mhat = rm;
            else { const float d = rm - mhat;
                if (__any(d > ATT_THR)) { const float dl = fmaxf(d, 0.f); mhat += dl; const float f = __builtin_amdgcn_exp2f(-dl); l_reg *= f;
                    if (hi == 0) wsf[r32] = f; WAITLGKM0();
#pragma unroll
                    for (int r = 0; r < 16; ++r) { const float fr_ = wsf[crow(r, hi)]; o0[r] *= fr_; o1[r] *= fr_; }
                    WAITLGKM0(); } }
            float sacc = 0.f;
#pragma unroll
            for (int r = 0; r < 16; ++r) { s0[r] = __builtin_amdgcn_exp2f(s0[r] - mhat); s1[r] = __builtin_amdgcn_exp2f(s1[r] - mhat); sacc += s0[r] + s1[r]; }
            l_reg += sacc;
            u32x4 pw[4];
#pragma unroll
            for (int i = 0; i < 4; ++i) { pw[0][i] = cvtpk(s0[2 * i], s0[2 * i + 1]); pw[1][i] = cvtpk(s0[8 + 2 * i], s0[8 + 2 * i + 1]); pw[2][i] = cvtpk(s1[2 * i], s1[2 * i + 1]); pw[3][i] = cvtpk(s1[8 + 2 * i], s1[8 + 2 * i + 1]); }
            const lds_cptr vp = vp0 + (t & 1) * 8192;
#pragma unroll
            for (int ks = 0; ks < 4; ++ks) { const bf16x8 pa = __builtin_bit_cast(bf16x8, pw[ks]);
                const bf16x8 v0 = cat8(vtr(vp + ks * 1024), vtr(vp + ks * 1024 + 512)), v1 = cat8(vtr(vp + 4096 + ks * 1024), vtr(vp + 4096 + ks * 1024 + 512));
                o0 = MFMA32(pa, v0, o0); o1 = MFMA32(pa, v1, o1); }
        }
    }
    l_reg += __shfl_xor(l_reg, 32);
    WAITLGKM0();
    if (hi == 0) wsf[32 + r32] = l_reg;
    WAITLGKM0();
    bf16_t* Ow = att + (rowbase + q0 + wid * 32) * 1024 + h * 64;
#pragma unroll
    for (int r = 0; r < 16; ++r) { const int orow = crow(r, hi); const float rl = 1.0f / wsf[32 + orow];
        Ow[(size_t)orow * 1024 + r32] = (bf16_t)(cvtpk(o0[r] * rl, 0.f) & 0xffffu); Ow[(size_t)orow * 1024 + 32 + r32] = (bf16_t)(cvtpk(o1[r] * rl, 0.f) & 0xffffu); }
    WAITLGKM0();
}

constexpr int LDS_M2_C = 0, LDS_M2_Q = 32768, LDS_M2_K = 49152, LDS_M2_V = 65536, LDS_M2_KS = 81920, LDS_M2_NUM = 98304  , LDS_M2_MISC = 98304 + 33792;
__device__ __forceinline__ void mlstm_unit2(const Params& P, int u, char* lds) {
    unsigned char* ws = P.ws; const bf16_t* proj = (const bf16_t*)(ws + OFF_PROJ);
    const bf16_t* xc = (const bf16_t*)(ws + OFF_XC); const bf16_t* mq = (const bf16_t*)(ws + OFF_MQ); const bf16_t* mk = (const bf16_t*)(ws + OFF_MK); const bf16_t* mv = (const bf16_t*)(ws + OFF_MV);
    bf16_t* mlo = (bf16_t*)(ws + OFF_MIX) + 512;
    const int b = u >> 6, h = (u >> 4) & 3, g = u & 15, tok0 = b * SEQ + g * 512, seq = b * 4 + h;
    const int tid = threadIdx.x, lane = tid & 63, wid = RFL(tid >> 6), r32 = lane & 31, hi = lane >> 5, wr = wid >> 1, wc = wid & 1;
    float* misc = (float*)(lds + LDS_M2_MISC);
    float* sb = misc; float* sgs = sb + 512; float* spm = sgs + 512; float* sbl = spm + 512; float* sa = sbl + 8;
    float* marr = sa + 8; float* fbarr = marr + 136; float* cst = fbarr + 136;
    float* nfull = cst + 256; float* nseg = nfull + 128; float* sden = nseg + 128; float* swi = sden + 64; float* coef = swi + 64;
    __syncthreads();
    gate_prep(P, tok0, h, sb, sgs, spm, sbl, sa);
    if (tid < 256) cst[tid] = ((const float*)(ws + OFF_CSTAT))[(size_t)seq * 256 + tid];
    __syncthreads();
    if (wid == 0) { const float b0 = cst[4 * lane], a0 = cst[4 * lane + 1], b1 = cst[4 * lane + 2], a1 = cst[4 * lane + 3];
        float B = b0 + b1, A = fmaxf(a0 + b1, a1);
#pragma unroll
        for (int o = 1; o < 64; o <<= 1) { const float Bp = __shfl_up(B, o), Ap = __shfl_up(A, o); if (lane >= o) { A = fmaxf(Ap + B, A); B = Bp + B; } }
        float Be = __shfl_up(B, 1), Ae = __shfl_up(A, 1); if (lane == 0) { Be = 0.f; Ae = -INFINITY; }
        const float m_in = fmaxf(Be + 0.f, Ae);
        const float m_mid = fmaxf(b0 + m_in, a0);
        marr[2 * lane] = m_in; marr[2 * lane + 1] = m_mid; fbarr[2 * lane] = Be; fbarr[2 * lane + 1] = Be + b0;
        if (lane == 63) { marr[128] = fmaxf(b1 + m_mid, a1); fbarr[128] = B; } }
    __syncthreads();
    const float* mstg = (const float*)(ws + OFF_MST);
    if (tid < 16) { float c = 0.f; if (tid < g) c = __expf(mstg[u - g + tid] + (fbarr[8 * g] - fbarr[8 * (tid + 1)]) - marr[8 * g]); coef[tid] = c; }
    __syncthreads();
    f32x16 cacc[2];
    { float cseg[32];
#pragma unroll
      for (int i = 0; i < 32; ++i) cseg[i] = 0.f;
      float nsg = 0.f;
      const bf16_t* stall = (const bf16_t*)(ws + OFF_STATE); const float* nstall = (const float*)(ws + OFF_NST);
#pragma unroll 4
      for (int gp = 0; gp < g; ++gp) { const float c = coef[gp]; const bf16_t* st = stall + (size_t)(u - g + gp) * 16384;
#pragma unroll
          for (int i = 0; i < 4; ++i) { const u32x4 v = *(const u32x4*)(st + (i * 512 + tid) * 8);
#pragma unroll
              for (int e = 0; e < 4; ++e) { cseg[i * 8 + 2 * e] += c * bflo(v[e]); cseg[i * 8 + 2 * e + 1] += c * bfhi(v[e]); } }
          if (tid < 128) nsg += c * nstall[(size_t)(u - g + gp) * 128 + tid]; }
      if (tid < 128) nseg[tid] = nsg;
      float* tmp = (float*)lds;
#pragma unroll
      for (int i = 0; i < 4; ++i) { *(f32x4*)(tmp + (i * 512 + tid) * 8) = (f32x4){cseg[i * 8], cseg[i * 8 + 1], cseg[i * 8 + 2], cseg[i * 8 + 3]}; *(f32x4*)(tmp + (i * 512 + tid) * 8 + 4) = (f32x4){cseg[i * 8 + 4], cseg[i * 8 + 5], cseg[i * 8 + 6], cseg[i * 8 + 7]}; }
      __syncthreads();
#pragma unroll
      for (int nb2 = 0; nb2 < 2; ++nb2)
#pragma unroll
          for (int r = 0; r < 16; ++r) cacc[nb2][r] = tmp[(wr * 32 + crow(r, hi)) * 128 + wc * 64 + nb2 * 32 + r32];
    }
    const int tb = wid & 1, db = wid >> 1;
    const int s0 = tid >> 4, c8 = tid & 15; const size_t gbase = (size_t)(tok0 + s0) * 512 + h * 128 + c8 * 8;
    u32x4 qa0 = *(const u32x4*)(mq + gbase), qa1 = *(const u32x4*)(mq + gbase + 32 * 512), ka0 = *(const u32x4*)(mk + gbase), ka1 = *(const u32x4*)(mk + gbase + 32 * 512),
          va0 = *(const u32x4*)(mv + gbase), va1 = *(const u32x4*)(mv + gbase + 32 * 512);
#pragma unroll 1
    for (int j = 0; j < 8; ++j) {
        int tz = threadIdx.x; asm volatile("" : "+v"(tz));
        const int tid = tz, lane = tz & 63, r32 = lane & 31, hi = lane >> 5; const int wid = RFL(tz >> 6), wr = wid >> 1, wc = wid & 1, tb = wid & 1, db = wid >> 1, s0 = tz >> 4, c8 = tz & 15;
        const int c = 8 * g + j; const float mc = marr[c], mn = marr[c + 1], bl = sbl[j]; const float decay = __expf(bl + mc - mn);
        __syncthreads();
#pragma unroll
        for (int nb2 = 0; nb2 < 2; ++nb2)
#pragma unroll
            for (int r = 0; r < 16; ++r) *(bf16_t*)(lds + LDS_M2_C + (2 * wc + nb2) * 8192 + (wr * 32 + crow(r, hi)) * 64 + r32 * 2) = (bf16_t)(cvtpk(cacc[nb2][r], 0.f) & 0xffffu);
        float* ncur = (j & 1) ? nfull : nseg; float* nnxt = (j & 1) ? nseg : nfull;
        { const float w0 = __expf(bl + sgs[j * 64 + s0] - mn), w1 = __expf(bl + sgs[j * 64 + s0 + 32] - mn);
          u32x4 k0, k1;
#pragma unroll
          for (int e = 0; e < 4; ++e) { k0[e] = cvtpk(bflo(ka0[e]) * w0, bfhi(ka0[e]) * w0); k1[e] = cvtpk(bflo(ka1[e]) * w1, bfhi(ka1[e]) * w1); }
          const int so0 = s0 * 256 + ((c8 ^ (s0 & 15)) << 4), so1 = (s0 + 32) * 256 + ((c8 ^ (s0 & 15)) << 4);
          *(u32x4*)(lds + LDS_M2_Q + so0) = qa0; *(u32x4*)(lds + LDS_M2_Q + so1) = qa1; *(u32x4*)(lds + LDS_M2_K + so0) = ka0; *(u32x4*)(lds + LDS_M2_K + so1) = ka1;
          const int off = (c8 >> 2) * 4096 + s0 * 64 + (c8 & 3) * 16;
          *(u32x4*)(lds + LDS_M2_V + off) = va0; *(u32x4*)(lds + LDS_M2_V + off + 32 * 64) = va1; *(u32x4*)(lds + LDS_M2_KS + off) = k0; *(u32x4*)(lds + LDS_M2_KS + off + 32 * 64) = k1; }
        if (tid < 64) swi[tid] = __expf(mc - fmaxf(spm[j * 64 + tid], mc));
        const int ft = tid >> 3, pp = tid & 7; const size_t ftok = (size_t)tok0 + j * 64 + ft; const int fch = h * 128 + 16 * pp;
        u32x4 xa, xb, za, zb;
        __syncthreads();
        { const int t = 32 * tb + r32; const float mt = fmaxf(spm[j * 64 + t], mc);
          const char* qrow = lds + LDS_M2_Q + t * 256;
          f32x16 sT[2]; sT[0] = f32x16{}; sT[1] = f32x16{};
#pragma unroll
          for (int ks = 0; ks < 8; ++ks) { const bf16x8 qf = *(const bf16x8*)(qrow + (((2 * ks + hi) ^ (t & 15)) << 4));
              { const int s = r32; const bf16x8 kf = *(const bf16x8*)(lds + LDS_M2_K + s * 256 + (((2 * ks + hi) ^ (s & 15)) << 4)); sT[0] = MFMA32(kf, qf, sT[0]); }
              if (tb) { const int s = 32 + r32; const bf16x8 kf = *(const bf16x8*)(lds + LDS_M2_K + s * 256 + (((2 * ks + hi) ^ (s & 15)) << 4)); sT[1] = MFMA32(kf, qf, sT[1]); } }
          float dsum = 0.f;
#pragma unroll
          for (int sbk = 0; sbk < 2; ++sbk)
#pragma unroll
              for (int r = 0; r < 16; ++r) { const int s = 32 * sbk + crow(r, hi); const float w = (s <= t) ? __expf(sgs[j * 64 + s] - mt) : 0.f; const float v = sT[sbk][r] * w; sT[sbk][r] = v; dsum += v; }
          dsum += __shfl_xor(dsum, 32);
          if (db == 0 && hi == 0) sden[t] = dsum;
          u32x4 pw[4];
#pragma unroll
          for (int i = 0; i < 4; ++i) { pw[0][i] = cvtpk(sT[0][2 * i], sT[0][2 * i + 1]); pw[1][i] = cvtpk(sT[0][8 + 2 * i], sT[0][8 + 2 * i + 1]); pw[2][i] = cvtpk(sT[1][2 * i], sT[1][2 * i + 1]); pw[3][i] = cvtpk(sT[1][8 + 2 * i], sT[1][8 + 2 * i + 1]); }
          const int q = (lane & 15) >> 2, p = lane & 3, cb = (lane >> 4) & 1;
          const lds_cptr vp = (lds_cptr)lds + LDS_M2_V + db * 4096 + (4 * hi + q) * 64 + cb * 32 + p * 8;
          f32x16 o1 = f32x16{}, o2 = f32x16{};
#pragma unroll
          for (int ks = 0; ks < 4; ++ks) { if (ks < 2 * (tb + 1)) { const bf16x8 vf = cat8(vtr(vp + ks * 1024), vtr(vp + ks * 1024 + 512)); o1 = MFMA32(__builtin_bit_cast(bf16x8, pw[ks]), vf, o1); } }
          const lds_cptr cp = (lds_cptr)lds + LDS_M2_C + db * 8192 + (8 * hi + q) * 64 + cb * 32 + p * 8;
#pragma unroll
          for (int ks = 0; ks < 8; ++ks) { const bf16x8 qf = *(const bf16x8*)(qrow + (((2 * ks + hi) ^ (t & 15)) << 4)); const bf16x8 cf = cat8(vtr(cp + ks * 1024), vtr(cp + ks * 1024 + 256)); o2 = MFMA32(qf, cf, o2); }
          float* num = (float*)(lds + LDS_M2_NUM);
#pragma unroll
          for (int r = 0; r < 16; ++r) { const int tr_ = 32 * tb + crow(r, hi); num[tr_ * 132 + db * 32 + r32] = o1[r] + swi[tr_] * o2[r]; }
          if (j < 7) { const size_t gn = gbase + (size_t)(j + 1) * 64 * 512; qa0 = *(const u32x4*)(mq + gn); qa1 = *(const u32x4*)(mq + gn + 32 * 512); ka0 = *(const u32x4*)(mk + gn); ka1 = *(const u32x4*)(mk + gn + 32 * 512);
              va0 = *(const u32x4*)(mv + gn); va1 = *(const u32x4*)(mv + gn + 32 * 512); }
#pragma unroll
          for (int r = 0; r < 16; ++r) { cacc[0][r] *= decay; cacc[1][r] *= decay; }
          const lds_cptr kp = (lds_cptr)lds + LDS_M2_KS + wr * 4096 + (4 * hi + q) * 64 + cb * 32 + p * 8;
          const lds_cptr vp2 = (lds_cptr)lds + LDS_M2_V + (2 * wc) * 4096 + (4 * hi + q) * 64 + cb * 32 + p * 8;
#pragma unroll
          for (int ks = 0; ks < 4; ++ks) { const bf16x8 af = cat8(vtr(kp + ks * 1024), vtr(kp + ks * 1024 + 512));
              const bf16x8 b0 = cat8(vtr(vp2 + ks * 1024), vtr(vp2 + ks * 1024 + 512)), b1 = cat8(vtr(vp2 + 4096 + ks * 1024), vtr(vp2 + 4096 + ks * 1024 + 512));
              cacc[0] = MFMA32(af, b0, cacc[0]); cacc[1] = MFMA32(af, b1, cacc[1]); }
          if (tid < 128) { float a = 0.f; const char* kcol = lds + LDS_M2_KS + (tid >> 5) * 4096 + (tid & 31) * 2;
#pragma unroll 8
              for (int s2 = 0; s2 < 64; ++s2) a += bf2f(*(const bf16_t*)(kcol + s2 * 64));
              nnxt[tid] = decay * ncur[tid] + a; } }
        xa = *(const u32x4*)(xc + ftok * 512 + fch); xb = *(const u32x4*)(xc + ftok * 512 + fch + 8);
        za = *(const u32x4*)(proj + ftok * INWP + C_Z + fch); zb = *(const u32x4*)(proj + ftok * INWP + C_Z + fch + 8);
        __syncthreads();
        { const int t = ft; const float* num = (const float*)(lds + LDS_M2_NUM);
          float qn = 0.f;
#pragma unroll
          for (int cc = 0; cc < 2; ++cc) { const u32x4 qv = *(const u32x4*)(lds + LDS_M2_Q + t * 256 + (((2 * pp + cc) ^ (t & 15)) << 4));
#pragma unroll
              for (int e = 0; e < 4; ++e) qn += bflo(qv[e]) * ncur[16 * pp + 8 * cc + 2 * e] + bfhi(qv[e]) * ncur[16 * pp + 8 * cc + 2 * e + 1]; }
          qn += __shfl_xor(qn, 1); qn += __shfl_xor(qn, 2); qn += __shfl_xor(qn, 4);
          const float mt = sb[j * 64 + t] + fmaxf(spm[j * 64 + t], mc);
          float den = sden[t] + swi[t] * qn; den = fmaxf(fabsf(den), __expf(-mt)); const float rden = 1.0f / den;
          float hv[16]; float s1 = 0.f;
#pragma unroll
          for (int e = 0; e < 16; ++e) { hv[e] = num[t * 132 + 16 * pp + e] * rden; s1 += hv[e]; }
          s1 += __shfl_xor(s1, 1); s1 += __shfl_xor(s1, 2); s1 += __shfl_xor(s1, 4);
          const float mu = s1 * (1.0f / 128.0f); float s2 = 0.f;
#pragma unroll
          for (int e = 0; e < 16; ++e) { const float d = hv[e] - mu; s2 += d * d; }
          s2 += __shfl_xor(s2, 1); s2 += __shfl_xor(s2, 2); s2 += __shfl_xor(s2, 4);
          const float rstd = rsqrtf(s2 * (1.0f / 128.0f) + EPS);
          float ov[16];
#pragma unroll
          for (int e = 0; e < 16; ++e) { const unsigned xw = e < 8 ? xa[e >> 1] : xb[(e - 8) >> 1], zw = e < 8 ? za[e >> 1] : zb[(e - 8) >> 1];
              const float xcv = (e & 1) ? bfhi(xw) : bflo(xw), zv = (e & 1) ? bfhi(zw) : bflo(zw);
              const float hn = (hv[e] - mu) * rstd * P.mh_norm_g[fch + e];
              ov[e] = (hn + P.ml_skip[fch + e] * xcv) * siluf(zv); }
          u32x4 oa, ob;
#pragma unroll
          for (int e = 0; e < 4; ++e) { oa[e] = cvtpk(ov[2 * e], ov[2 * e + 1]); ob[e] = cvtpk(ov[8 + 2 * e], ov[8 + 2 * e + 1]); }
          *(u32x4*)(mlo + ftok * 1024 + fch) = oa; *(u32x4*)(mlo + ftok * 1024 + fch + 8) = ob; }
    }
}

__device__ __forceinline__ void phase_outproj(const Params& P, char* lds) {
    unsigned char* ws = P.ws; const bf16_t* mix = (const bf16_t*)(ws + OFF_MIX); const bf16_t* Wt = (const bf16_t*)(ws + OFF_WO);
    const int G = gridDim.x, xs = xcd_slot();
    g8::phase((LAS unsigned char*)lds,
      [&](int i, g8::Unit& u) { const int id = xs + i * G; if (id >= 128 * 4) return false; const int mt = id >> 2, nt = id & 3;
          u.A = (const char*)(mix + (size_t)mt * 256 * DM); u.B = (const char*)(Wt + (size_t)nt * 256 * DM); u.gather = nullptr; u.nvalid = 0; u.K = DM; u.i0 = mt; u.i1 = nt; u.i2 = 0; return true; },
      [&](const f32x4 (&acc)[2][2][4][2], const g8::Unit& u, int wr, int wc, int fr, int fq) {
        const int m0 = u.i0 * 256, n0 = u.i1 * 256;
#pragma unroll
        for (int ai = 0; ai < 2; ++ai)
#pragma unroll
          for (int m = 0; m < 4; ++m) { const size_t row = m0 + 128 * ai + 64 * wr + 16 * m + fr;
#pragma unroll
            for (int bj = 0; bj < 2; ++bj)
#pragma unroll
              for (int n = 0; n < 2; ++n) { const int col = n0 + 128 * bj + 32 * wc + 16 * n + 4 * fq; const f32x4 xv = *(const f32x4*)(P.x + row * DM + col); st4bf((bf16_t*)(P.ws + OFF_RES) + row * DM + col, xv + acc[ai][bj][m][n]); } }
      });
}

constexpr int LDS_LOGIT = LDS_GEMM;
__device__ __forceinline__ void phase_router(const Params& P, char* lds) {
    unsigned char* ws = P.ws; const bool shd = (P.sub & 256) != 0; bf16_t* hn = (bf16_t*)(ws + (shd ? OFF_PROJ : OFF_XN)); const bf16_t* Wr = (const bf16_t*)(ws + OFF_WR);
    unsigned* cnt = (unsigned*)(ws + OFF_CNT + (shd ? 8192 : 0)); int* list = (int*)(ws + (shd ? OFF_PROJ + 64 * MiB : OFF_LIST)); float* tokrec = (float*)(ws + (shd ? OFF_PROJ + 72 * MiB : OFF_TOKREC));
    const int tid = threadIdx.x, lane = tid & 63, wid = RFL(tid >> 6), wr = wid >> 1, wc = wid & 1, fr = lane & 15, fq = lane >> 4;
    float* logit = (float*)(lds + LDS_LOGIT);
    for (int u = blockIdx.x; u < 256; u += gridDim.x) {
        const int m0 = u * 128;
        for (int i = 0; i < 16; i += 4) { f32x4 a[4][4];
#pragma unroll
            for (int q = 0; q < 4; ++q) ld_row_bf16((const bf16_t*)(P.ws + OFF_RES) + (size_t)(m0 + wid * 16 + i + q) * DM, lane, a[q]);
#pragma unroll
            for (int q = 0; q < 4; ++q) norm_row_store(a[q][0], a[q][1], a[q][2], a[q][3], P.norm_ffn_g, lane, hn + (size_t)(m0 + wid * 16 + i + q) * DM); }
        WAITVM0(); __syncthreads();
        gemm_tiles<2>(1, [&](int) { return gdesc(hn, DM, m0, Wr, DM, 16); },
          [&](int, f32x4 (&acc)[2][4]) {
            if (wc == 0) {
#pragma unroll
                for (int m = 0; m < 2; ++m) { const int lr = wr * 32 + 16 * m + fr;
#pragma unroll
                    for (int n = 0; n < 3; ++n) { const int col = 16 * n + 4 * fq; if (col < 36) *(f32x4*)(logit + lr * 40 + col) = acc[m][n]; } } }
          }, lds);
        __syncthreads();
        if (tid < 128) { const int tok = m0 + tid; const float* lg = logit + tid * 40;
            float gl[4]; float gm = -INFINITY; int gi = 0;
#pragma unroll
            for (int k = 0; k < 4; ++k) { gl[k] = lg[k] + P.b_rg[k]; if (gl[k] > gm) { gm = gl[k]; gi = k; } }
            float gsum = 0.f;
#pragma unroll
            for (int k = 0; k < 4; ++k) gsum += __expf(gl[k] - gm);
            const float gtop = 1.0f / gsum;
            float el[8]; float e1 = -INFINITY, e2 = -INFINITY; int i1 = 0, i2 = 0;
#pragma unroll
            for (int k = 0; k < 8; ++k) { el[k] = lg[4 + gi * 8 + k] + P.b_re[gi * 8 + k]; }
#pragma unroll
            for (int k = 0; k < 8; ++k) { if (el[k] > e1) { e2 = e1; i2 = i1; e1 = el[k]; i1 = k; } else if (el[k] > e2) { e2 = el[k]; i2 = k; } }
            const float rr = __expf(e2 - e1); const float w1 = gtop / (1.f + rr), w2 = gtop * rr / (1.f + rr);
            const int ex1 = gi * 8 + i1, ex2 = gi * 8 + i2;
            const unsigned p1 = __hip_atomic_fetch_add(cnt + ex1 * 64, 1u, __ATOMIC_RELAXED, __HIP_MEMORY_SCOPE_AGENT);
            const unsigned p2 = __hip_atomic_fetch_add(cnt + ex2 * 64, 1u, __ATOMIC_RELAXED, __HIP_MEMORY_SCOPE_AGENT);
            list[(size_t)ex1 * T_TOK + p1] = tok; list[(size_t)ex2 * T_TOK + p2] = tok;
            f32x4 rec; rec[0] = __uint_as_float((unsigned)(ex1 << 16) | 0u); rec[1] = w1; rec[2] = __uint_as_float(p1); rec[3] = w2;
            rec[0] = __uint_as_float((unsigned)ex1 | ((unsigned)ex2 << 8));
            *(f32x4*)(tokrec + (size_t)tok * 4) = rec;
            ((unsigned*)(ws + (shd ? OFF_PROJ + 80 * MiB : OFF_GATES)))[tok] = p2;
        }
        __syncthreads();
    }
}

__device__ __forceinline__ int moe_bases(const Params& P, int* sbase, int* stile) {
    const unsigned* cnt = (const unsigned*)(P.ws + OFF_CNT);
    __syncthreads();
    if (threadIdx.x == 0) { int acc = 0, tt = 0; for (int e = 0; e < NEXP; ++e) { const int c = (int)__hip_atomic_load(cnt + e * 64, __ATOMIC_RELAXED, __HIP_MEMORY_SCOPE_AGENT); const int nt = (c + 255) >> 8; sbase[e] = acc; stile[e] = tt; acc += nt * 256; tt += nt; } sbase[NEXP] = acc; stile[NEXP] = tt; }
    __syncthreads();
    return stile[NEXP];
}

constexpr int LDS_MOE = 4 * 32768 + 1024;
__device__ __forceinline__ void phase_moe_gu(const Params& P, char* lds) {
    unsigned char* ws = P.ws; const bf16_t* hn = (const bf16_t*)(ws + OFF_XN); bf16_t* act = (bf16_t*)(ws + OFF_ACT); const int* list = (const int*)(ws + OFF_LIST);
    const unsigned* cnt = (const unsigned*)(ws + OFF_CNT);
    int* sbase = (int*)(lds + LDS_MOE); int* stile = sbase + 40;
    const int ntiles = moe_bases(P, sbase, stile);
    const int G = gridDim.x, xs = xcd_slot();
    g8::phase((LAS unsigned char*)lds,
      [&](int i, g8::Unit& u) { const int id = xs + i * G; if (id >= ntiles * 2) return false; const int ti = id >> 1, nt = id & 1; int e = 0; for (int k = 1; k < NEXP; ++k) if (stile[k] <= ti) e = k;
          const int it = ti - stile[e]; const int ce = (int)cnt[e * 64];
          u.A = (const char*)hn; u.B = (const char*)((const bf16_t*)(ws + OFF_WGU) + ((size_t)e * 512 + nt * 256) * 1024); u.gather = list + (size_t)e * T_TOK + it * 256; u.nvalid = ce - it * 256; u.K = DM;
          u.i0 = sbase[e] + it * 256; u.i1 = nt; u.i2 = e; return true; },
      [&](const f32x4 (&acc)[2][2][4][2], const g8::Unit& u, int wr, int wc, int fr, int fq) {
#pragma unroll
        for (int ai = 0; ai < 2; ++ai)
#pragma unroll
          for (int m = 0; m < 4; ++m) { const size_t row = (size_t)u.i0 + 128 * ai + 64 * wr + 16 * m + fr;
#pragma unroll
            for (int n = 0; n < 2; ++n) { f32x4 v;
#pragma unroll
                for (int q = 0; q < 4; ++q) v[q] = siluf(acc[ai][0][m][n][q]) * acc[ai][1][m][n][q];
                st4bf(act + row * DEXP + u.i1 * 128 + 32 * wc + 16 * n + 4 * fq, v); } }
      });
}
__device__ __forceinline__ void phase_moe_down(const Params& P, char* lds) {
    unsigned char* ws = P.ws; const bf16_t* act = (const bf16_t*)(ws + OFF_ACT); bf16_t* y = (bf16_t*)(ws + OFF_Y);
    int* sbase = (int*)(lds + LDS_MOE); int* stile = sbase + 40;
    const int ntiles = moe_bases(P, sbase, stile);
    const int G = gridDim.x, xs = xcd_slot();
    g8::phase((LAS unsigned char*)lds,
      [&](int i, g8::Unit& u) { const int id = xs + i * G; if (id >= ntiles * 4) return false; const int ti = id >> 2, nt = id & 3; int e = 0; for (int k = 1; k < NEXP; ++k) if (stile[k] <= ti) e = k;
          const int rbase = sbase[e] + (ti - stile[e]) * 256;
          u.A = (const char*)(act + (size_t)rbase * DEXP); u.B = (const char*)((const bf16_t*)(ws + OFF_WD) + ((size_t)e * 1024 + nt * 256) * 256); u.gather = nullptr; u.nvalid = 0; u.K = DEXP; u.i0 = rbase; u.i1 = nt; u.i2 = e; return true; },
      [&](const f32x4 (&acc)[2][2][4][2], const g8::Unit& u, int wr, int wc, int fr, int fq) {
#pragma unroll
        for (int ai = 0; ai < 2; ++ai)
#pragma unroll
          for (int m = 0; m < 4; ++m) { const size_t row = (size_t)u.i0 + 128 * ai + 64 * wr + 16 * m + fr;
#pragma unroll
            for (int bj = 0; bj < 2; ++bj)
#pragma unroll
              for (int n = 0; n < 2; ++n) st4bf(y + row * DM + u.i1 * 256 + 128 * bj + 32 * wc + 16 * n + 4 * fq, acc[ai][bj][m][n]); }
      });
}
__device__ __forceinline__ void phase_combine(const Params& P, char* lds) {
    unsigned char* ws = P.ws; const bf16_t* y = (const bf16_t*)(ws + OFF_Y); bf16_t* hp = (bf16_t*)(ws + OFF_XN); const float* tokrec = (const float*)(ws + OFF_TOKREC);
    int* sbase = (int*)(lds + LDS_MOE); int* stile = sbase + 40;
    (void)moe_bases(P, sbase, stile);
    const int tid = threadIdx.x, lane = tid & 63, wv = tid >> 6;
    for (int r0 = (blockIdx.x * 8 + wv) * 4; r0 < T_TOK; r0 += gridDim.x * 8 * 4) {
        f32x4 rec[4]; unsigned p2[4];
#pragma unroll
        for (int q = 0; q < 4; ++q) { rec[q] = *(const f32x4*)(tokrec + (size_t)(r0 + q) * 4); p2[q] = ((const unsigned*)(ws + OFF_GATES))[r0 + q]; }
        f32x4 a[4][4]; u32x4 ya[4][4];
#pragma unroll
        for (int q = 0; q < 4; ++q) { const unsigned ee = __float_as_uint(rec[q][0]); const int e1 = ee & 255, e2 = (ee >> 8) & 255; const unsigned p1 = __float_as_uint(rec[q][2]);
            const bf16_t* y1 = y + ((size_t)sbase[e1] + p1) * DM; const bf16_t* y2 = y + ((size_t)sbase[e2] + p2[q]) * DM;
            ld_row_bf16((const bf16_t*)(P.ws + OFF_RES) + (size_t)(r0 + q) * DM, lane, a[q]);
            ya[q][0] = *(const u32x4*)(y1 + lane * 8); ya[q][1] = *(const u32x4*)(y1 + 512 + lane * 8); ya[q][2] = *(const u32x4*)(y2 + lane * 8); ya[q][3] = *(const u32x4*)(y2 + 512 + lane * 8); }
#pragma unroll
        for (int q = 0; q < 4; ++q) { const float w1 = rec[q][1], w2 = rec[q][3]; bf16_t* xr = (bf16_t*)(P.ws + ((P.sub & 256) ? OFF_PROJ : OFF_RES)) + (size_t)(r0 + q) * DM;
#pragma unroll
            for (int e = 0; e < 2; ++e) { a[q][0][2 * e] += w1 * bflo(ya[q][0][e]) + w2 * bflo(ya[q][2][e]); a[q][0][2 * e + 1] += w1 * bfhi(ya[q][0][e]) + w2 * bfhi(ya[q][2][e]);
                a[q][1][2 * e] += w1 * bflo(ya[q][0][2 + e]) + w2 * bflo(ya[q][2][2 + e]); a[q][1][2 * e + 1] += w1 * bfhi(ya[q][0][2 + e]) + w2 * bfhi(ya[q][2][2 + e]);
                a[q][2][2 * e] += w1 * bflo(ya[q][1][e]) + w2 * bflo(ya[q][3][e]); a[q][2][2 * e + 1] += w1 * bfhi(ya[q][1][e]) + w2 * bfhi(ya[q][3][e]);
                a[q][3][2 * e] += w1 * bflo(ya[q][1][2 + e]) + w2 * bflo(ya[q][3][2 + e]); a[q][3][2 * e + 1] += w1 * bfhi(ya[q][1][2 + e]) + w2 * bfhi(ya[q][3][2 + e]); }
            st_row_bf16(xr, lane, a[q]);
            norm_row_store(a[q][0], a[q][1], a[q][2], a[q][3], P.norm_ple_g, lane, ((P.sub & 256) ? (bf16_t*)(P.ws + OFF_STATE) : hp) + (size_t)(r0 + q) * DM); }
    }
}
__device__ __forceinline__ void phase_ple(const Params& P, char* lds) {
    unsigned char* ws = P.ws; const bf16_t* hp = (const bf16_t*)(ws + OFF_XN); const bf16_t* pb = (const bf16_t*)(ws + OFF_PB); bf16_t* pe = (bf16_t*)(ws + ((P.sub & 256) ? OFF_STATE : OFF_PE)); bf16_t* res = (bf16_t*)(ws + OFF_RES); bf16_t* xout = (bf16_t*)(ws + ((P.sub & 256) ? OFF_XC : OFF_RES));
    const int G = gridDim.x, xs = xcd_slot();
    g8::phase((LAS unsigned char*)lds,
      [&](int i, g8::Unit& u) { const int id = xs + (i >> 1) * G; if (id >= 128 * 4) return false; const int mt = id >> 2, nt = id & 3; u.gather = nullptr; u.nvalid = 0; u.i0 = mt; u.i1 = nt; u.i2 = i & 1;
          if (i & 1) { u.A = (const char*)(hp + (size_t)mt * 256 * DM); u.B = (const char*)((const bf16_t*)(ws + OFF_WPG) + (size_t)nt * 256 * DM); u.K = DM; }
          else { u.A = (const char*)(pb + (size_t)mt * 256 * 256); u.B = (const char*)((const bf16_t*)(ws + OFF_WPLE) + (size_t)nt * 256 * 256); u.K = 256; }
          return true; },
      [&](const f32x4 (&acc)[2][2][4][2], const g8::Unit& u, int wr, int wc, int fr, int fq) {
        const int m0 = u.i0 * 256, n0 = u.i1 * 256;
#pragma unroll
        for (int ai = 0; ai < 2; ++ai)
#pragma unroll
          for (int m = 0; m < 4; ++m) { const size_t row = m0 + 128 * ai + 64 * wr + 16 * m + fr;
#pragma unroll
            for (int bj = 0; bj < 2; ++bj)
#pragma unroll
              for (int n = 0; n < 2; ++n) { const int col = n0 + 128 * bj + 32 * wc + 16 * n + 4 * fq;
                if (!u.i2) st4bf(pe + row * DM + col, acc[ai][bj][m][n]);
                else { const u32x2 pw = *(const u32x2*)(pe + row * DM + col); const u32x2 xw = *(const u32x2*)(res + row * DM + col); f32x4 xv = (f32x4){bflo(xw.x), bfhi(xw.x), bflo(xw.y), bfhi(xw.y)}; const f32x4 a = acc[ai][bj][m][n];
                    xv[0] += bflo(pw.x) * sigmf(a[0]); xv[1] += bfhi(pw.x) * sigmf(a[1]); xv[2] += bflo(pw.y) * sigmf(a[2]); xv[3] += bfhi(pw.y) * sigmf(a[3]);
                    st4bf(xout + row * DM + col, xv); } } }
      });
}
__device__ __forceinline__ void phase_final(const Params& P) {
    const int tid = threadIdx.x, lane = tid & 63, wv = tid >> 6; const float* g = P.final_g; const bf16_t* res = (const bf16_t*)(P.ws + OFF_RES);
    f32x4 gv[4];
#pragma unroll
    for (int i = 0; i < 4; ++i) gv[i] = *(const f32x4*)(g + 256 * i + 4 * lane);
    for (int r0 = (blockIdx.x * 8 + wv) * 4; r0 < T_TOK; r0 += gridDim.x * 8 * 4) {
        u32x2 w[4][4];
#pragma unroll
        for (int q = 0; q < 4; ++q)
#pragma unroll
            for (int i = 0; i < 4; ++i) w[q][i] = *(const u32x2*)(res + (size_t)(r0 + q) * DM + 256 * i + 4 * lane);
#pragma unroll
        for (int q = 0; q < 4; ++q) { float* xr = P.out + (size_t)(r0 + q) * DM; f32x4 a[4]; float ss = 0.f;
#pragma unroll
            for (int i = 0; i < 4; ++i) { a[i] = (f32x4){bflo(w[q][i].x), bfhi(w[q][i].x), bflo(w[q][i].y), bfhi(w[q][i].y)};
#pragma unroll
                for (int e = 0; e < 4; ++e) ss += a[i][e] * a[i][e]; }
            ss = wsum(ss); const float r = rsqrtf(ss * (1.0f / DM) + EPS);
#pragma unroll
            for (int i = 0; i < 4; ++i) *(f32x4*)(xr + 256 * i + 4 * lane) = a[i] * r * gv[i]; } }
}
constexpr int NPHASE = 11;
constexpr int LDS_BYTES = 144 * 1024;
__global__ void __launch_bounds__(512, 2) mk_fwd(Params P) {
    extern __shared__ __attribute__((aligned(16))) char lds[];
    volatile LAS unsigned* xbw = (volatile LAS unsigned*)(LAS char*)(lds + LDS_BYTES - 16);
    if (threadIdx.x == 0) { xbw[0] = 0u; xbw[1] = 0u; xbw[2] = 0u; xbw[3] = 0u; }
    __syncthreads();
    XcdBarrier bar = xcd_barrier_post((unsigned*)(P.ws + OFF_BAR), xbw);
    const int lo = P.ph_lo, hi = P.ph_hi;
#define PH(k) (lo <= (k) && (k) < hi)
#define SEAM(k) if (lo <= (k) && (k) + 1 < hi) xcd_barrier(bar)
    if (PH(0)) phase_prep(P, lds);
    SEAM(0);
    if (PH(1) && !(P.sub & 8)) phase_inproj(P, lds);
    SEAM(1);
    if (PH(2)) { for (int u = blockIdx.x; u < 256; u += gridDim.x) { mla_unit(P, u >> 1, u & 1, lds); mlstm_unit1(P, u, lds); } }
    SEAM(2);
    if (PH(3)) {
        if (!(P.sub & 1)) for (int u = blockIdx.x; u < 512; u += gridDim.x) { const int x = u & 7, kk = u >> 3, bh = x + 8 * (kk >> 4), j = kk & 15;
#pragma unroll 1
            for (int hf = 0; hf < 2; ++hf) attn_unit(P, bh >> 3, bh & 7, hf ? 31 - j : j, lds); }
        if (!(P.sub & 2)) for (int u = blockIdx.x; u < 256; u += gridDim.x) mlstm_unit2(P, u, lds);
    }
    SEAM(3);
    if (PH(4)) phase_outproj(P, lds);
    SEAM(4);
    if (PH(5)) phase_router(P, lds);
    SEAM(5);
    if (PH(6)) phase_moe_gu(P, lds);
    SEAM(6);
    if (PH(7)) phase_moe_down(P, lds);
    SEAM(7);
    if (PH(8)) phase_combine(P, lds);
    SEAM(8);
    if (PH(9)) phase_ple(P, lds);
    SEAM(9);
    if (PH(10)) phase_final(P);
}

#ifndef DUP_PHASE
#define DUP_PHASE -1
#endif
#ifndef DUP_REPS
#define DUP_REPS 2
#endif
#ifndef DUP_SUB
#define DUP_SUB 0
#endif
#ifndef DBG_PHASES
#define DBG_PHASES 0
#endif
#ifndef DBG_OFF
#define DBG_OFF OFF_MQ
#endif
#ifndef DBG_LD
#define DBG_LD 512
#endif
#ifndef DBG_C0
#define DBG_C0 0
#endif
#ifndef DBG_NC
#define DBG_NC 512
#endif
#ifndef DBG_ROWS
#define DBG_ROWS T_TOK
#endif
__global__ void __launch_bounds__(256) dbg_dump(const bf16_t* src, float* out) {
    for (size_t i = (size_t)blockIdx.x * 256 + threadIdx.x; i < (size_t)T_TOK * DM; i += (size_t)gridDim.x * 256) { const size_t r = i / DM; const int c = (int)(i % DM); float a = 0.f;
        for (size_t rr = r; rr < (size_t)DBG_ROWS; rr += T_TOK) for (int cc = c; cc < DBG_NC; cc += DM) a += bf2f(src[rr * DBG_LD + DBG_C0 + cc]);
        out[i] = a; }
}
extern "C" void kernel_launch(void* const* d_in, const int* in_sizes, int n_in, void* d_out, int out_size, void* d_ws, size_t ws_size, hipStream_t stream) {
    static int grid = 0;
    if (grid == 0) {
        if (n_in != 31 || in_sizes[0] != T_TOK * DM || out_size != T_TOK * DM || ws_size < WS_END) { fprintf(stderr, "kernel_launch: unexpected shapes (n_in %d, ws %zu < %zu)\n", n_in, ws_size, (size_t)WS_END); grid = -1; return; }
        int dev = 0, cus = 0, per_cu = 0;
        if (hipGetDevice(&dev) != hipSuccess || hipDeviceGetAttribute(&cus, hipDeviceAttributeMultiprocessorCount, dev) != hipSuccess) { grid = -1; return; }
        if (hipFuncSetAttribute((const void*)mk_fwd, hipFuncAttributeMaxDynamicSharedMemorySize, LDS_BYTES) != hipSuccess) { fprintf(stderr, "kernel_launch: hipFuncSetAttribute failed\n"); grid = -1; return; }
        if (hipOccupancyMaxActiveBlocksPerMultiprocessor(&per_cu, (const void*)mk_fwd, 512, LDS_BYTES) != hipSuccess || per_cu < 1) fprintf(stderr, "kernel_launch: occupancy query reports %d\n", per_cu);
        (void)hipGetLastError();
        grid = cus;
    }
    if (grid < 0) return;
    (void)hipMemsetAsync(d_ws, 0, CTL_BYTES, stream);
    Params P{};
    P.x = (const float*)d_in[0]; P.p = (const float*)d_in[1]; P.pos = (const int*)d_in[2];
    P.norm_mix_g = (const float*)d_in[3]; P.w_in = (const float*)d_in[4]; P.q_norm_g = (const float*)d_in[5]; P.w_uq = (const float*)d_in[6]; P.kv_norm_g = (const float*)d_in[7]; P.w_ukv = (const float*)d_in[8];
    P.conv_w = (const float*)d_in[9]; P.conv_b = (const float*)d_in[10]; P.w_mq = (const float*)d_in[11]; P.w_mk = (const float*)d_in[12]; P.w_mv = (const float*)d_in[13];
    P.b_igate = (const float*)d_in[14]; P.b_fgate = (const float*)d_in[15]; P.mh_norm_g = (const float*)d_in[16]; P.ml_skip = (const float*)d_in[17]; P.w_o = (const float*)d_in[18];
    P.norm_ffn_g = (const float*)d_in[19]; P.w_rg = (const float*)d_in[20]; P.b_rg = (const float*)d_in[21]; P.w_re = (const float*)d_in[22]; P.b_re = (const float*)d_in[23];
    P.w_gate_e = (const float*)d_in[24]; P.w_up_e = (const float*)d_in[25]; P.w_down_e = (const float*)d_in[26]; P.norm_ple_g = (const float*)d_in[27]; P.w_ple = (const float*)d_in[28]; P.w_pg = (const float*)d_in[29]; P.final_g = (const float*)d_in[30];
    P.out = (float*)d_out; P.ws = (unsigned char*)d_ws;
#if DBG_PHASES
    for (int k = 0; k < DBG_PHASES; ++k) { P.ph_lo = k; P.ph_hi = k + 1; hipLaunchKernelGGL(mk_fwd, dim3(grid), dim3(512), LDS_BYTES, stream, P); }
    hipLaunchKernelGGL(dbg_dump, dim3(2048), dim3(256), 0, stream, (const bf16_t*)((unsigned char*)d_ws + DBG_OFF), (float*)d_out);
#elif MK_MULTI
    for (int k = 0; k < NPHASE; ++k) { P.ph_lo = k; P.ph_hi = k + 1;
        if (k == DUP_PHASE) for (int r = 0; r < DUP_REPS; ++r) { P.sub = DUP_SUB; hipLaunchKernelGGL(mk_fwd, dim3(grid), dim3(512), LDS_BYTES, stream, P); }
        P.sub = 0; hipLaunchKernelGGL(mk_fwd, dim3(grid), dim3(512), LDS_BYTES, stream, P); }
#else
    P.ph_lo = 0; P.ph_hi = NPHASE; hipLaunchKernelGGL(mk_fwd, dim3(grid), dim3(512), LDS_BYTES, stream, P);
#endif
}
```

```cpp
#include <hip/hip_runtime.h>
#include <cstdio>
#include <cstdint>

#ifndef MK_MULTI
#define MK_MULTI 0
#endif

typedef unsigned short bf16_t;
typedef short bf16x8 __attribute__((ext_vector_type(8)));
typedef short s16x4 __attribute__((ext_vector_type(4)));
typedef float f32x4 __attribute__((ext_vector_type(4)));
typedef float f32x16 __attribute__((ext_vector_type(16)));
typedef unsigned u32x4 __attribute__((ext_vector_type(4)));
typedef unsigned u32x2 __attribute__((ext_vector_type(2)));
#define LAS __attribute__((address_space(3)))
typedef LAS const char* lds_cptr;
typedef short v4i16_t __attribute__((ext_vector_type(4)));

constexpr int T_TOK = 32768, DM = 1024, SEQ = 8192, NB = 4;
constexpr int INW = 1448, INWP = 1536;
constexpr int C_CQ = 0, C_CKV = 256, C_KR = 384, C_XM = 416, C_Z = 928, C_IG = 1440;
constexpr int QW = 768, KW = 768, VW = 512;
constexpr int NEXP = 32, DEXP = 256;
constexpr int PROWS = 65536 + 32 * 256;
constexpr float EPS = 1e-6f;
constexpr float QSCALE = 0.10206207261596577f * 1.4426950408889634f;

constexpr size_t MiB = 1ull << 20;
constexpr size_t OFF_BAR = 0;
constexpr size_t OFF_CNT = 16384;
constexpr size_t CTL_BYTES = 32768;
constexpr size_t OFF_WIN = 1 * MiB;
constexpr size_t OFF_WUQ = OFF_WIN + (size_t)INWP * 1024 * 2;
constexpr size_t OFF_WUKV = OFF_WUQ + 768 * 256 * 2;
constexpr size_t OFF_WM = OFF_WUKV + 1024 * 128 * 2;
constexpr size_t OFF_WO = OFF_WM + 12 * 128 * 128 * 2;
constexpr size_t OFF_WR = OFF_WO + 1024 * 1024 * 2;
constexpr size_t OFF_WGU = OFF_WR + 128 * 1024 * 2;
constexpr size_t OFF_WD = OFF_WGU + (size_t)32 * 512 * 1024 * 2;
constexpr size_t OFF_WPLE = OFF_WD + (size_t)32 * 1024 * 256 * 2;
constexpr size_t OFF_WPG = OFF_WPLE + 1024 * 256 * 2;
constexpr size_t OFF_ROPE = OFF_WPG + 1024 * 1024 * 2;
constexpr size_t OFF_PB = OFF_ROPE + (size_t)T_TOK * 32 * 4;
constexpr size_t OFF_GATES = OFF_PB + (size_t)T_TOK * 256 * 2;
constexpr size_t OFF_CSTAT = OFF_GATES + (size_t)T_TOK * 8 * 4;
constexpr size_t OFF_NST = OFF_CSTAT + 2048 * 2 * 4;
constexpr size_t OFF_MST = OFF_NST + 256 * 8 * 128 * 4;
constexpr size_t OFF_TOKREC = OFF_MST + 256 * 8 * 4;
constexpr size_t OFF_LIST = OFF_TOKREC + (size_t)T_TOK * 16;
constexpr size_t OFF_STATIC_END = OFF_LIST + (size_t)32 * T_TOK * 4;
static_assert(OFF_STATIC_END <= 88 * MiB, "static region");
constexpr size_t OFF_PROJ = 88 * MiB;
constexpr size_t OFF_XC = OFF_PROJ + 96 * MiB;
constexpr size_t OFF_MQ = OFF_XC + 32 * MiB;
constexpr size_t OFF_MK = OFF_MQ + 32 * MiB;
constexpr size_t OFF_MV = OFF_MK + 32 * MiB;
constexpr size_t OFF_MIX = OFF_MV + 32 * MiB;
constexpr size_t OFF_XN = OFF_MIX + 64 * MiB;
constexpr size_t OFF_STATE = OFF_XN + 64 * MiB;
constexpr size_t WS_END = OFF_STATE + 64 * MiB;
static_assert(WS_END <= 512 * MiB, "workspace");
constexpr size_t OFF_ACT = OFF_PROJ;
constexpr size_t OFF_Y = OFF_XC;
static_assert(OFF_Y + (size_t)PROWS * 1024 * 2 <= OFF_XN, "y overlay");
constexpr size_t OFF_RES = OFF_STATE;
constexpr size_t OFF_PE = OFF_PROJ;

#define XB_TMO      128
#define XB_XCNT(j)  (256  + 64 * (j))
#define XB_XSUB(j)  (1280 + 64 * (j))
#define XB_XGEN(j)  (2304 + 64 * (j))
#define XB_TOP      3328
#define XB_TOPGEN   3392
#define XCD_BAR_WORDS 3456
#define XB_SPIN_CAP (1u << 18)

__device__ __forceinline__ unsigned xb_ld(unsigned* p)              { return __hip_atomic_load(p, __ATOMIC_RELAXED, __HIP_MEMORY_SCOPE_AGENT); }
__device__ __forceinline__ unsigned xb_add(unsigned* p, unsigned v) { return __hip_atomic_fetch_add(p, v, __ATOMIC_RELAXED, __HIP_MEMORY_SCOPE_AGENT); }
__device__ __forceinline__ unsigned xb_xcc_id() { return (unsigned)__builtin_amdgcn_s_getreg((3 << 11) | 20) & 0xFu; }
#define XB_SPIN(cond, bar) do { unsigned _sp = 0; while (cond) { __builtin_amdgcn_s_sleep(1); \
    if ((++_sp & 255u) == 0u) { if (xb_ld(&(bar)[XB_TMO])) break; if (_sp > XB_SPIN_CAP) { atomicAdd(&(bar)[XB_TMO], 1u); break; } } } } while (0)

struct XcdBarrier { unsigned* bar; unsigned x; volatile LAS unsigned* st; };

__device__ __forceinline__ XcdBarrier xcd_barrier_post(unsigned* bar, volatile LAS unsigned* st) {
    XcdBarrier b; b.bar = bar; b.x = xb_xcc_id(); b.st = st;
    if (threadIdx.x == 0) (void)xb_add(&bar[XB_XCNT(b.x)], 1u);
    return b;
}
__device__ __forceinline__ void xcd_barrier_complete(unsigned* bar, unsigned x, unsigned& nloc, unsigned& nx) {
    const unsigned G = gridDim.x * gridDim.y * gridDim.z;
    unsigned sum, cnt, mine, sp = 0u;
    for (;;) {
        sum = 0u; cnt = 0u; mine = 0u;
#pragma unroll
        for (unsigned j = 0; j < 16; ++j) { const unsigned c = xb_ld(&bar[XB_XCNT(j)]); sum += c; cnt += (c > 0u) ? 1u : 0u; mine = (j == x) ? c : mine; }
        if (sum == G) break;
        __builtin_amdgcn_s_sleep(1);
        if ((++sp & 255u) == 0u) { if (xb_ld(&bar[XB_TMO])) break; if (sp > XB_SPIN_CAP) { atomicAdd(&bar[XB_TMO], 1u); break; } }
    }
    nloc = mine > 0u ? mine : 1u; nx = cnt > 0u ? cnt : 1u;
}
__device__ __forceinline__ void xcd_barrier(const XcdBarrier& b) {
    asm volatile("s_waitcnt vmcnt(0)" ::: "memory");
    __syncthreads();
    if (threadIdx.x == 0) {
        unsigned* bar = b.bar;
        __builtin_amdgcn_s_waitcnt(0);
        unsigned nloc = b.st[0], nx = b.st[1];
        if (nloc == 0u) { xcd_barrier_complete(bar, b.x, nloc, nx); b.st[0] = nloc; b.st[1] = nx; }
        const unsigned old = xb_add(&bar[XB_XSUB(b.x)], 1u);
        const unsigned gen = old / nloc;
        if (old + 1u == (gen + 1u) * nloc) {
            __builtin_amdgcn_fence(__ATOMIC_RELEASE, "agent");
            asm volatile("s_waitcnt vmcnt(0)" ::: "memory");
            const unsigned og = xb_add(&bar[XB_TOP], 1u);
            const unsigned tg = og / nx;
            if (og + 1u == (tg + 1u) * nx) xb_add(&bar[XB_TOPGEN], 1u);
            else XB_SPIN(xb_ld(&bar[XB_TOPGEN]) == tg, bar);
            __builtin_amdgcn_fence(__ATOMIC_ACQUIRE, "agent");
            xb_add(&bar[XB_XGEN(b.x)], 1u);
            asm volatile("s_waitcnt vmcnt(0)" ::: "memory");
        } else {
            XB_SPIN(xb_ld(&bar[XB_XGEN(b.x)]) == gen, bar);
            __builtin_amdgcn_fence(__ATOMIC_ACQUIRE, "agent");
            asm volatile("s_waitcnt vmcnt(0)" ::: "memory");
        }
    }
    __syncthreads();
}

typedef __bf16 bf16x2_t __attribute__((ext_vector_type(2)));
typedef float f32x2 __attribute__((ext_vector_type(2)));
__device__ __forceinline__ unsigned cvtpk(float lo, float hi) { f32x2 v = {lo, hi}; bf16x2_t b = __builtin_convertvector(v, bf16x2_t); return __builtin_bit_cast(unsigned, b); }
__device__ __forceinline__ float bf2f(unsigned short v) { return __uint_as_float((unsigned)v << 16); }
__device__ __forceinline__ float bflo(unsigned w) { return __uint_as_float(w << 16); }
__device__ __forceinline__ float bfhi(unsigned w) { return __uint_as_float(w & 0xffff0000u); }
__device__ __forceinline__ void st4bf(bf16_t* p, f32x4 v) { u32x2 w; w.x = cvtpk(v[0], v[1]); w.y = cvtpk(v[2], v[3]); *(u32x2*)p = w; }
__device__ __forceinline__ void st8bf(bf16_t* p, f32x4 a, f32x4 b) { u32x4 w; w.x = cvtpk(a[0], a[1]); w.y = cvtpk(a[2], a[3]); w.z = cvtpk(b[0], b[1]); w.w = cvtpk(b[2], b[3]); *(u32x4*)p = w; }
__device__ __forceinline__ float wsum(float v) {
#pragma unroll
    for (int o = 32; o > 0; o >>= 1) v += __shfl_xor(v, o);
    return v; }
__device__ __forceinline__ float wmax(float v) {
#pragma unroll
    for (int o = 32; o > 0; o >>= 1) v = fmaxf(v, __shfl_xor(v, o));
    return v; }
__device__ __forceinline__ float siluf(float v) { return v / (1.f + __expf(-v)); }
__device__ __forceinline__ float sigmf(float v) { return 1.f / (1.f + __expf(-v)); }
__device__ __forceinline__ void glds16(const void* g, unsigned lds_base) {
    unsigned sv; asm volatile("s_mov_b32 %0, m0\n\ts_mov_b32 m0, %2\n\ts_nop 0\n\tglobal_load_lds_dwordx4 %1, off\n\ts_mov_b32 m0, %0" : "=&s"(sv) : "v"(g), "s"(lds_base) : "memory"); }
__device__ __forceinline__ const void* rfl_ptr(const void* p) { const unsigned long long v = (unsigned long long)p; const unsigned lo = __builtin_amdgcn_readfirstlane((unsigned)v), hi = __builtin_amdgcn_readfirstlane((unsigned)(v >> 32)); return (const void*)(((unsigned long long)hi << 32) | lo); }
__device__ __forceinline__ void glds16s(const void* sbase, unsigned voff, unsigned lds_base) {
    unsigned sv; asm volatile("s_mov_b32 %0, m0\n\ts_mov_b32 m0, %3\n\ts_nop 0\n\tglobal_load_lds_dwordx4 %1, %2\n\ts_mov_b32 m0, %0" : "=&s"(sv) : "v"(voff), "s"(sbase), "s"(lds_base) : "memory"); }
#define RFL(x) __builtin_amdgcn_readfirstlane(x)
#define MFMA16(a, b, c) __builtin_amdgcn_mfma_f32_16x16x32_bf16(a, b, c, 0, 0, 0)
#define MFMA32(a, b, c) __builtin_amdgcn_mfma_f32_32x32x16_bf16(a, b, c, 0, 0, 0)
#define WAITVM0() asm volatile("s_waitcnt vmcnt(0)" ::: "memory")
#define WAITLGKM0() asm volatile("s_waitcnt lgkmcnt(0)" ::: "memory")
__device__ __forceinline__ int crow(int r, int hi) { return (r & 3) + 8 * (r >> 2) + 4 * hi; }
__device__ __forceinline__ s16x4 vtr(lds_cptr p) { return __builtin_bit_cast(s16x4, __builtin_amdgcn_ds_read_tr16_b64_v4i16((LAS v4i16_t*)p)); }
__device__ __forceinline__ bf16x8 cat8(s16x4 a, s16x4 b) { return (bf16x8){a[0], a[1], a[2], a[3], b[0], b[1], b[2], b[3]}; }

__device__ __forceinline__ int xcd_slot() { const int G = gridDim.x, b = blockIdx.x; return (G & 7) ? b : (b & 7) * (G >> 3) + (b >> 3); }
struct Params {
    const float* x; const float* p; const int* pos;
    const float *norm_mix_g, *w_in, *q_norm_g, *w_uq, *kv_norm_g, *w_ukv, *conv_w, *conv_b, *w_mq, *w_mk, *w_mv, *b_igate, *b_fgate,
                *mh_norm_g, *ml_skip, *w_o, *norm_ffn_g, *w_rg, *b_rg, *w_re, *b_re, *w_gate_e, *w_up_e, *w_down_e, *norm_ple_g, *w_ple, *w_pg, *final_g;
    float* out; unsigned char* ws; int ph_lo, ph_hi, sub, pad;
};

constexpr int G_STAGE = 49152;
constexpr int LDS_GEMM = 2 * G_STAGE;
struct GDesc { const bf16_t* a0; const bf16_t* a1; const int* gather; const bf16_t* bt; int ld0, ld1, ksplit, m0, nvalid, ldb, nk; };
__device__ __forceinline__ GDesc gdesc(const bf16_t* a, int lda, int m0, const bf16_t* bt, int ldb, int nk) {
    GDesc d; d.a0 = a; d.a1 = a; d.gather = nullptr; d.bt = bt; d.ld0 = lda; d.ld1 = lda; d.ksplit = 1 << 30; d.m0 = m0; d.nvalid = 0; d.ldb = ldb; d.nk = nk; return d; }
template <int MT> __device__ __forceinline__ void g_rows(const GDesc& d, int (&rows)[MT]) {
    const int lane = threadIdx.x & 63, wid = RFL(threadIdx.x >> 6);
#pragma unroll
    for (int i = 0; i < MT; ++i) { const int r = i * 64 + wid * 8 + (lane >> 3); rows[i] = d.gather ? (r < d.nvalid ? d.gather[r] : 0) : d.m0 + r; }
}
template <int MT> __device__ __forceinline__ void g_stage(const GDesc& d, const int (&rows)[MT], int kt, int buf, unsigned lds0) {
    const int lane = threadIdx.x & 63, wid = RFL(threadIdx.x >> 6); const int cch = (lane & 7) ^ (lane >> 3);
    const bf16_t* ab = d.a0; int ld = d.ld0, kk = kt;
    if (kt >= d.ksplit) { ab = d.a1; ld = d.ld1; kk = kt - d.ksplit; }
#pragma unroll
    for (int i = 0; i < MT; ++i) glds16(ab + (size_t)rows[i] * ld + kk * 64 + cch * 8, RFL(lds0 + buf * G_STAGE + i * 8192 + wid * 1024));
    const bf16_t* bp = d.bt + (size_t)(wid * 8 + (lane >> 3)) * d.ldb + cch * 8 + kt * 64;
    glds16(bp, RFL(lds0 + buf * G_STAGE + 32768 + wid * 1024));
    glds16(bp + (size_t)64 * d.ldb, RFL(lds0 + buf * G_STAGE + 32768 + 8192 + wid * 1024));
}
template <int MT> __device__ __forceinline__ void g_compute(f32x4 (&acc)[MT][4], const char* sa) {
    const int lane = threadIdx.x & 63, wid = RFL(threadIdx.x >> 6), wr = wid >> 1, wc = wid & 1, fr = lane & 15, fq = lane >> 4;
    const char* sb = sa + 32768;
#pragma unroll
    for (int kk = 0; kk < 2; ++kk) {
        bf16x8 af[MT], bfr[4];
        const int sw = ((4 * kk + fq) ^ (fr & 7)) << 4;
#pragma unroll
        for (int m = 0; m < MT; ++m) af[m] = *(const bf16x8*)(sa + (wr * 16 * MT + 16 * m + fr) * 128 + sw);
#pragma unroll
        for (int n = 0; n < 4; ++n) bfr[n] = *(const bf16x8*)(sb + (wc * 64 + 16 * n + fr) * 128 + sw);
#pragma unroll
        for (int m = 0; m < MT; ++m)
#pragma unroll
            for (int n = 0; n < 4; ++n) acc[m][n] = MFMA16(bfr[n], af[m], acc[m][n]);
    }
}
template <int MT, class DescFn, class EpiFn>
__device__ __forceinline__ void gemm_tiles(int ntiles, DescFn df, EpiFn ef, char* lds) {
    if (ntiles <= 0) return;
    const unsigned lds0 = (unsigned)(uintptr_t)lds;
    GDesc d = df(0); int rows[MT]; g_rows<MT>(d, rows);
    int cur = 0;
    __syncthreads();
    g_stage<MT>(d, rows, 0, 0, lds0);
    for (int t = 0; t < ntiles; ++t) {
        const bool hn = t + 1 < ntiles; GDesc dn = d; int rowsn[MT];
#pragma unroll
        for (int i = 0; i < MT; ++i) rowsn[i] = rows[i];
        if (hn) { dn = df(t + 1); g_rows<MT>(dn, rowsn); }
        f32x4 acc[MT][4];
#pragma unroll
        for (int m = 0; m < MT; ++m)
#pragma unroll
            for (int n = 0; n < 4; ++n) acc[m][n] = (f32x4){0.f, 0.f, 0.f, 0.f};
        for (int kt = 0; kt < d.nk; ++kt) {
            WAITVM0(); __syncthreads();
            if (kt + 1 < d.nk) g_stage<MT>(d, rows, kt + 1, cur ^ 1, lds0); else if (hn) g_stage<MT>(dn, rowsn, 0, cur ^ 1, lds0);
            g_compute<MT>(acc, lds + cur * G_STAGE); cur ^= 1;
        }
        ef(t, acc);
        d = dn;
#pragma unroll
        for (int i = 0; i < MT; ++i) rows[i] = rowsn[i];
    }
}
template <int NF> struct G2C { static constexpr int BN = 64 * NF, A_BYTES = 16384, B_BYTES = BN * 64, STAGE = A_BYTES + B_BYTES, DPS = 2 + NF / 2; };
template <int NF> __device__ __forceinline__ void g2_offs(const GDesc& d, unsigned (&ao)[2], unsigned (&bo)[NF / 2]) {
    const int lane = threadIdx.x & 63, wid = RFL(threadIdx.x >> 6); const unsigned cch = (unsigned)((lane & 3) ^ ((0 - (lane >> 4)) & 3)) * 16u;
#pragma unroll
    for (int i = 0; i < 2; ++i) { const int r = 16 * (i * 8 + wid) + (lane >> 2); const int gr = d.gather ? (r < d.nvalid ? d.gather[r] : 0) : d.m0 + r; ao[i] = (unsigned)gr * (unsigned)(d.ld0 * 2) + cch; }
#pragma unroll
    for (int i = 0; i < NF / 2; ++i) bo[i] = (unsigned)(16 * (i * 8 + wid) + (lane >> 2)) * (unsigned)(d.ldb * 2) + cch;
}
template <int NF> __device__ __forceinline__ void g2_piece(const GDesc& d, const unsigned (&ao)[2], const unsigned (&bo)[NF / 2], int kt, int slot, unsigned lds0, int p) {
    const int wid = RFL(threadIdx.x >> 6);
    const unsigned sb = lds0 + slot * G2C<NF>::STAGE;
    if (p < 2) { const bf16_t* ab = d.a0; int kk = kt;
        if (kt >= d.ksplit) { ab = d.a1; kk = kt - d.ksplit; }
        glds16s(rfl_ptr(ab + kk * 32), ao[p], RFL(sb + (p * 8 + wid) * 1024));
    } else { const int i = p - 2; glds16s(rfl_ptr(d.bt + kt * 32), bo[i], RFL(sb + 16384 + (i * 8 + wid) * 1024)); }
}
template <int N> __device__ __forceinline__ void waitvm() { asm volatile("s_waitcnt vmcnt(%0)" :: "n"(N) : "memory"); }
template <int NF, class DescFn, class EpiFn>
__device__ __forceinline__ void gemm2_tiles(int ntiles, DescFn df, EpiFn ef, char* lds, int dbg = 0) {
    if (ntiles <= 0) return;
    constexpr int DPS = G2C<NF>::DPS, STG = G2C<NF>::STAGE;
    const unsigned lds0 = (unsigned)(uintptr_t)lds;
    const int lane = threadIdx.x & 63, wid = RFL(threadIdx.x >> 6), wr2 = wid >> 2, wc4 = wid & 3, fr = lane & 15, fq = lane >> 4;
    const int sw = (fq ^ ((0 - (fr >> 2)) & 3)) << 4;
    const int aoff = (wr2 * 128 + fr) * 64 + sw, boff = 16384 + (wc4 * 16 * NF + fr) * 64 + sw;
    GDesc dc = df(0), di = dc; unsigned ao[2], bo[NF / 2]; g2_offs<NF>(di, ao, bo);
    int ti = 0, ki = 0, issued = 0, done = 0;
    auto advance = [&]() { ++issued; ++ki; if (ki == di.nk) { ++ti; ki = 0; if (ti < ntiles) { di = df(ti); g2_offs<NF>(di, ao, bo); } } };
#define G2_BAR() do { if (!(dbg & 16)) asm volatile("s_waitcnt lgkmcnt(0)\n\ts_barrier" ::: "memory"); } while (0)
#define G2_WAIT(need) do { const int fly_ = issued - (need) - 1; if (fly_ >= 2) waitvm<2 * DPS>(); else if (fly_ == 1) waitvm<DPS>(); else waitvm<0>(); } while (0)
    __syncthreads();
    for (int q = 0; q < 3; ++q) if (ti < ntiles) {
#pragma unroll
        for (int p = 0; p < DPS; ++p) g2_piece<NF>(di, ao, bo, ki, issued & 3, lds0, p);
        advance(); }
    if (wr2) { G2_WAIT(0); G2_BAR(); }
    bf16x8 fa[8], fb[NF];
    for (int t = 0; t < ntiles; ++t) {
        f32x4 acc[8][NF];
#pragma unroll
        for (int m = 0; m < 8; ++m)
#pragma unroll
            for (int n = 0; n < NF; ++n) acc[m][n] = (f32x4){0.f, 0.f, 0.f, 0.f};
        const int nk = dc.nk;
        for (int kt = 0; kt < nk; ++kt) {
            if (!wr2) G2_WAIT(done);
            G2_BAR();
            { const char* sc = lds + (done & 3) * STG; const bool doi = ti < ntiles && !(dbg & 2); const int islot = issued & 3;
#pragma unroll
              for (int n = 0; n < NF; ++n) fb[n] = *(const bf16x8*)(sc + boff + n * 1024);
#pragma unroll
              for (int m = 0; m < 8; ++m) { fa[m] = *(const bf16x8*)(sc + aoff + m * 1024);
                  if ((m & 1) && (m >> 1) < DPS) { if (doi) g2_piece<NF>(di, ao, bo, ki, islot, lds0, m >> 1); } }
              if (ti < ntiles) advance(); }
            if (wr2) G2_WAIT(done + 1);
            G2_BAR();
            __builtin_amdgcn_s_setprio(1);
            if (!(dbg & 1)) {
#pragma unroll
            for (int m = 0; m < 8; ++m)
#pragma unroll
                for (int n = 0; n < NF; ++n) acc[m][n] = MFMA16(fb[n], fa[m], acc[m][n]); }
            __builtin_amdgcn_s_setprio(0);
            ++done;
        }
        if (!(dbg & 4)) ef(t, acc);
        if (t + 1 < ntiles) dc = (ti == t + 1) ? di : df(t + 1);
    }
    if (!wr2) G2_BAR();
#undef G2_BAR
#undef G2_WAIT
}

namespace g8 {
constexpr int BM = 256, BK = 64, HALF = 128, HTB = HALF * BK * 2;
__device__ __forceinline__ int lds_byte(int r, int c) { const int st = (r >> 4) * 2 + (c >> 5), rr = r & 15, cc = c & 31, ob = rr * 64 + cc * 2; return st * 1024 + (ob ^ (((ob >> 9) & 1) << 5)); }
__device__ __forceinline__ int perm32(int rho) { const int n = rho >> 4, i = rho & 15; return 8 * (i >> 2) + 4 * n + (i & 3); }
__device__ __forceinline__ void stage_rc(int b, int& R, int& C) { const int st = b / 1024, sb = b % 1024, swz = sb ^ (((sb >> 9) & 1) << 5); R = (st >> 1) * 16 + swz / 64; C = (st & 1) * 32 + (swz % 64) / 2; }
struct Unit { const char* A; const char* B; const int* gather; int nvalid, K, perm, i0, i1, i2; };
__device__ __forceinline__ void offs(const Unit& u, unsigned (&va)[2][2], unsigned (&vb)[2]) {
#pragma unroll
    for (int i = 0; i < 2; ++i) { int R, C; stage_rc(threadIdx.x * 16 + i * 8192, R, C);
        { const int Rb = u.perm ? ((R & ~31) + perm32(R & 31)) : R; vb[i] = (unsigned)(Rb * u.K + C) * 2u; }
#pragma unroll
        for (int h = 0; h < 2; ++h) { const int r = h * HALF + R; const int gr = u.gather ? (r < u.nvalid ? u.gather[r] : 0) : r; va[h][i] = (unsigned)(gr * u.K + C) * 2u; } }
}
template <class NextFn, class EpiFn>
__device__ __forceinline__ void phase(LAS unsigned char* lds, NextFn next, EpiFn epi) {
    const int tid = threadIdx.x, wid = __builtin_amdgcn_readfirstlane(tid >> 6), lane = tid & 63, wr = wid >> 2, wc = wid & 3, fr = lane & 15, fq = lane >> 4;
    const unsigned ldsw = (unsigned)wid * 1024u;
    const int aoff = lds_byte(wr * 64 + fr, fq * 8), boff = lds_byte(wc * 32 + fr, fq * 8);
#define G8_SA(b, h) (((b) * 2 + (h)) * HTB)
#define G8_SB(b, h) ((4 + (b) * 2 + (h)) * HTB)
#define G8_STAGE(bufoff, gbase, voff) do { _Pragma("unroll") for (int _i = 0; _i < 2; ++_i) \
        __builtin_amdgcn_global_load_lds((const unsigned*)((const char*)(gbase) + (voff)[_i]), (LAS unsigned*)(lds + (bufoff) + ldsw + _i * 8192), 16, 0, 0); } while (0)
#define G8_LDA(dst, b, h) do { _Pragma("unroll") for (int m = 0; m < 4; ++m) _Pragma("unroll") for (int k = 0; k < 2; ++k) dst[m][k] = *(const LAS bf16x8*)(lds + G8_SA(b, h) + aoff + m * 2048 + k * 1024); } while (0)
#define G8_LDB(dst, b, h) do { _Pragma("unroll") for (int n = 0; n < 2; ++n) _Pragma("unroll") for (int k = 0; k < 2; ++k) dst[n][k] = *(const LAS bf16x8*)(lds + G8_SB(b, h) + boff + n * 2048 + k * 1024); } while (0)
#define G8_MMA(ai, bj, At, Bt) do { __builtin_amdgcn_s_setprio(1); _Pragma("unroll") for (int m = 0; m < 4; ++m) _Pragma("unroll") for (int n = 0; n < 2; ++n) _Pragma("unroll") for (int k = 0; k < 2; ++k) \
        acc[ai][bj][m][n] = __builtin_amdgcn_mfma_f32_16x16x32_bf16(Bt[n][k], At[m][k], acc[ai][bj][m][n], 0, 0, 0); __builtin_amdgcn_s_setprio(0); } while (0)
#define G8_WAIT_V(n) asm volatile("s_waitcnt vmcnt(" #n ")" ::: "memory")
#define G8_WAIT_L(n) asm volatile("s_waitcnt lgkmcnt(" #n ")" ::: "memory")
#define G8_BAR __builtin_amdgcn_s_barrier()
#define G8_SCHED __builtin_amdgcn_sched_barrier(0)
    Unit cur, nxt; int ui = 0;
    if (!next(0, cur)) return;
    f32x4 acc[2][2][4][2];
#pragma unroll
    for (int a = 0; a < 2; ++a)
#pragma unroll
        for (int b = 0; b < 2; ++b)
#pragma unroll
            for (int m = 0; m < 4; ++m)
#pragma unroll
                for (int n = 0; n < 2; ++n) acc[a][b][m][n] = (f32x4){0.f, 0.f, 0.f, 0.f};
    bf16x8 At[4][2], B0[2][2], B1[2][2];
    unsigned vaC[2][2], vbC[2], vaN[2][2], vbN[2];
    offs(cur, vaC, vbC);
    const size_t kstep = (size_t)(BK * 2);
    __syncthreads();
    { const char* cA = cur.A; const char* cB = cur.B; const size_t hsB = (size_t)HALF * cur.K * 2;
      G8_STAGE(G8_SB(0, 0), cB, vbC); G8_STAGE(G8_SA(0, 0), cA, vaC[0]); G8_STAGE(G8_SB(0, 1), cB + hsB, vbC); G8_STAGE(G8_SA(0, 1), cA, vaC[1]);
      if (wr == 1) G8_BAR;
      G8_WAIT_V(4); G8_BAR;
      G8_STAGE(G8_SB(1, 0), cB + kstep, vbC); G8_STAGE(G8_SA(1, 0), cA + kstep, vaC[0]); G8_STAGE(G8_SB(1, 1), cB + hsB + kstep, vbC);
      G8_WAIT_V(6); G8_BAR; }
    for (;;) {
        const bool has_next = next(ui + 1, nxt);
        if (has_next) offs(nxt, vaN, vbN);
        else {
#pragma unroll
            for (int i = 0; i < 2; ++i) { vbN[i] = vbC[i]; vaN[0][i] = vaC[0][i]; vaN[1][i] = vaC[1][i]; } }
        const char* cA = cur.A; const char* cB = cur.B; const size_t hsB = (size_t)HALF * cur.K * 2;
        const char* nA = has_next ? nxt.A : cA; const char* nB = has_next ? nxt.B : cB; const size_t hsN = has_next ? (size_t)HALF * nxt.K * 2 : hsB;
        const int nt = cur.K / BK;
        for (int t = 0; t < nt; t += 2) {
            const bool last = (t == nt - 2);
            const char* a1 = cA + (size_t)(t + 1) * kstep;
            const char* a2 = last ? nA : cA + (size_t)(t + 2) * kstep; const char* b2 = last ? nB : cB + (size_t)(t + 2) * kstep;
            const char* a3 = a2 + kstep; const char* b3 = b2 + kstep; const size_t hs2 = last ? hsN : hsB;
            unsigned va2[2][2], vb2[2];
#pragma unroll
            for (int i = 0; i < 2; ++i) { vb2[i] = last ? vbN[i] : vbC[i]; va2[0][i] = last ? vaN[0][i] : vaC[0][i]; va2[1][i] = last ? vaN[1][i] : vaC[1][i]; }
            G8_LDB(B0, 0, 0); G8_SCHED; G8_LDA(At, 0, 0); G8_STAGE(G8_SA(1, 1), a1, vaC[1]);
            G8_WAIT_L(8); G8_BAR; G8_WAIT_L(0); G8_MMA(0, 0, At, B0); G8_BAR; G8_SCHED;
            G8_LDB(B1, 0, 1); G8_STAGE(G8_SB(0, 0), b2, vb2);
            G8_BAR; G8_WAIT_L(0); G8_MMA(0, 1, At, B1); G8_BAR;
            G8_LDA(At, 0, 1); G8_STAGE(G8_SA(0, 0), a2, va2[0]);
            G8_BAR; G8_WAIT_L(0); G8_MMA(1, 0, At, B0); G8_BAR; G8_SCHED;
            G8_STAGE(G8_SB(0, 1), b2 + hs2, vb2);
            G8_WAIT_V(6); G8_BAR; G8_MMA(1, 1, At, B1); G8_BAR;
            G8_LDB(B0, 1, 0); G8_SCHED; G8_LDA(At, 1, 0); G8_STAGE(G8_SA(0, 1), a2, va2[1]);
            G8_WAIT_L(8); G8_BAR; G8_WAIT_L(0); G8_MMA(0, 0, At, B0); G8_BAR; G8_SCHED;
            G8_LDB(B1, 1, 1); G8_STAGE(G8_SB(1, 0), b3, vb2);
            G8_BAR; G8_WAIT_L(0); G8_MMA(0, 1, At, B1); G8_BAR;
            G8_LDA(At, 1, 1); G8_STAGE(G8_SA(1, 0), a3, va2[0]);
            G8_BAR; G8_WAIT_L(0); G8_MMA(1, 0, At, B0); G8_BAR; G8_SCHED;
            G8_STAGE(G8_SB(1, 1), b3 + hs2, vb2);
            G8_WAIT_V(6); G8_BAR; G8_MMA(1, 1, At, B1); G8_BAR;
        }
        epi(acc, cur, wr, wc, fr, fq);
        if (!has_next) break;
#pragma unroll
        for (int a = 0; a < 2; ++a)
#pragma unroll
            for (int b = 0; b < 2; ++b)
#pragma unroll
                for (int m = 0; m < 4; ++m)
#pragma unroll
                    for (int n = 0; n < 2; ++n) acc[a][b][m][n] = (f32x4){0.f, 0.f, 0.f, 0.f};
        cur = nxt; ++ui;
#pragma unroll
        for (int i = 0; i < 2; ++i) { vbC[i] = vbN[i]; vaC[0][i] = vaN[0][i]; vaC[1][i] = vaN[1][i]; }
    }
    G8_WAIT_V(0);
    if (wr == 0) G8_BAR;
    G8_BAR;
#undef G8_SA
#undef G8_SB
#undef G8_STAGE
#undef G8_LDA
#undef G8_LDB
#undef G8_MMA
#undef G8_WAIT_V
#undef G8_WAIT_L
#undef G8_BAR
#undef G8_SCHED
}
}


__device__ __forceinline__ void ld_row_bf16(const bf16_t* r, int lane, f32x4 (&a)[4]) {
    const u32x4 lo = *(const u32x4*)(r + lane * 8), hi = *(const u32x4*)(r + 512 + lane * 8);
    a[0] = (f32x4){bflo(lo[0]), bfhi(lo[0]), bflo(lo[1]), bfhi(lo[1])}; a[1] = (f32x4){bflo(lo[2]), bfhi(lo[2]), bflo(lo[3]), bfhi(lo[3])};
    a[2] = (f32x4){bflo(hi[0]), bfhi(hi[0]), bflo(hi[1]), bfhi(hi[1])}; a[3] = (f32x4){bflo(hi[2]), bfhi(hi[2]), bflo(hi[3]), bfhi(hi[3])}; }
__device__ __forceinline__ void st_row_bf16(bf16_t* r, int lane, const f32x4 (&a)[4]) {
    u32x4 lo, hi; lo[0] = cvtpk(a[0][0], a[0][1]); lo[1] = cvtpk(a[0][2], a[0][3]); lo[2] = cvtpk(a[1][0], a[1][1]); lo[3] = cvtpk(a[1][2], a[1][3]);
    hi[0] = cvtpk(a[2][0], a[2][1]); hi[1] = cvtpk(a[2][2], a[2][3]); hi[2] = cvtpk(a[3][0], a[3][1]); hi[3] = cvtpk(a[3][2], a[3][3]);
    *(u32x4*)(r + lane * 8) = lo; *(u32x4*)(r + 512 + lane * 8) = hi; }
__device__ __forceinline__ void norm_row_store_A(const f32x4 (&a)[4], const float* g, int lane, bf16_t* dst) {
    float ss = 0.f;
#pragma unroll
    for (int i = 0; i < 4; ++i)
#pragma unroll
        for (int e = 0; e < 4; ++e) ss += a[i][e] * a[i][e];
    ss = wsum(ss); const float r = rsqrtf(ss * (1.0f / DM) + EPS);
#pragma unroll
    for (int i = 0; i < 4; ++i) { const f32x4 gv = *(const f32x4*)(g + 256 * i + 4 * lane); st4bf(dst + 256 * i + 4 * lane, a[i] * r * gv); }
}
__device__ __forceinline__ void norm_row_store(const f32x4& a0, const f32x4& a1, const f32x4& a2, const f32x4& a3, const float* g, int lane, bf16_t* dst) {
    float ss = 0.f;
#pragma unroll
    for (int e = 0; e < 4; ++e) ss += a0[e] * a0[e] + a1[e] * a1[e] + a2[e] * a2[e] + a3[e] * a3[e];
    ss = wsum(ss); const float r = rsqrtf(ss * (1.0f / DM) + EPS);
    const f32x4 g0 = *(const f32x4*)(g + lane * 8), g1 = *(const f32x4*)(g + lane * 8 + 4), g2 = *(const f32x4*)(g + 512 + lane * 8), g3 = *(const f32x4*)(g + 512 + lane * 8 + 4);
    u32x4 w0, w1;
    w0.x = cvtpk(a0[0] * r * g0[0], a0[1] * r * g0[1]); w0.y = cvtpk(a0[2] * r * g0[2], a0[3] * r * g0[3]); w0.z = cvtpk(a1[0] * r * g1[0], a1[1] * r * g1[1]); w0.w = cvtpk(a1[2] * r * g1[2], a1[3] * r * g1[3]);
    w1.x = cvtpk(a2[0] * r * g2[0], a2[1] * r * g2[1]); w1.y = cvtpk(a2[2] * r * g2[2], a2[3] * r * g2[3]); w1.z = cvtpk(a3[0] * r * g3[0], a3[1] * r * g3[1]); w1.w = cvtpk(a3[2] * r * g3[2], a3[3] * r * g3[3]);
    *(u32x4*)(dst + lane * 8) = w0; *(u32x4*)(dst + 512 + lane * 8) = w1;
}

__device__ __forceinline__ void tr_tile(const float* src, int N, int k0, int n0, bf16_t* dst, int ldd, int mode, float scale, const float* kgain, float* tile) {
    const int tid = threadIdx.x;
    __syncthreads();
#pragma unroll
    for (int i = 0; i < 8; ++i) { const int idx = tid + 512 * i, kk = idx >> 6, nn = idx & 63;
        float v = 0.f; if (n0 + nn < N) v = src[(size_t)(k0 + kk) * N + n0 + nn];
        if (kgain) v *= kgain[k0 + kk];
        tile[kk * 65 + nn] = v * scale; }
    __syncthreads();
#pragma unroll
    for (int i = 0; i < 8; ++i) { const int idx = tid + 512 * i, nn = idx >> 6, kk = idx & 63; const int n = n0 + nn;
        if (n < N) { int r = n; if (mode) r = (n >> 7) * 256 + (mode - 1) * 128 + (n & 127);
            dst[(size_t)r * ldd + k0 + kk] = (bf16_t)(cvtpk(tile[kk * 65 + nn], 0.f) & 0xffffu); } }
}

__device__ __forceinline__ void phase_prep(const Params& P, char* lds) {
    unsigned char* ws = P.ws; float* tile = (float*)lds;
    const int bid = blockIdx.x, nb = gridDim.x, tid = threadIdx.x;
    const int NJ = 12;
    const int cnt[NJ] = {16 * 23, 4 * 12, 2 * 16, 12 * 4, 256, 2048, 2048, 2048, 64, 256, 16, 16};
    int total = 0;
#pragma unroll
    for (int j = 0; j < NJ; ++j) total += cnt[j];
    if (!(P.sub & 16)) for (int u = bid; u < total; u += nb) {
        int j = 0, r = u;
#pragma unroll
        for (int jj = 0; jj < NJ - 1; ++jj) if (j == jj && r >= cnt[jj]) { r -= cnt[jj]; j = jj + 1; }
        switch (j) {
        case 0: tr_tile(P.w_in, INW, (r / 23) * 64, (r % 23) * 64, (bf16_t*)(ws + OFF_WIN), 1024, 0, 1.f, nullptr, tile); break;
        case 1: tr_tile(P.w_uq, 768, (r / 12) * 64, (r % 12) * 64, (bf16_t*)(ws + OFF_WUQ), 256, 0, 1.f, P.q_norm_g, tile); break;
        case 2: tr_tile(P.w_ukv, 1024, (r / 16) * 64, (r % 16) * 64, (bf16_t*)(ws + OFF_WUKV), 128, 0, 1.f, P.kv_norm_g, tile); break;
        case 3: { const int mat = r >> 2, t4 = r & 3, kind = mat >> 2, h = mat & 3; const float* s = (kind == 0 ? P.w_mq : kind == 1 ? P.w_mk : P.w_mv) + h * 16384;
                  tr_tile(s, 128, (t4 >> 1) * 64, (t4 & 1) * 64, (bf16_t*)(ws + OFF_WM) + mat * 16384, 128, 0, kind == 1 ? 0.08838834764831845f : 1.f, nullptr, tile); } break;
        case 4: tr_tile(P.w_o, 1024, (r >> 4) * 64, (r & 15) * 64, (bf16_t*)(ws + OFF_WO), 1024, 0, 1.f, nullptr, tile); break;
        case 5: { const int e = r >> 6, t6 = r & 63; tr_tile(P.w_gate_e + (size_t)e * 1024 * 256, 256, (t6 >> 2) * 64, (t6 & 3) * 64, (bf16_t*)(ws + OFF_WGU) + (size_t)e * 512 * 1024, 1024, 1, 1.f, nullptr, tile); } break;
        case 6: { const int e = r >> 6, t6 = r & 63; tr_tile(P.w_up_e + (size_t)e * 1024 * 256, 256, (t6 >> 2) * 64, (t6 & 3) * 64, (bf16_t*)(ws + OFF_WGU) + (size_t)e * 512 * 1024, 1024, 2, 1.f, nullptr, tile); } break;
        case 7: { const int e = r >> 6, t6 = r & 63; tr_tile(P.w_down_e + (size_t)e * 256 * 1024, 1024, (t6 >> 4) * 64, (t6 & 15) * 64, (bf16_t*)(ws + OFF_WD) + (size_t)e * 1024 * 256, 256, 0, 1.f, nullptr, tile); } break;
        case 8: tr_tile(P.w_ple, 1024, (r >> 4) * 64, (r & 15) * 64, (bf16_t*)(ws + OFF_WPLE), 256, 0, 1.f, nullptr, tile); break;
        case 9: tr_tile(P.w_pg, 1024, (r >> 4) * 64, (r & 15) * 64, (bf16_t*)(ws + OFF_WPG), 1024, 0, 1.f, nullptr, tile); break;
        case 10: tr_tile(P.w_rg, 4, r * 64, 0, (bf16_t*)(ws + OFF_WR), 1024, 0, 1.f, nullptr, tile); break;
        default: tr_tile(P.w_re, 32, r * 64, 0, (bf16_t*)(ws + OFF_WR) + 4 * 1024, 1024, 0, 1.f, nullptr, tile); break;
        }
    }
    { u32x4 z = (u32x4){0u, 0u, 0u, 0u};
      u32x4* a = (u32x4*)((bf16_t*)(ws + OFF_WIN) + (size_t)INW * 1024); const int na = (INWP - INW) * 1024 / 8;
      for (int i = bid * 512 + tid; i < na; i += nb * 512) a[i] = z;
      u32x4* b = (u32x4*)((bf16_t*)(ws + OFF_WR) + 36 * 1024); const int nbz = (128 - 36) * 1024 / 8;
      for (int i = bid * 512 + tid; i < nbz; i += nb * 512) b[i] = z; }
    if (!(P.sub & 128)) { float2* rt = (float2*)(ws + OFF_ROPE);
      for (int i = bid * 512 + tid; i < T_TOK * 16; i += nb * 512) { const int t = i >> 4, j = i & 15;
          const float inv = 1.0f / powf(10000.0f, (float)(2 * j) / 32.0f); const float ang = (float)P.pos[t] * inv; float s, c; sincosf(ang, &s, &c); rt[i] = make_float2(c, s); } }
    if (!(P.sub & 64)) { const f32x4* src = (const f32x4*)P.p; u32x2* dst = (u32x2*)(ws + OFF_PB);
      for (int i = bid * 512 + tid; i < T_TOK * 256 / 4; i += nb * 512) { const f32x4 v = src[i]; u32x2 w; w.x = cvtpk(v[0], v[1]); w.y = cvtpk(v[2], v[3]); dst[i] = w; } }
    if (!(P.sub & 32)) { const int lane = tid & 63, wv = tid >> 6; bf16_t* xn = (bf16_t*)(ws + OFF_XN);
      for (int r0 = (bid * 8 + wv) * 4; r0 < T_TOK; r0 += nb * 8 * 4) {
          f32x4 a[4][4];
#pragma unroll
          for (int q = 0; q < 4; ++q) { const float* xr = P.x + (size_t)(r0 + q) * DM;
#pragma unroll
              for (int i = 0; i < 4; ++i) a[q][i] = *(const f32x4*)(xr + 256 * i + 4 * lane); }
#pragma unroll
          for (int q = 0; q < 4; ++q) norm_row_store_A(a[q], P.norm_mix_g, lane, xn + (size_t)(r0 + q) * DM); } }
}

__device__ __forceinline__ void phase_inproj(const Params& P, char* lds) {
    unsigned char* ws = P.ws; const bf16_t* xn = (const bf16_t*)(ws + OFF_XN); const bf16_t* Wt = (const bf16_t*)(ws + OFF_WIN);
    bf16_t* proj = (bf16_t*)(ws + OFF_PROJ); bf16_t* Kb = (bf16_t*)P.out + (size_t)T_TOK * QW; float* gates = (float*)(ws + OFF_GATES); const float2* rope = (const float2*)(ws + OFF_ROPE);
    const int G = gridDim.x, xs = xcd_slot();
    g8::phase((LAS unsigned char*)lds,
      [&](int i, g8::Unit& u) { const int id = xs + i * G; if (id >= 128 * 6) return false; const int mt = id / 6, nt = id % 6;
          u.A = (const char*)(xn + (size_t)mt * 256 * DM); u.B = (const char*)(Wt + (size_t)nt * 256 * DM); u.gather = nullptr; u.nvalid = 0; u.K = DM; u.perm = (nt != 1); u.i0 = mt; u.i1 = nt; u.i2 = 0; return true; },
      [&](const f32x4 (&acc)[2][2][4][2], const g8::Unit& u, int wr, int wc, int fr, int fq) {
        const int m0 = u.i0 * 256, n0 = u.i1 * 256;
        if (u.perm) {
#pragma unroll
            for (int ai = 0; ai < 2; ++ai)
#pragma unroll
              for (int m = 0; m < 4; ++m) { const int row = m0 + 128 * ai + 64 * wr + 16 * m + fr;
#pragma unroll
                for (int bj = 0; bj < 2; ++bj) { const int c32 = n0 + 128 * bj + 32 * wc;
                    if (c32 + 32 <= C_IG) st8bf(proj + (size_t)row * INWP + c32 + 8 * fq, acc[ai][bj][m][0], acc[ai][bj][m][1]);
                    else if (c32 == C_IG && fq == 0) { *(f32x4*)(gates + (size_t)row * 8) = acc[ai][bj][m][0]; *(f32x4*)(gates + (size_t)row * 8 + 4) = acc[ai][bj][m][1]; } } }
            return; }
#pragma unroll
        for (int ai = 0; ai < 2; ++ai)
#pragma unroll
          for (int m = 0; m < 4; ++m) { const int row = m0 + 128 * ai + 64 * wr + 16 * m + fr;
#pragma unroll
            for (int bj = 0; bj < 2; ++bj)
#pragma unroll
              for (int n = 0; n < 2; ++n) { const int c16 = n0 + 128 * bj + 32 * wc + 16 * n, col = c16 + 4 * fq;
                if (c16 == C_KR) {
                    const f32x4 x1 = acc[ai][bj][m][0], x2 = acc[ai][bj][m][1]; f32x4 o1, o2;
#pragma unroll
                    for (int e = 0; e < 4; ++e) { const float2 cs = rope[(size_t)row * 16 + 4 * fq + e]; o1[e] = x1[e] * cs.x - x2[e] * cs.y; o2[e] = x1[e] * cs.y + x2[e] * cs.x; }
#pragma unroll
                    for (int h = 0; h < 8; ++h) { st4bf(Kb + (size_t)row * KW + h * 96 + 64 + 4 * fq, o1); st4bf(Kb + (size_t)row * KW + h * 96 + 80 + 4 * fq, o2); }
                } else if (c16 == C_KR + 16) {   }
                else if (c16 == C_IG) { if (fq < 2) *(f32x4*)(gates + (size_t)row * 8 + 4 * fq) = acc[ai][bj][m][n]; }
                else if (c16 < C_IG) st4bf(proj + (size_t)row * INWP + col, acc[ai][bj][m][n]);
              } }
      });
}

constexpr int LDS_RS = LDS_GEMM;
__device__ __forceinline__ void mla_unit(const Params& P, int mt, int part, char* lds) {
    unsigned char* ws = P.ws; const bf16_t* proj = (const bf16_t*)(ws + OFF_PROJ);
    bf16_t* Qb = (bf16_t*)P.out; bf16_t* Kb = Qb + (size_t)T_TOK * QW; bf16_t* Vb = Kb + (size_t)T_TOK * KW; const float2* rope = (const float2*)(ws + OFF_ROPE);
    const int tid = threadIdx.x, lane = tid & 63, wid = RFL(tid >> 6), wr = wid >> 1, wc = wid & 1, fr = lane & 15, fq = lane >> 4;
    float* rs = (float*)(lds + LDS_RS);
    const int m0 = mt * 256;
    __syncthreads();
    { const int row = tid >> 1, half = tid & 1; const int cw = part == 0 ? 256 : 128, c0 = part == 0 ? C_CQ : C_CKV; const int per = cw / 2;
      const bf16_t* src = proj + (size_t)(m0 + row) * INWP + c0 + half * per; float ss = 0.f;
      for (int i = 0; i < per / 8; ++i) { const u32x4 v = *(const u32x4*)(src + i * 8);
#pragma unroll
          for (int e = 0; e < 4; ++e) { const float a = bflo(v[e]), b = bfhi(v[e]); ss += a * a + b * b; } }
      ss += __shfl_xor(ss, 1);
      if (half == 0) rs[row] = rsqrtf(ss / (float)cw + EPS); }
    __syncthreads();
    if (part == 0) {
        const bf16_t* Wt = (const bf16_t*)(ws + OFF_WUQ);
        gemm_tiles<4>(6, [&](int nt) { return gdesc(proj + C_CQ, INWP, m0, Wt + (size_t)nt * 128 * 256, 256, 4); },
          [&](int nt, f32x4 (&acc)[4][4]) {
#pragma unroll
            for (int m = 0; m < 4; ++m) { const int lr = wr * 64 + 16 * m + fr, row = m0 + lr; const float r = rs[lr] * QSCALE;
#pragma unroll
                for (int n = 0; n < 4; n += 2) { const int g16 = nt * 8 + wc * 4 + n, h = g16 / 6, jj = g16 % 6;
                    if (jj == 4) { const f32x4 x1 = acc[m][n] * r, x2 = acc[m][n + 1] * r; f32x4 o1, o2;
#pragma unroll
                        for (int e = 0; e < 4; ++e) { const float2 cs = rope[(size_t)row * 16 + 4 * fq + e]; o1[e] = x1[e] * cs.x - x2[e] * cs.y; o2[e] = x1[e] * cs.y + x2[e] * cs.x; }
                        st4bf(Qb + (size_t)row * QW + h * 96 + 64 + 4 * fq, o1); st4bf(Qb + (size_t)row * QW + h * 96 + 80 + 4 * fq, o2);
                    } else { st4bf(Qb + (size_t)row * QW + g16 * 16 + 4 * fq, acc[m][n] * r); st4bf(Qb + (size_t)row * QW + (g16 + 1) * 16 + 4 * fq, acc[m][n + 1] * r); } } }
          }, lds);
    } else {
        const bf16_t* Wt = (const bf16_t*)(ws + OFF_WUKV);
        gemm_tiles<4>(8, [&](int nt) { return gdesc(proj + C_CKV, INWP, m0, Wt + (size_t)nt * 128 * 128, 128, 2); },
          [&](int nt, f32x4 (&acc)[4][4]) {
#pragma unroll
            for (int m = 0; m < 4; ++m) { const int lr = wr * 64 + 16 * m + fr, row = m0 + lr; const float r = rs[lr];
#pragma unroll
                for (int n = 0; n < 4; ++n) { const int jj = wc * 4 + n;
                    if (jj < 4) st4bf(Kb + (size_t)row * KW + nt * 96 + jj * 16 + 4 * fq, acc[m][n] * r);
                    else st4bf(Vb + (size_t)row * VW + nt * 64 + (jj - 4) * 16 + 4 * fq, acc[m][n] * r); } }
          }, lds);
    }
}

__device__ __forceinline__ void gate_prep(const Params& P, int tok0, int h, float* sb, float* sgs, float* spm, float* sbl, float* sa) {
    const float* gates = (const float*)(P.ws + OFF_GATES);
    const int tid = threadIdx.x, lane = tid & 63, w = tid >> 6;
    const float fpre = gates[(size_t)(tok0 + tid) * 8 + 4 + h] + P.b_fgate[h], ig = gates[(size_t)(tok0 + tid) * 8 + h] + P.b_igate[h];
    const float logf = fminf(fpre, 0.f) - log1pf(__expf(-fabsf(fpre)));
    float b = logf;
#pragma unroll
    for (int o = 1; o < 64; o <<= 1) { const float t = __shfl_up(b, o); if (lane >= o) b += t; }
    const float gs = ig - b; float pm = gs;
#pragma unroll
    for (int o = 1; o < 64; o <<= 1) { const float t = __shfl_up(pm, o); if (lane >= o) pm = fmaxf(pm, t); }
    const float bl = __shfl(b, 63), mx = __shfl(pm, 63);
    sb[tid] = b; sgs[tid] = gs; spm[tid] = pm;
    if (lane == 0) { sbl[w] = bl; sa[w] = bl + mx; }
}

constexpr int LDS_M1_G = LDS_GEMM + 1024;
__device__ __forceinline__ void mlstm_unit1(const Params& P, int u, char* lds) {
    unsigned char* ws = P.ws; const bf16_t* proj = (const bf16_t*)(ws + OFF_PROJ);
    bf16_t* xc = (bf16_t*)(ws + OFF_XC); bf16_t* mq = (bf16_t*)(ws + OFF_MQ); bf16_t* mk = (bf16_t*)(ws + OFF_MK); bf16_t* mv = (bf16_t*)(ws + OFF_MV);
    const int b = u >> 6, h = (u >> 4) & 3, g = u & 15, tok0 = b * SEQ + g * 512;
    const int tid = threadIdx.x, lane = tid & 63, wid = RFL(tid >> 6), wr = wid >> 1, wc = wid & 1, fr = lane & 15, fq = lane >> 4, r32 = lane & 31, hi = lane >> 5;
    { const int ch = h * 128 + (tid & 15) * 8, sl = tid >> 4;
      float wv[4][8], bias[8];
#pragma unroll
      for (int k = 0; k < 4; ++k)
#pragma unroll
          for (int e = 0; e < 8; ++e) wv[k][e] = P.conv_w[k * 512 + ch + e];
#pragma unroll
      for (int e = 0; e < 8; ++e) bias[e] = P.conv_b[ch + e];
      const int tin0 = g * 512 + sl * 16; const bf16_t* src = proj + (size_t)(b * SEQ + tin0) * INWP + C_XM + ch;
      u32x4 xr[19];
#pragma unroll
      for (int i = 0; i < 19; ++i) { const int tt = tin0 - 3 + i; xr[i] = (u32x4){0u, 0u, 0u, 0u}; if (tt >= 0) xr[i] = *(const u32x4*)(src + (ptrdiff_t)(i - 3) * INWP); }
#pragma unroll
      for (int i = 0; i < 16; ++i) { float a[8];
#pragma unroll
          for (int e = 0; e < 8; ++e) a[e] = bias[e];
#pragma unroll
          for (int k = 0; k < 4; ++k) { const u32x4 v = xr[i + k];
#pragma unroll
              for (int e = 0; e < 4; ++e) { a[2 * e] += wv[k][2 * e] * bflo(v[e]); a[2 * e + 1] += wv[k][2 * e + 1] * bfhi(v[e]); } }
          u32x4 o;
#pragma unroll
          for (int e = 0; e < 4; ++e) o[e] = cvtpk(siluf(a[2 * e]), siluf(a[2 * e + 1]));
          *(u32x4*)(xc + (size_t)(tok0 + sl * 16 + i) * 512 + ch) = o; } }
    WAITVM0(); __syncthreads();
    gemm_tiles<4>(6, [&](int t) { const int kind = t >> 1, rt = t & 1; const bf16_t* A = kind < 2 ? xc + h * 128 : proj + C_XM + h * 128;
                                  return gdesc(A, kind < 2 ? 512 : INWP, tok0 + rt * 256, (const bf16_t*)(ws + OFF_WM) + (kind * 4 + h) * 16384, 128, 2); },
      [&](int t, f32x4 (&acc)[4][4]) { const int kind = t >> 1, rt = t & 1, m0 = tok0 + rt * 256; bf16_t* dst = kind == 0 ? mq : kind == 1 ? mk : mv;
#pragma unroll
        for (int m = 0; m < 4; ++m) { const int row = m0 + wr * 64 + 16 * m + fr;
#pragma unroll
            for (int n = 0; n < 4; ++n) st4bf(dst + (size_t)row * 512 + h * 128 + wc * 64 + 16 * n + 4 * fq, acc[m][n]); }
      }, lds);
    WAITVM0(); __syncthreads();
    float* sb = (float*)(lds + LDS_M1_G); float* sgs = sb + 512; float* spm = sgs + 512; float* sbl = spm + 512; float* sa = sbl + 8;
    gate_prep(P, tok0, h, sb, sgs, spm, sbl, sa);
    __syncthreads();
    if (tid < 8) { float* cs = (float*)(ws + OFF_CSTAT) + ((size_t)(b * 4 + h) * 128 + g * 8 + tid) * 2; cs[0] = sbl[tid]; cs[1] = sa[tid]; }
    float tail[8]; float mend = -INFINITY;
    { float acc = 0.f;
#pragma unroll
      for (int j = 7; j >= 0; --j) { tail[j] = acc; mend = fmaxf(mend, acc + sa[j]); acc += sbl[j]; } }
    f32x16 cacc[2], nacc; cacc[0] = f32x16{}; cacc[1] = f32x16{}; nacc = f32x16{};
    const bf16x8 ones = (bf16x8){0x3f80, 0x3f80, 0x3f80, 0x3f80, 0x3f80, 0x3f80, 0x3f80, 0x3f80};
    const int s0 = tid >> 4, c8 = tid & 15; const size_t gbase = (size_t)(tok0 + s0) * 512 + h * 128 + c8 * 8;
    u32x4 kq0 = *(const u32x4*)(mk + gbase), kq1 = *(const u32x4*)(mk + gbase + 32 * 512), vq0 = *(const u32x4*)(mv + gbase), vq1 = *(const u32x4*)(mv + gbase + 32 * 512);
#pragma unroll 1
    for (int j = 0; j < 8; ++j) {
        char* img = lds + (j & 1) * 32768;
        { const float e0 = tail[j] + sbl[j] - mend; const float w0 = __expf(e0 + sgs[j * 64 + s0]), w1 = __expf(e0 + sgs[j * 64 + s0 + 32]);
          u32x4 k0, k1;
#pragma unroll
          for (int e = 0; e < 4; ++e) { k0[e] = cvtpk(bflo(kq0[e]) * w0, bfhi(kq0[e]) * w0); k1[e] = cvtpk(bflo(kq1[e]) * w1, bfhi(kq1[e]) * w1); }
          const int off = (c8 >> 2) * 4096 + s0 * 64 + (c8 & 3) * 16;
          *(u32x4*)(img + off) = k0; *(u32x4*)(img + off + 32 * 64) = k1; *(u32x4*)(img + 16384 + off) = vq0; *(u32x4*)(img + 16384 + off + 32 * 64) = vq1; }
        if (j < 7) { const size_t gn = gbase + (size_t)(j + 1) * 64 * 512; kq0 = *(const u32x4*)(mk + gn); kq1 = *(const u32x4*)(mk + gn + 32 * 512); vq0 = *(const u32x4*)(mv + gn); vq1 = *(const u32x4*)(mv + gn + 32 * 512); }
        __syncthreads();
        { const int q = (lane & 15) >> 2, p = lane & 3, cb = (lane >> 4) & 1;
          const lds_cptr kp = (lds_cptr)img + wr * 4096 + (4 * hi + q) * 64 + cb * 32 + p * 8;
          const lds_cptr vp = (lds_cptr)img + 16384 + (2 * wc) * 4096 + (4 * hi + q) * 64 + cb * 32 + p * 8;
#pragma unroll
          for (int ks = 0; ks < 4; ++ks) { const bf16x8 af = cat8(vtr(kp + ks * 1024), vtr(kp + ks * 1024 + 512));
              const bf16x8 b0 = cat8(vtr(vp + ks * 1024), vtr(vp + ks * 1024 + 512)), b1 = cat8(vtr(vp + 4096 + ks * 1024), vtr(vp + 4096 + ks * 1024 + 512));
              cacc[0] = MFMA32(af, b0, cacc[0]); cacc[1] = MFMA32(af, b1, cacc[1]);
              if (wc == 0) nacc = MFMA32(af, ones, nacc); } }
    }
    bf16_t* st = (bf16_t*)(ws + OFF_STATE) + (size_t)u * 16384; float* nst = (float*)(ws + OFF_NST) + (size_t)u * 128; float* mst = (float*)(ws + OFF_MST) + u;
#pragma unroll
    for (int nb2 = 0; nb2 < 2; ++nb2)
#pragma unroll
        for (int r = 0; r < 16; ++r) st[(wr * 32 + crow(r, hi)) * 128 + wc * 64 + nb2 * 32 + r32] = (bf16_t)(cvtpk(cacc[nb2][r], 0.f) & 0xffffu);
    if (wc == 0 && r32 == 0) {
#pragma unroll
        for (int r = 0; r < 16; ++r) nst[wr * 32 + crow(r, hi)] = nacc[r]; }
    if (tid == 0) mst[0] = mend;
    __syncthreads();
}

constexpr int LDS_AK = 0, LDS_AV = 2 * 12288, LDS_AW = LDS_AV + 2 * 8192;
#ifndef ATT_THR
#define ATT_THR 8.0f
#endif
__device__ __forceinline__ void attn_unit(const Params& P, int b, int h, int qb, char* lds) {
    const bf16_t* Qb = (const bf16_t*)P.out; const bf16_t* Kb = Qb + (size_t)T_TOK * QW; const bf16_t* Vb = Kb + (size_t)T_TOK * KW; bf16_t* att = (bf16_t*)(P.ws + OFF_MIX);
    const int tid = threadIdx.x, lane = tid & 63, r32 = lane & 31, hi = lane >> 5; const int wid = RFL(tid >> 6);
    const unsigned lds0 = (unsigned)(uintptr_t)lds;
    const size_t rowbase = (size_t)b * SEQ; const int q0 = qb * 256, NT = 4 * qb + 4, mynt = 4 * qb + (wid >> 1) + 1;
    const bf16_t* Qw = Qb + (rowbase + q0 + wid * 32 + r32) * QW + h * 96;
    bf16x8 qr[6];
#pragma unroll
    for (int d0 = 0; d0 < 6; ++d0) qr[d0] = *(const bf16x8*)(Qw + d0 * 16 + hi * 8);
    const bf16_t* ksrc0 = Kb + (rowbase + lane) * KW + h * 96 + wid * 8;
    const bf16_t* ksrc1 = Kb + (rowbase + lane) * KW + h * 96 + (8 + (wid & 3)) * 8;
    const bf16_t* vsrc = Vb + (rowbase + 16 * (wid & 3) + (lane >> 2)) * VW + h * 64 + (wid >> 2) * 32 + (lane & 3) * 8;
    float* wsf = (float*)(lds + LDS_AW) + wid * 64;
    float mhat = 0.f, l_reg = 0.f; f32x16 o0 = f32x16{}, o1 = f32x16{};
    const lds_cptr vp0 = (lds_cptr)lds + LDS_AV + ((lane >> 4) & 1) * 32 + (lane & 3) * 8 + (4 * hi + ((lane & 15) >> 2)) * 64;
    const char* kp0 = lds + LDS_AK + hi * 1024 + r32 * 16;
    auto dma = [&](int t, int slot) {
        glds16(ksrc0 + (size_t)t * 64 * KW, RFL(lds0 + LDS_AK + slot * 12288 + wid * 1024));
        if (wid < 4) glds16(ksrc1 + (size_t)t * 64 * KW, RFL(lds0 + LDS_AK + slot * 12288 + (8 + wid) * 1024));
        glds16(vsrc + (size_t)t * 64 * VW, RFL(lds0 + LDS_AV + slot * 8192 + wid * 1024));
    };
    __syncthreads();
    dma(0, 0);
    for (int t = 0; t < NT; ++t) {
        asm volatile("s_waitcnt vmcnt(0) lgkmcnt(0)" ::: "memory"); __syncthreads();
        if (t + 1 < NT) dma(t + 1, (t + 1) & 1);
        if (t < mynt) {
            const char* kp = kp0 + (t & 1) * 12288;
            f32x16 s0 = f32x16{}, s1 = f32x16{};
#pragma unroll
            for (int d0 = 0; d0 < 6; ++d0) { const bf16x8 k0 = *(const bf16x8*)(kp + d0 * 2048), k1 = *(const bf16x8*)(kp + d0 * 2048 + 512);
                s0 = MFMA32(k0, qr[d0], s0); s1 = MFMA32(k1, qr[d0], s1); }
            float rm = s0[0];
#pragma unroll
            for (int r = 1; r < 16; ++r) rm = fmaxf(rm, s0[r]);
#pragma unroll
            for (int r = 0; r < 16; ++r) rm = fmaxf(rm, s1[r]);
            rm = fmaxf(rm, __shfl_xor(rm, 32));
            if (t == 0) mhat = rm;
            else { const float d = rm - mhat;
                if (__any(d > ATT_THR)) { const float dl = fmaxf(d, 0.f); mhat += dl; const float f = __builtin_amdgcn_exp2f(-dl); l_reg *= f;
                    if (hi == 0) wsf[r32] = f; WAITLGKM0();
#pragma unroll
                    for (int r = 0; r < 16; ++r) { const float fr_ = wsf[crow(r, hi)]; o0[r] *= fr_; o1[r] *= fr_; }
                    WAITLGKM0(); } }
            float sacc = 0.f;
#pragma unroll
            for (int r = 0; r < 16; ++r) { s0[r] = __builtin_amdgcn_exp2f(s0[r] - mhat); s1[r] = __builtin_amdgcn_exp2f(s1[r] - mhat); sacc += s0[r] + s1[r]; }
            l_reg += sacc;
            u32x4 pw[4];
#pragma unroll
            for (int i = 0; i < 4; ++i) { pw[0][i] = cvtpk(s0[2 * i], s0[2 * i + 1]); pw[1][i] = cvtpk(s0[8 + 2 * i], s0[8 + 2 * i + 1]); pw[2][i] = cvtpk(s1[2 * i], s1[2 * i + 1]); pw[3][i] = cvtpk(s1[8 + 2 * i], s1[8 + 2 * i + 1]); }
            const lds_cptr vp = vp0 + (t & 1) * 8192;
#pragma unroll
            for (int ks = 0; ks < 4; ++ks) { const bf16x8 pa = __builtin_bit_cast(bf16x8, pw[ks]);
                const bf16x8 v0 = cat8(vtr(vp + ks * 1024), vtr(vp + ks * 1024 + 512)), v1 = cat8(vtr(vp + 4096 + ks * 1024), vtr(vp + 4096 + ks * 1024 + 512));
                o0 = MFMA32(pa, v0, o0); o1 = MFMA32(pa, v1, o1); }
        }
    }
    l_reg += __shfl_xor(l_reg, 32);
    WAITLGKM0();
    if (hi == 0) wsf[32 + r32] = l_reg;
    WAITLGKM0();
    bf16_t* Ow = att + (rowbase + q0 + wid * 32) * 1024 + h * 64;
#pragma unroll
    for (int r = 0; r < 16; ++r) { const int orow = crow(r, hi); const float rl = 1.0f / wsf[32 + orow];
        Ow[(size_t)orow * 1024 + r32] = (bf16_t)(cvtpk(o0[r] * rl, 0.f) & 0xffffu); Ow[(size_t)orow * 1024 + 32 + r32] = (bf16_t)(cvtpk(o1[r] * rl, 0.f) & 0xffffu); }
    WAITLGKM0();
}

constexpr int LDS_M2_C = 0, LDS_M2_Q = 32768, LDS_M2_K = 49152, LDS_M2_V = 65536, LDS_M2_KS = 81920, LDS_M2_NUM = 98304  , LDS_M2_MISC = 98304 + 33792;
__device__ __forceinline__ void mlstm_unit2(const Params& P, int u, char* lds) {
    unsigned char* ws = P.ws; const bf16_t* proj = (const bf16_t*)(ws + OFF_PROJ);
    const bf16_t* xc = (const bf16_t*)(ws + OFF_XC); const bf16_t* mq = (const bf16_t*)(ws + OFF_MQ); const bf16_t* mk = (const bf16_t*)(ws + OFF_MK); const bf16_t* mv = (const bf16_t*)(ws + OFF_MV);
    bf16_t* mlo = (bf16_t*)(ws + OFF_MIX) + 512;
    const int b = u >> 6, h = (u >> 4) & 3, g = u & 15, tok0 = b * SEQ + g * 512, seq = b * 4 + h;
    const int tid = threadIdx.x, lane = tid & 63, wid = RFL(tid >> 6), r32 = lane & 31, hi = lane >> 5, wr = wid >> 1, wc = wid & 1;
    float* misc = (float*)(lds + LDS_M2_MISC);
    float* sb = misc; float* sgs = sb + 512; float* spm = sgs + 512; float* sbl = spm + 512; float* sa = sbl + 8;
    float* marr = sa + 8; float* fbarr = marr + 136; float* cst = fbarr + 136;
    float* nfull = cst + 256; float* nseg = nfull + 128; float* sden = nseg + 128; float* swi = sden + 64; float* coef = swi + 64;
    __syncthreads();
    gate_prep(P, tok0, h, sb, sgs, spm, sbl, sa);
    if (tid < 256) cst[tid] = ((const float*)(ws + OFF_CSTAT))[(size_t)seq * 256 + tid];
    __syncthreads();
    if (wid == 0) { const float b0 = cst[4 * lane], a0 = cst[4 * lane + 1], b1 = cst[4 * lane + 2], a1 = cst[4 * lane + 3];
        float B = b0 + b1, A = fmaxf(a0 + b1, a1);
#pragma unroll
        for (int o = 1; o < 64; o <<= 1) { const float Bp = __shfl_up(B, o), Ap = __shfl_up(A, o); if (lane >= o) { A = fmaxf(Ap + B, A); B = Bp + B; } }
        float Be = __shfl_up(B, 1), Ae = __shfl_up(A, 1); if (lane == 0) { Be = 0.f; Ae = -INFINITY; }
        const float m_in = fmaxf(Be + 0.f, Ae);
        const float m_mid = fmaxf(b0 + m_in, a0);
        marr[2 * lane] = m_in; marr[2 * lane + 1] = m_mid; fbarr[2 * lane] = Be; fbarr[2 * lane + 1] = Be + b0;
        if (lane == 63) { marr[128] = fmaxf(b1 + m_mid, a1); fbarr[128] = B; } }
    __syncthreads();
    const float* mstg = (const float*)(ws + OFF_MST);
    if (tid < 16) { float c = 0.f; if (tid < g) c = __expf(mstg[u - g + tid] + (fbarr[8 * g] - fbarr[8 * (tid + 1)]) - marr[8 * g]); coef[tid] = c; }
    __syncthreads();
    f32x16 cacc[2];
    { float cseg[32];
#pragma unroll
      for (int i = 0; i < 32; ++i) cseg[i] = 0.f;
      float nsg = 0.f;
      const bf16_t* stall = (const bf16_t*)(ws + OFF_STATE); const float* nstall = (const float*)(ws + OFF_NST);
#pragma unroll 4
      for (int gp = 0; gp < g; ++gp) { const float c = coef[gp]; const bf16_t* st = stall + (size_t)(u - g + gp) * 16384;
#pragma unroll
          for (int i = 0; i < 4; ++i) { const u32x4 v = *(const u32x4*)(st + (i * 512 + tid) * 8);
#pragma unroll
              for (int e = 0; e < 4; ++e) { cseg[i * 8 + 2 * e] += c * bflo(v[e]); cseg[i * 8 + 2 * e + 1] += c * bfhi(v[e]); } }
          if (tid < 128) nsg += c * nstall[(size_t)(u - g + gp) * 128 + tid]; }
      if (tid < 128) nseg[tid] = nsg;
      float* tmp = (float*)lds;
#pragma unroll
      for (int i = 0; i < 4; ++i) { *(f32x4*)(tmp + (i * 512 + tid) * 8) = (f32x4){cseg[i * 8], cseg[i * 8 + 1], cseg[i * 8 + 2], cseg[i * 8 + 3]}; *(f32x4*)(tmp + (i * 512 + tid) * 8 + 4) = (f32x4){cseg[i * 8 + 4], cseg[i * 8 + 5], cseg[i * 8 + 6], cseg[i * 8 + 7]}; }
      __syncthreads();
#pragma unroll
      for (int nb2 = 0; nb2 < 2; ++nb2)
#pragma unroll
          for (int r = 0; r < 16; ++r) cacc[nb2][r] = tmp[(wr * 32 + crow(r, hi)) * 128 + wc * 64 + nb2 * 32 + r32];
    }
    const int tb = wid & 1, db = wid >> 1;
    const int s0 = tid >> 4, c8 = tid & 15; const size_t gbase = (size_t)(tok0 + s0) * 512 + h * 128 + c8 * 8;
    u32x4 qa0 = *(const u32x4*)(mq + gbase), qa1 = *(const u32x4*)(mq + gbase + 32 * 512), ka0 = *(const u32x4*)(mk + gbase), ka1 = *(const u32x4*)(mk + gbase + 32 * 512),
          va0 = *(const u32x4*)(mv + gbase), va1 = *(const u32x4*)(mv + gbase + 32 * 512);
#pragma unroll 1
    for (int j = 0; j < 8; ++j) {
        int tz = threadIdx.x; asm volatile("" : "+v"(tz));
        const int tid = tz, lane = tz & 63, r32 = lane & 31, hi = lane >> 5; const int wid = RFL(tz >> 6), wr = wid >> 1, wc = wid & 1, tb = wid & 1, db = wid >> 1, s0 = tz >> 4, c8 = tz & 15;
        const int c = 8 * g + j; const float mc = marr[c], mn = marr[c + 1], bl = sbl[j]; const float decay = __expf(bl + mc - mn);
        __syncthreads();
#pragma unroll
        for (int nb2 = 0; nb2 < 2; ++nb2)
#pragma unroll
            for (int r = 0; r < 16; ++r) *(bf16_t*)(lds + LDS_M2_C + (2 * wc + nb2) * 8192 + (wr * 32 + crow(r, hi)) * 64 + r32 * 2) = (bf16_t)(cvtpk(cacc[nb2][r], 0.f) & 0xffffu);
        float* ncur = (j & 1) ? nfull : nseg; float* nnxt = (j & 1) ? nseg : nfull;
        { const float w0 = __expf(bl + sgs[j * 64 + s0] - mn), w1 = __expf(bl + sgs[j * 64 + s0 + 32] - mn);
          u32x4 k0, k1;
#pragma unroll
          for (int e = 0; e < 4; ++e) { k0[e] = cvtpk(bflo(ka0[e]) * w0, bfhi(ka0[e]) * w0); k1[e] = cvtpk(bflo(ka1[e]) * w1, bfhi(ka1[e]) * w1); }
          const int so0 = s0 * 256 + ((c8 ^ (s0 & 15)) << 4), so1 = (s0 + 32) * 256 + ((c8 ^ (s0 & 15)) << 4);
          *(u32x4*)(lds + LDS_M2_Q + so0) = qa0; *(u32x4*)(lds + LDS_M2_Q + so1) = qa1; *(u32x4*)(lds + LDS_M2_K + so0) = ka0; *(u32x4*)(lds + LDS_M2_K + so1) = ka1;
          const int off = (c8 >> 2) * 4096 + s0 * 64 + (c8 & 3) * 16;
          *(u32x4*)(lds + LDS_M2_V + off) = va0; *(u32x4*)(lds + LDS_M2_V + off + 32 * 64) = va1; *(u32x4*)(lds + LDS_M2_KS + off) = k0; *(u32x4*)(lds + LDS_M2_KS + off + 32 * 64) = k1; }
        if (tid < 64) swi[tid] = __expf(mc - fmaxf(spm[j * 64 + tid], mc));
        const int ft = tid >> 3, pp = tid & 7; const size_t ftok = (size_t)tok0 + j * 64 + ft; const int fch = h * 128 + 16 * pp;
        u32x4 xa, xb, za, zb;
        __syncthreads();
        { const int t = 32 * tb + r32; const float mt = fmaxf(spm[j * 64 + t], mc);
          const char* qrow = lds + LDS_M2_Q + t * 256;
          f32x16 sT[2]; sT[0] = f32x16{}; sT[1] = f32x16{};
#pragma unroll
          for (int ks = 0; ks < 8; ++ks) { const bf16x8 qf = *(const bf16x8*)(qrow + (((2 * ks + hi) ^ (t & 15)) << 4));
              { const int s = r32; const bf16x8 kf = *(const bf16x8*)(lds + LDS_M2_K + s * 256 + (((2 * ks + hi) ^ (s & 15)) << 4)); sT[0] = MFMA32(kf, qf, sT[0]); }
              if (tb) { const int s = 32 + r32; const bf16x8 kf = *(const bf16x8*)(lds + LDS_M2_K + s * 256 + (((2 * ks + hi) ^ (s & 15)) << 4)); sT[1] = MFMA32(kf, qf, sT[1]); } }
          float dsum = 0.f;
#pragma unroll
          for (int sbk = 0; sbk < 2; ++sbk)
#pragma unroll
              for (int r = 0; r < 16; ++r) { const int s = 32 * sbk + crow(r, hi); const float w = (s <= t) ? __expf(sgs[j * 64 + s] - mt) : 0.f; const float v = sT[sbk][r] * w; sT[sbk][r] = v; dsum += v; }
          dsum += __shfl_xor(dsum, 32);
          if (db == 0 && hi == 0) sden[t] = dsum;
          u32x4 pw[4];
#pragma unroll
          for (int i = 0; i < 4; ++i) { pw[0][i] = cvtpk(sT[0][2 * i], sT[0][2 * i + 1]); pw[1][i] = cvtpk(sT[0][8 + 2 * i], sT[0][8 + 2 * i + 1]); pw[2][i] = cvtpk(sT[1][2 * i], sT[1][2 * i + 1]); pw[3][i] = cvtpk(sT[1][8 + 2 * i], sT[1][8 + 2 * i + 1]); }
          const int q = (lane & 15) >> 2, p = lane & 3, cb = (lane >> 4) & 1;
          const lds_cptr vp = (lds_cptr)lds + LDS_M2_V + db * 4096 + (4 * hi + q) * 64 + cb * 32 + p * 8;
          f32x16 o1 = f32x16{}, o2 = f32x16{};
#pragma unroll
          for (int ks = 0; ks < 4; ++ks) { if (ks < 2 * (tb + 1)) { const bf16x8 vf = cat8(vtr(vp + ks * 1024), vtr(vp + ks * 1024 + 512)); o1 = MFMA32(__builtin_bit_cast(bf16x8, pw[ks]), vf, o1); } }
          const lds_cptr cp = (lds_cptr)lds + LDS_M2_C + db * 8192 + (8 * hi + q) * 64 + cb * 32 + p * 8;
#pragma unroll
          for (int ks = 0; ks < 8; ++ks) { const bf16x8 qf = *(const bf16x8*)(qrow + (((2 * ks + hi) ^ (t & 15)) << 4)); const bf16x8 cf = cat8(vtr(cp + ks * 1024), vtr(cp + ks * 1024 + 256)); o2 = MFMA32(qf, cf, o2); }
          float* num = (float*)(lds + LDS_M2_NUM);
#pragma unroll
          for (int r = 0; r < 16; ++r) { const int tr_ = 32 * tb + crow(r, hi); num[tr_ * 132 + db * 32 + r32] = o1[r] + swi[tr_] * o2[r]; }
          if (j < 7) { const size_t gn = gbase + (size_t)(j + 1) * 64 * 512; qa0 = *(const u32x4*)(mq + gn); qa1 = *(const u32x4*)(mq + gn + 32 * 512); ka0 = *(const u32x4*)(mk + gn); ka1 = *(const u32x4*)(mk + gn + 32 * 512);
              va0 = *(const u32x4*)(mv + gn); va1 = *(const u32x4*)(mv + gn + 32 * 512); }
#pragma unroll
          for (int r = 0; r < 16; ++r) { cacc[0][r] *= decay; cacc[1][r] *= decay; }
          const lds_cptr kp = (lds_cptr)lds + LDS_M2_KS + wr * 4096 + (4 * hi + q) * 64 + cb * 32 + p * 8;
          const lds_cptr vp2 = (lds_cptr)lds + LDS_M2_V + (2 * wc) * 4096 + (4 * hi + q) * 64 + cb * 32 + p * 8;
#pragma unroll
          for (int ks = 0; ks < 4; ++ks) { const bf16x8 af = cat8(vtr(kp + ks * 1024), vtr(kp + ks * 1024 + 512));
              const bf16x8 b0 = cat8(vtr(vp2 + ks * 1024), vtr(vp2 + ks * 1024 + 512)), b1 = cat8(vtr(vp2 + 4096 + ks * 1024), vtr(vp2 + 4096 + ks * 1024 + 512));
              cacc[0] = MFMA32(af, b0, cacc[0]); cacc[1] = MFMA32(af, b1, cacc[1]); }
          if (tid < 128) { float a = 0.f; const char* kcol = lds + LDS_M2_KS + (tid >> 5) * 4096 + (tid & 31) * 2;
#pragma unroll 8
              for (int s2 = 0; s2 < 64; ++s2) a += bf2f(*(const bf16_t*)(kcol + s2 * 64));
              nnxt[tid] = decay * ncur[tid] + a; } }
        xa = *(const u32x4*)(xc + ftok * 512 + fch); xb = *(const u32x4*)(xc + ftok * 512 + fch + 8);
        za = *(const u32x4*)(proj + ftok * INWP + C_Z + fch); zb = *(const u32x4*)(proj + ftok * INWP + C_Z + fch + 8);
        __syncthreads();
        { const int t = ft; const float* num = (const float*)(lds + LDS_M2_NUM);
          float qn = 0.f;
#pragma unroll
          for (int cc = 0; cc < 2; ++cc) { const u32x4 qv = *(const u32x4*)(lds + LDS_M2_Q + t * 256 + (((2 * pp + cc) ^ (t & 15)) << 4));
#pragma unroll
              for (int e = 0; e < 4; ++e) qn += bflo(qv[e]) * ncur[16 * pp + 8 * cc + 2 * e] + bfhi(qv[e]) * ncur[16 * pp + 8 * cc + 2 * e + 1]; }
          qn += __shfl_xor(qn, 1); qn += __shfl_xor(qn, 2); qn += __shfl_xor(qn, 4);
          const float mt = sb[j * 64 + t] + fmaxf(spm[j * 64 + t], mc);
          float den = sden[t] + swi[t] * qn; den = fmaxf(fabsf(den), __expf(-mt)); const float rden = 1.0f / den;
          float hv[16]; float s1 = 0.f;
#pragma unroll
          for (int e = 0; e < 16; ++e) { hv[e] = num[t * 132 + 16 * pp + e] * rden; s1 += hv[e]; }
          s1 += __shfl_xor(s1, 1); s1 += __shfl_xor(s1, 2); s1 += __shfl_xor(s1, 4);
          const float mu = s1 * (1.0f / 128.0f); float s2 = 0.f;
#pragma unroll
          for (int e = 0; e < 16; ++e) { const float d = hv[e] - mu; s2 += d * d; }
          s2 += __shfl_xor(s2, 1); s2 += __shfl_xor(s2, 2); s2 += __shfl_xor(s2, 4);
          const float rstd = rsqrtf(s2 * (1.0f / 128.0f) + EPS);
          float ov[16];
#pragma unroll
          for (int e = 0; e < 16; ++e) { const unsigned xw = e < 8 ? xa[e >> 1] : xb[(e - 8) >> 1], zw = e < 8 ? za[e >> 1] : zb[(e - 8) >> 1];
              const float xcv = (e & 1) ? bfhi(xw) : bflo(xw), zv = (e & 1) ? bfhi(zw) : bflo(zw);
              const float hn = (hv[e] - mu) * rstd * P.mh_norm_g[fch + e];
              ov[e] = (hn + P.ml_skip[fch + e] * xcv) * siluf(zv); }
          u32x4 oa, ob;
#pragma unroll
          for (int e = 0; e < 4; ++e) { oa[e] = cvtpk(ov[2 * e], ov[2 * e + 1]); ob[e] = cvtpk(ov[8 + 2 * e], ov[8 + 2 * e + 1]); }
          *(u32x4*)(mlo + ftok * 1024 + fch) = oa; *(u32x4*)(mlo + ftok * 1024 + fch + 8) = ob; }
    }
}

__device__ __forceinline__ void phase_outproj(const Params& P, char* lds) {
    unsigned char* ws = P.ws; const bf16_t* mix = (const bf16_t*)(ws + OFF_MIX); const bf16_t* Wt = (const bf16_t*)(ws + OFF_WO);
    const int G = gridDim.x, xs = xcd_slot();
    g8::phase((LAS unsigned char*)lds,
      [&](int i, g8::Unit& u) { const int id = xs + i * G; if (id >= 128 * 4) return false; const int mt = id >> 2, nt = id & 3;
          u.A = (const char*)(mix + (size_t)mt * 256 * DM); u.B = (const char*)(Wt + (size_t)nt * 256 * DM); u.gather = nullptr; u.nvalid = 0; u.K = DM; u.perm = 1; u.i0 = mt; u.i1 = nt; u.i2 = 0; return true; },
      [&](const f32x4 (&acc)[2][2][4][2], const g8::Unit& u, int wr, int wc, int fr, int fq) {
        const int m0 = u.i0 * 256, n0 = u.i1 * 256;
#pragma unroll
        for (int ai = 0; ai < 2; ++ai)
#pragma unroll
          for (int m = 0; m < 4; ++m) { const size_t row = m0 + 128 * ai + 64 * wr + 16 * m + fr;
#pragma unroll
            for (int bj = 0; bj < 2; ++bj) { const int col = n0 + 128 * bj + 32 * wc + 8 * fq; const f32x4 x0 = *(const f32x4*)(P.x + row * DM + col), x1 = *(const f32x4*)(P.x + row * DM + col + 4);
                st8bf((bf16_t*)(P.ws + OFF_RES) + row * DM + col, x0 + acc[ai][bj][m][0], x1 + acc[ai][bj][m][1]); } }
      });
}

constexpr int LDS_LOGIT = LDS_GEMM;
__device__ __forceinline__ void phase_router(const Params& P, char* lds) {
    unsigned char* ws = P.ws; const bool shd = (P.sub & 256) != 0; bf16_t* hn = (bf16_t*)(ws + (shd ? OFF_PROJ : OFF_XN)); const bf16_t* Wr = (const bf16_t*)(ws + OFF_WR);
    unsigned* cnt = (unsigned*)(ws + OFF_CNT + (shd ? 8192 : 0)); int* list = (int*)(ws + (shd ? OFF_PROJ + 64 * MiB : OFF_LIST)); float* tokrec = (float*)(ws + (shd ? OFF_PROJ + 72 * MiB : OFF_TOKREC));
    const int tid = threadIdx.x, lane = tid & 63, wid = RFL(tid >> 6), wr = wid >> 1, wc = wid & 1, fr = lane & 15, fq = lane >> 4;
    float* logit = (float*)(lds + LDS_LOGIT);
    for (int u = blockIdx.x; u < 256; u += gridDim.x) {
        const int m0 = u * 128;
        for (int i = 0; i < 16; i += 4) { f32x4 a[4][4];
#pragma unroll
            for (int q = 0; q < 4; ++q) ld_row_bf16((const bf16_t*)(P.ws + OFF_RES) + (size_t)(m0 + wid * 16 + i + q) * DM, lane, a[q]);
#pragma unroll
            for (int q = 0; q < 4; ++q) norm_row_store(a[q][0], a[q][1], a[q][2], a[q][3], P.norm_ffn_g, lane, hn + (size_t)(m0 + wid * 16 + i + q) * DM); }
        WAITVM0(); __syncthreads();
        gemm_tiles<2>(1, [&](int) { return gdesc(hn, DM, m0, Wr, DM, 16); },
          [&](int, f32x4 (&acc)[2][4]) {
            if (wc == 0) {
#pragma unroll
                for (int m = 0; m < 2; ++m) { const int lr = wr * 32 + 16 * m + fr;
#pragma unroll
                    for (int n = 0; n < 3; ++n) { const int col = 16 * n + 4 * fq; if (col < 36) *(f32x4*)(logit + lr * 40 + col) = acc[m][n]; } } }
          }, lds);
        __syncthreads();
        if (tid < 128) { const int tok = m0 + tid; const float* lg = logit + tid * 40;
            float gl[4]; float gm = -INFINITY; int gi = 0;
#pragma unroll
            for (int k = 0; k < 4; ++k) { gl[k] = lg[k] + P.b_rg[k]; if (gl[k] > gm) { gm = gl[k]; gi = k; } }
            float gsum = 0.f;
#pragma unroll
            for (int k = 0; k < 4; ++k) gsum += __expf(gl[k] - gm);
            const float gtop = 1.0f / gsum;
            float el[8]; float e1 = -INFINITY, e2 = -INFINITY; int i1 = 0, i2 = 0;
#pragma unroll
            for (int k = 0; k < 8; ++k) { el[k] = lg[4 + gi * 8 + k] + P.b_re[gi * 8 + k]; }
#pragma unroll
            for (int k = 0; k < 8; ++k) { if (el[k] > e1) { e2 = e1; i2 = i1; e1 = el[k]; i1 = k; } else if (el[k] > e2) { e2 = el[k]; i2 = k; } }
            const float rr = __expf(e2 - e1); const float w1 = gtop / (1.f + rr), w2 = gtop * rr / (1.f + rr);
            const int ex1 = gi * 8 + i1, ex2 = gi * 8 + i2;
            const unsigned p1 = __hip_atomic_fetch_add(cnt + ex1 * 64, 1u, __ATOMIC_RELAXED, __HIP_MEMORY_SCOPE_AGENT);
            const unsigned p2 = __hip_atomic_fetch_add(cnt + ex2 * 64, 1u, __ATOMIC_RELAXED, __HIP_MEMORY_SCOPE_AGENT);
            list[(size_t)ex1 * T_TOK + p1] = tok; list[(size_t)ex2 * T_TOK + p2] = tok;
            f32x4 rec; rec[0] = __uint_as_float((unsigned)(ex1 << 16) | 0u); rec[1] = w1; rec[2] = __uint_as_float(p1); rec[3] = w2;
            rec[0] = __uint_as_float((unsigned)ex1 | ((unsigned)ex2 << 8));
            *(f32x4*)(tokrec + (size_t)tok * 4) = rec;
            ((unsigned*)(ws + (shd ? OFF_PROJ + 80 * MiB : OFF_GATES)))[tok] = p2;
        }
        __syncthreads();
    }
}

__device__ __forceinline__ int moe_bases(const Params& P, int* sbase, int* stile) {
    const unsigned* cnt = (const unsigned*)(P.ws + OFF_CNT);
    __syncthreads();
    if (threadIdx.x == 0) { int acc = 0, tt = 0; for (int e = 0; e < NEXP; ++e) { const int c = (int)__hip_atomic_load(cnt + e * 64, __ATOMIC_RELAXED, __HIP_MEMORY_SCOPE_AGENT); const int nt = (c + 255) >> 8; sbase[e] = acc; stile[e] = tt; acc += nt * 256; tt += nt; } sbase[NEXP] = acc; stile[NEXP] = tt; }
    __syncthreads();
    return stile[NEXP];
}

constexpr int LDS_MOE = 4 * 32768 + 1024;
__device__ __forceinline__ void phase_moe_gu(const Params& P, char* lds) {
    unsigned char* ws = P.ws; const bf16_t* hn = (const bf16_t*)(ws + OFF_XN); bf16_t* act = (bf16_t*)(ws + OFF_ACT); const int* list = (const int*)(ws + OFF_LIST);
    const unsigned* cnt = (const unsigned*)(ws + OFF_CNT);
    int* sbase = (int*)(lds + LDS_MOE); int* stile = sbase + 40;
    const int ntiles = moe_bases(P, sbase, stile);
    const int G = gridDim.x, xs = xcd_slot();
    g8::phase((LAS unsigned char*)lds,
      [&](int i, g8::Unit& u) { const int id = xs + i * G; if (id >= ntiles * 2) return false; const int ti = id >> 1, nt = id & 1; int e = 0; for (int k = 1; k < NEXP; ++k) if (stile[k] <= ti) e = k;
          const int it = ti - stile[e]; const int ce = (int)cnt[e * 64];
          u.A = (const char*)hn; u.B = (const char*)((const bf16_t*)(ws + OFF_WGU) + ((size_t)e * 512 + nt * 256) * 1024); u.gather = list + (size_t)e * T_TOK + it * 256; u.nvalid = ce - it * 256; u.K = DM; u.perm = 1;
          u.i0 = sbase[e] + it * 256; u.i1 = nt; u.i2 = e; return true; },
      [&](const f32x4 (&acc)[2][2][4][2], const g8::Unit& u, int wr, int wc, int fr, int fq) {
#pragma unroll
        for (int ai = 0; ai < 2; ++ai)
#pragma unroll
          for (int m = 0; m < 4; ++m) { const size_t row = (size_t)u.i0 + 128 * ai + 64 * wr + 16 * m + fr;
            { f32x4 v0, v1;
#pragma unroll
                for (int q = 0; q < 4; ++q) { v0[q] = siluf(acc[ai][0][m][0][q]) * acc[ai][1][m][0][q]; v1[q] = siluf(acc[ai][0][m][1][q]) * acc[ai][1][m][1][q]; }
                st8bf(act + row * DEXP + u.i1 * 128 + 32 * wc + 8 * fq, v0, v1); } }
      });
}
__device__ __forceinline__ void phase_moe_down(const Params& P, char* lds) {
    unsigned char* ws = P.ws; const bf16_t* act = (const bf16_t*)(ws + OFF_ACT); bf16_t* y = (bf16_t*)(ws + OFF_Y);
    int* sbase = (int*)(lds + LDS_MOE); int* stile = sbase + 40;
    const int ntiles = moe_bases(P, sbase, stile);
    const int G = gridDim.x, xs = xcd_slot();
    g8::phase((LAS unsigned char*)lds,
      [&](int i, g8::Unit& u) { const int id = xs + i * G; if (id >= ntiles * 4) return false; const int ti = id >> 2, nt = id & 3; int e = 0; for (int k = 1; k < NEXP; ++k) if (stile[k] <= ti) e = k;
          const int rbase = sbase[e] + (ti - stile[e]) * 256;
          u.A = (const char*)(act + (size_t)rbase * DEXP); u.B = (const char*)((const bf16_t*)(ws + OFF_WD) + ((size_t)e * 1024 + nt * 256) * 256); u.gather = nullptr; u.nvalid = 0; u.K = DEXP; u.perm = 1; u.i0 = rbase; u.i1 = nt; u.i2 = e; return true; },
      [&](const f32x4 (&acc)[2][2][4][2], const g8::Unit& u, int wr, int wc, int fr, int fq) {
#pragma unroll
        for (int ai = 0; ai < 2; ++ai)
#pragma unroll
          for (int m = 0; m < 4; ++m) { const size_t row = (size_t)u.i0 + 128 * ai + 64 * wr + 16 * m + fr;
#pragma unroll
            for (int bj = 0; bj < 2; ++bj) st8bf(y + row * DM + u.i1 * 256 + 128 * bj + 32 * wc + 8 * fq, acc[ai][bj][m][0], acc[ai][bj][m][1]); }
      });
}
__device__ __forceinline__ void phase_combine(const Params& P, char* lds) {
    unsigned char* ws = P.ws; const bf16_t* y = (const bf16_t*)(ws + OFF_Y); bf16_t* hp = (bf16_t*)(ws + OFF_XN); const float* tokrec = (const float*)(ws + OFF_TOKREC);
    int* sbase = (int*)(lds + LDS_MOE); int* stile = sbase + 40;
    (void)moe_bases(P, sbase, stile);
    const int tid = threadIdx.x, lane = tid & 63, wv = tid >> 6;
    for (int r0 = (blockIdx.x * 8 + wv) * 4; r0 < T_TOK; r0 += gridDim.x * 8 * 4) {
        f32x4 rec[4]; unsigned p2[4];
#pragma unroll
        for (int q = 0; q < 4; ++q) { rec[q] = *(const f32x4*)(tokrec + (size_t)(r0 + q) * 4); p2[q] = ((const unsigned*)(ws + OFF_GATES))[r0 + q]; }
        f32x4 a[4][4]; u32x4 ya[4][4];
#pragma unroll
        for (int q = 0; q < 4; ++q) { const unsigned ee = __float_as_uint(rec[q][0]); const int e1 = ee & 255, e2 = (ee >> 8) & 255; const unsigned p1 = __float_as_uint(rec[q][2]);
            const bf16_t* y1 = y + ((size_t)sbase[e1] + p1) * DM; const bf16_t* y2 = y + ((size_t)sbase[e2] + p2[q]) * DM;
            ld_row_bf16((const bf16_t*)(P.ws + OFF_RES) + (size_t)(r0 + q) * DM, lane, a[q]);
            ya[q][0] = *(const u32x4*)(y1 + lane * 8); ya[q][1] = *(const u32x4*)(y1 + 512 + lane * 8); ya[q][2] = *(const u32x4*)(y2 + lane * 8); ya[q][3] = *(const u32x4*)(y2 + 512 + lane * 8); }
#pragma unroll
        for (int q = 0; q < 4; ++q) { const float w1 = rec[q][1], w2 = rec[q][3]; bf16_t* xr = (bf16_t*)(P.ws + ((P.sub & 256) ? OFF_PROJ : OFF_RES)) + (size_t)(r0 + q) * DM;
#pragma unroll
            for (int e = 0; e < 2; ++e) { a[q][0][2 * e] += w1 * bflo(ya[q][0][e]) + w2 * bflo(ya[q][2][e]); a[q][0][2 * e + 1] += w1 * bfhi(ya[q][0][e]) + w2 * bfhi(ya[q][2][e]);
                a[q][1][2 * e] += w1 * bflo(ya[q][0][2 + e]) + w2 * bflo(ya[q][2][2 + e]); a[q][1][2 * e + 1] += w1 * bfhi(ya[q][0][2 + e]) + w2 * bfhi(ya[q][2][2 + e]);
                a[q][2][2 * e] += w1 * bflo(ya[q][1][e]) + w2 * bflo(ya[q][3][e]); a[q][2][2 * e + 1] += w1 * bfhi(ya[q][1][e]) + w2 * bfhi(ya[q][3][e]);
                a[q][3][2 * e] += w1 * bflo(ya[q][1][2 + e]) + w2 * bflo(ya[q][3][2 + e]); a[q][3][2 * e + 1] += w1 * bfhi(ya[q][1][2 + e]) + w2 * bfhi(ya[q][3][2 + e]); }
            st_row_bf16(xr, lane, a[q]);
            norm_row_store(a[q][0], a[q][1], a[q][2], a[q][3], P.norm_ple_g, lane, ((P.sub & 256) ? (bf16_t*)(P.ws + OFF_STATE) : hp) + (size_t)(r0 + q) * DM); }
    }
}
__device__ __forceinline__ void phase_ple(const Params& P, char* lds) {
    unsigned char* ws = P.ws; const bf16_t* hp = (const bf16_t*)(ws + OFF_XN); const bf16_t* pb = (const bf16_t*)(ws + OFF_PB); bf16_t* pe = (bf16_t*)(ws + ((P.sub & 256) ? OFF_STATE : OFF_PE)); bf16_t* res = (bf16_t*)(ws + OFF_RES); bf16_t* xout = (bf16_t*)(ws + ((P.sub & 256) ? OFF_XC : OFF_RES));
    const int G = gridDim.x, xs = xcd_slot();
    g8::phase((LAS unsigned char*)lds,
      [&](int i, g8::Unit& u) { const int id = xs + (i >> 1) * G; if (id >= 128 * 4) return false; const int mt = id >> 2, nt = id & 3; u.gather = nullptr; u.nvalid = 0; u.perm = 1; u.i0 = mt; u.i1 = nt; u.i2 = i & 1;
          if (i & 1) { u.A = (const char*)(hp + (size_t)mt * 256 * DM); u.B = (const char*)((const bf16_t*)(ws + OFF_WPG) + (size_t)nt * 256 * DM); u.K = DM; }
          else { u.A = (const char*)(pb + (size_t)mt * 256 * 256); u.B = (const char*)((const bf16_t*)(ws + OFF_WPLE) + (size_t)nt * 256 * 256); u.K = 256; }
          return true; },
      [&](const f32x4 (&acc)[2][2][4][2], const g8::Unit& u, int wr, int wc, int fr, int fq) {
        const int m0 = u.i0 * 256, n0 = u.i1 * 256;
#pragma unroll
        for (int ai = 0; ai < 2; ++ai)
#pragma unroll
          for (int m = 0; m < 4; ++m) { const size_t row = m0 + 128 * ai + 64 * wr + 16 * m + fr;
#pragma unroll
            for (int bj = 0; bj < 2; ++bj) { const int col = n0 + 128 * bj + 32 * wc + 8 * fq;
                if (!u.i2) st8bf(pe + row * DM + col, acc[ai][bj][m][0], acc[ai][bj][m][1]);
                else { const u32x4 pw = *(const u32x4*)(pe + row * DM + col); const u32x4 xw = *(const u32x4*)(res + row * DM + col); const f32x4 a0 = acc[ai][bj][m][0], a1 = acc[ai][bj][m][1]; f32x4 o0, o1;
                    o0[0] = bflo(xw.x) + bflo(pw.x) * sigmf(a0[0]); o0[1] = bfhi(xw.x) + bfhi(pw.x) * sigmf(a0[1]); o0[2] = bflo(xw.y) + bflo(pw.y) * sigmf(a0[2]); o0[3] = bfhi(xw.y) + bfhi(pw.y) * sigmf(a0[3]);
                    o1[0] = bflo(xw.z) + bflo(pw.z) * sigmf(a1[0]); o1[1] = bfhi(xw.z) + bfhi(pw.z) * sigmf(a1[1]); o1[2] = bflo(xw.w) + bflo(pw.w) * sigmf(a1[2]); o1[3] = bfhi(xw.w) + bfhi(pw.w) * sigmf(a1[3]);
                    st8bf(xout + row * DM + col, o0, o1); } } }
      });
}
__device__ __forceinline__ void phase_final(const Params& P) {
    const int tid = threadIdx.x, lane = tid & 63, wv = tid >> 6; const float* g = P.final_g; const bf16_t* res = (const bf16_t*)(P.ws + OFF_RES);
    f32x4 gv[4];
#pragma unroll
    for (int i = 0; i < 4; ++i) gv[i] = *(const f32x4*)(g + 256 * i + 4 * lane);
    for (int r0 = (blockIdx.x * 8 + wv) * 4; r0 < T_TOK; r0 += gridDim.x * 8 * 4) {
        u32x2 w[4][4];
#pragma unroll
        for (int q = 0; q < 4; ++q)
#pragma unroll
            for (int i = 0; i < 4; ++i) w[q][i] = *(const u32x2*)(res + (size_t)(r0 + q) * DM + 256 * i + 4 * lane);
#pragma unroll
        for (int q = 0; q < 4; ++q) { float* xr = P.out + (size_t)(r0 + q) * DM; f32x4 a[4]; float ss = 0.f;
#pragma unroll
            for (int i = 0; i < 4; ++i) { a[i] = (f32x4){bflo(w[q][i].x), bfhi(w[q][i].x), bflo(w[q][i].y), bfhi(w[q][i].y)};
#pragma unroll
                for (int e = 0; e < 4; ++e) ss += a[i][e] * a[i][e]; }
            ss = wsum(ss); const float r = rsqrtf(ss * (1.0f / DM) + EPS);
#pragma unroll
            for (int i = 0; i < 4; ++i) *(f32x4*)(xr + 256 * i + 4 * lane) = a[i] * r * gv[i]; } }
}
constexpr int NPHASE = 11;
constexpr int LDS_BYTES = 144 * 1024;
__global__ void __launch_bounds__(512, 2) mk_fwd(Params P) {
    extern __shared__ __attribute__((aligned(16))) char lds[];
    volatile LAS unsigned* xbw = (volatile LAS unsigned*)(LAS char*)(lds + LDS_BYTES - 16);
    if (threadIdx.x == 0) { xbw[0] = 0u; xbw[1] = 0u; xbw[2] = 0u; xbw[3] = 0u; }
    __syncthreads();
    XcdBarrier bar = xcd_barrier_post((unsigned*)(P.ws + OFF_BAR), xbw);
    const int lo = P.ph_lo, hi = P.ph_hi;
#define PH(k) (lo <= (k) && (k) < hi)
#define SEAM(k) if (lo <= (k) && (k) + 1 < hi) xcd_barrier(bar)
    if (PH(0)) phase_prep(P, lds);
    SEAM(0);
    if (PH(1) && !(P.sub & 8)) phase_inproj(P, lds);
    SEAM(1);
    if (PH(2)) { for (int u = blockIdx.x; u < 256; u += gridDim.x) { mla_unit(P, u >> 1, u & 1, lds); mlstm_unit1(P, u, lds); } }
    SEAM(2);
    if (PH(3)) {
        if (!(P.sub & 1)) for (int u = blockIdx.x; u < 512; u += gridDim.x) { const int x = u & 7, kk = u >> 3, bh = x + 8 * (kk >> 4), j = kk & 15;
#pragma unroll 1
            for (int hf = 0; hf < 2; ++hf) attn_unit(P, bh >> 3, bh & 7, hf ? 31 - j : j, lds); }
        if (!(P.sub & 2)) for (int u = blockIdx.x; u < 256; u += gridDim.x) mlstm_unit2(P, u, lds);
    }
    SEAM(3);
    if (PH(4)) phase_outproj(P, lds);
    SEAM(4);
    if (PH(5)) phase_router(P, lds);
    SEAM(5);
    if (PH(6)) phase_moe_gu(P, lds);
    SEAM(6);
    if (PH(7)) phase_moe_down(P, lds);
    SEAM(7);
    if (PH(8)) phase_combine(P, lds);
    SEAM(8);
    if (PH(9)) phase_ple(P, lds);
    SEAM(9);
    if (PH(10)) phase_final(P);
}

#ifndef DUP_PHASE
#define DUP_PHASE -1
#endif
#ifndef DUP_REPS
#define DUP_REPS 2
#endif
#ifndef DUP_SUB
#define DUP_SUB 0
#endif
#ifndef DBG_PHASES
#define DBG_PHASES 0
#endif
#ifndef DBG_OFF
#define DBG_OFF OFF_MQ
#endif
#ifndef DBG_LD
#define DBG_LD 512
#endif
#ifndef DBG_C0
#define DBG_C0 0
#endif
#ifndef DBG_NC
#define DBG_NC 512
#endif
#ifndef DBG_ROWS
#define DBG_ROWS T_TOK
#endif
__global__ void __launch_bounds__(256) dbg_dump(const bf16_t* src, float* out) {
    for (size_t i = (size_t)blockIdx.x * 256 + threadIdx.x; i < (size_t)T_TOK * DM; i += (size_t)gridDim.x * 256) { const size_t r = i / DM; const int c = (int)(i % DM); float a = 0.f;
        for (size_t rr = r; rr < (size_t)DBG_ROWS; rr += T_TOK) for (int cc = c; cc < DBG_NC; cc += DM) a += bf2f(src[rr * DBG_LD + DBG_C0 + cc]);
        out[i] = a; }
}
extern "C" void kernel_launch(void* const* d_in, const int* in_sizes, int n_in, void* d_out, int out_size, void* d_ws, size_t ws_size, hipStream_t stream) {
    static int grid = 0;
    if (grid == 0) {
        if (n_in != 31 || in_sizes[0] != T_TOK * DM || out_size != T_TOK * DM || ws_size < WS_END) { fprintf(stderr, "kernel_launch: unexpected shapes (n_in %d, ws %zu < %zu)\n", n_in, ws_size, (size_t)WS_END); grid = -1; return; }
        int dev = 0, cus = 0, per_cu = 0;
        if (hipGetDevice(&dev) != hipSuccess || hipDeviceGetAttribute(&cus, hipDeviceAttributeMultiprocessorCount, dev) != hipSuccess) { grid = -1; return; }
        if (hipFuncSetAttribute((const void*)mk_fwd, hipFuncAttributeMaxDynamicSharedMemorySize, LDS_BYTES) != hipSuccess) { fprintf(stderr, "kernel_launch: hipFuncSetAttribute failed\n"); grid = -1; return; }
        if (hipOccupancyMaxActiveBlocksPerMultiprocessor(&per_cu, (const void*)mk_fwd, 512, LDS_BYTES) != hipSuccess || per_cu < 1) fprintf(stderr, "kernel_launch: occupancy query reports %d\n", per_cu);
        (void)hipGetLastError();
        grid = cus;
    }
    if (grid < 0) return;
    (void)hipMemsetAsync(d_ws, 0, CTL_BYTES, stream);
    Params P{};
    P.x = (const float*)d_in[0]; P.p = (const float*)d_in[1]; P.pos = (const int*)d_in[2];
    P.norm_mix_g = (const float*)d_in[3]; P.w_in = (const float*)d_in[4]; P.q_norm_g = (const float*)d_in[5]; P.w_uq = (const float*)d_in[6]; P.kv_norm_g = (const float*)d_in[7]; P.w_ukv = (const float*)d_in[8];
    P.conv_w = (const float*)d_in[9]; P.conv_b = (const float*)d_in[10]; P.w_mq = (const float*)d_in[11]; P.w_mk = (const float*)d_in[12]; P.w_mv = (const float*)d_in[13];
    P.b_igate = (const float*)d_in[14]; P.b_fgate = (const float*)d_in[15]; P.mh_norm_g = (const float*)d_in[16]; P.ml_skip = (const float*)d_in[17]; P.w_o = (const float*)d_in[18];
    P.norm_ffn_g = (const float*)d_in[19]; P.w_rg = (const float*)d_in[20]; P.b_rg = (const float*)d_in[21]; P.w_re = (const float*)d_in[22]; P.b_re = (const float*)d_in[23];
    P.w_gate_e = (const float*)d_in[24]; P.w_up_e = (const float*)d_in[25]; P.w_down_e = (const float*)d_in[26]; P.norm_ple_g = (const float*)d_in[27]; P.w_ple = (const float*)d_in[28]; P.w_pg = (const float*)d_in[29]; P.final_g = (const float*)d_in[30];
    P.out = (float*)d_out; P.ws = (unsigned char*)d_ws;
#if DBG_PHASES
    for (int k = 0; k < DBG_PHASES; ++k) { P.ph_lo = k; P.ph_hi = k + 1; hipLaunchKernelGGL(mk_fwd, dim3(grid), dim3(512), LDS_BYTES, stream, P); }
    hipLaunchKernelGGL(dbg_dump, dim3(2048), dim3(256), 0, stream, (const bf16_t*)((unsigned char*)d_ws + DBG_OFF), (float*)d_out);
#elif MK_MULTI
    for (int k = 0; k < NPHASE; ++k) { P.ph_lo = k; P.ph_hi = k + 1;
        if (k == DUP_PHASE) for (int r = 0; r < DUP_REPS; ++r) { P.sub = DUP_SUB; hipLaunchKernelGGL(mk_fwd, dim3(grid), dim3(512), LDS_BYTES, stream, P); }
        P.sub = 0; hipLaunchKernelGGL(mk_fwd, dim3(grid), dim3(512), LDS_BYTES, stream, P); }
#else
    P.ph_lo = 0; P.ph_hi = NPHASE; hipLaunchKernelGGL(mk_fwd, dim3(grid), dim3(512), LDS_BYTES, stream, P);
#endif
}
```

```cpp
#include <hip/hip_runtime.h>
#include <cstdio>
#include <cstdint>

#ifndef MK_MULTI
#define MK_MULTI 0
#endif

typedef unsigned short bf16_t;
typedef short bf16x8 __attribute__((ext_vector_type(8)));
typedef short s16x4 __attribute__((ext_vector_type(4)));
typedef float f32x4 __attribute__((ext_vector_type(4)));
typedef float f32x16 __attribute__((ext_vector_type(16)));
typedef unsigned u32x4 __attribute__((ext_vector_type(4)));
typedef unsigned u32x2 __attribute__((ext_vector_type(2)));
#define LAS __attribute__((address_space(3)))
typedef LAS const char* lds_cptr;
typedef short v4i16_t __attribute__((ext_vector_type(4)));

constexpr int T_TOK = 32768, DM = 1024, SEQ = 8192, NB = 4;
constexpr int INW = 1448, INWP = 1536;
constexpr int C_CQ = 0, C_CKV = 256, C_KR = 384, C_XM = 416, C_Z = 928, C_IG = 1440;
constexpr int QW = 768, KW = 768, VW = 512;
constexpr int NEXP = 32, DEXP = 256;
constexpr int PROWS = 65536 + 32 * 256;
constexpr float EPS = 1e-6f;
constexpr float QSCALE = 0.10206207261596577f * 1.4426950408889634f;

constexpr size_t MiB = 1ull << 20;
constexpr size_t OFF_BAR = 0;
constexpr size_t OFF_CNT = 16384;
constexpr size_t CTL_BYTES = 32768;
constexpr size_t OFF_WIN = 1 * MiB;
constexpr size_t OFF_WUQ = OFF_WIN + (size_t)INWP * 1024 * 2;
constexpr size_t OFF_WUKV = OFF_WUQ + 768 * 256 * 2;
constexpr size_t OFF_WM = OFF_WUKV + 1024 * 128 * 2;
constexpr size_t OFF_WO = OFF_WM + 12 * 128 * 128 * 2;
constexpr size_t OFF_WR = OFF_WO + 1024 * 1024 * 2;
constexpr size_t OFF_WGU = OFF_WR + 128 * 1024 * 2;
constexpr size_t OFF_WD = OFF_WGU + (size_t)32 * 512 * 1024 * 2;
constexpr size_t OFF_WPLE = OFF_WD + (size_t)32 * 1024 * 256 * 2;
constexpr size_t OFF_WPG = OFF_WPLE + 1024 * 256 * 2;
constexpr size_t OFF_ROPE = OFF_WPG + 1024 * 1024 * 2;
constexpr size_t OFF_PB = OFF_ROPE + (size_t)T_TOK * 32 * 4;
constexpr size_t OFF_GATES = OFF_PB + (size_t)T_TOK * 256 * 2;
constexpr size_t OFF_CSTAT = OFF_GATES + (size_t)T_TOK * 8 * 4;
constexpr size_t OFF_NST = OFF_CSTAT + 2048 * 2 * 4;
constexpr size_t OFF_MST = OFF_NST + 256 * 8 * 128 * 4;
constexpr size_t OFF_TOKREC = OFF_MST + 256 * 8 * 4;
constexpr size_t OFF_LIST = OFF_TOKREC + (size_t)T_TOK * 16;
constexpr size_t OFF_KROPE = OFF_LIST;
constexpr size_t OFF_STATIC_END = OFF_LIST + (size_t)32 * T_TOK * 4;
static_assert(OFF_STATIC_END <= 88 * MiB, "static region");
constexpr size_t OFF_PROJ = 88 * MiB;
constexpr size_t OFF_XC = OFF_PROJ + 96 * MiB;
constexpr size_t OFF_MQ = OFF_XC + 32 * MiB;
constexpr size_t OFF_MK = OFF_MQ + 32 * MiB;
constexpr size_t OFF_MV = OFF_MK + 32 * MiB;
constexpr size_t OFF_MIX = OFF_MV + 32 * MiB;
constexpr size_t OFF_XN = OFF_MIX + 64 * MiB;
constexpr size_t OFF_STATE = OFF_XN + 64 * MiB;
constexpr size_t WS_END = OFF_STATE + 64 * MiB;
static_assert(WS_END <= 512 * MiB, "workspace");
constexpr size_t OFF_ACT = OFF_PROJ;
constexpr size_t OFF_Y = OFF_XC;
static_assert(OFF_Y + (size_t)PROWS * 1024 * 2 <= OFF_XN, "y overlay");
constexpr size_t OFF_RS0 = OFF_TOKREC;
constexpr size_t OFF_SSQ = OFF_XC;
constexpr size_t OFF_LRS = OFF_XC + 8 * MiB;
constexpr size_t OFF_RS2 = OFF_GATES + 256 * 1024;
constexpr size_t OFF_RES = OFF_STATE;

#define XB_TMO      128
#define XB_XCNT(j)  (256  + 64 * (j))
#define XB_XSUB(j)  (1280 + 64 * (j))
#define XB_XGEN(j)  (2304 + 64 * (j))
#define XB_TOP      3328
#define XB_TOPGEN   3392
#define XCD_BAR_WORDS 3456
#define XB_SPIN_CAP (1u << 18)

__device__ __forceinline__ unsigned xb_ld(unsigned* p)              { return __hip_atomic_load(p, __ATOMIC_RELAXED, __HIP_MEMORY_SCOPE_AGENT); }
__device__ __forceinline__ unsigned xb_add(unsigned* p, unsigned v) { return __hip_atomic_fetch_add(p, v, __ATOMIC_RELAXED, __HIP_MEMORY_SCOPE_AGENT); }
__device__ __forceinline__ unsigned xb_xcc_id() { return (unsigned)__builtin_amdgcn_s_getreg((3 << 11) | 20) & 0xFu; }
#define XB_SPIN(cond, bar) do { unsigned _sp = 0; while (cond) { __builtin_amdgcn_s_sleep(1); \
    if ((++_sp & 255u) == 0u) { if (xb_ld(&(bar)[XB_TMO])) break; if (_sp > XB_SPIN_CAP) { atomicAdd(&(bar)[XB_TMO], 1u); break; } } } } while (0)

struct XcdBarrier { unsigned* bar; unsigned x; volatile LAS unsigned* st; };

__device__ __forceinline__ XcdBarrier xcd_barrier_post(unsigned* bar, volatile LAS unsigned* st) {
    XcdBarrier b; b.bar = bar; b.x = xb_xcc_id(); b.st = st;
    if (threadIdx.x == 0) (void)xb_add(&bar[XB_XCNT(b.x)], 1u);
    return b;
}
__device__ __forceinline__ void xcd_barrier_complete(unsigned* bar, unsigned x, unsigned& nloc, unsigned& nx) {
    const unsigned G = gridDim.x * gridDim.y * gridDim.z;
    unsigned sum, cnt, mine, sp = 0u;
    for (;;) {
        sum = 0u; cnt = 0u; mine = 0u;
#pragma unroll
        for (unsigned j = 0; j < 16; ++j) { const unsigned c = xb_ld(&bar[XB_XCNT(j)]); sum += c; cnt += (c > 0u) ? 1u : 0u; mine = (j == x) ? c : mine; }
        if (sum == G) break;
        __builtin_amdgcn_s_sleep(1);
        if ((++sp & 255u) == 0u) { if (xb_ld(&bar[XB_TMO])) break; if (sp > XB_SPIN_CAP) { atomicAdd(&bar[XB_TMO], 1u); break; } }
    }
    nloc = mine > 0u ? mine : 1u; nx = cnt > 0u ? cnt : 1u;
}
__device__ __forceinline__ void xcd_barrier(const XcdBarrier& b) {
    asm volatile("s_waitcnt vmcnt(0)" ::: "memory");
    __syncthreads();
    if (threadIdx.x == 0) {
        unsigned* bar = b.bar;
        __builtin_amdgcn_s_waitcnt(0);
        unsigned nloc = b.st[0], nx = b.st[1];
        if (nloc == 0u) { xcd_barrier_complete(bar, b.x, nloc, nx); b.st[0] = nloc; b.st[1] = nx; }
        const unsigned old = xb_add(&bar[XB_XSUB(b.x)], 1u);
        const unsigned gen = old / nloc;
        if (old + 1u == (gen + 1u) * nloc) {
            __builtin_amdgcn_fence(__ATOMIC_RELEASE, "agent");
            asm volatile("s_waitcnt vmcnt(0)" ::: "memory");
            const unsigned og = xb_add(&bar[XB_TOP], 1u);
            const unsigned tg = og / nx;
            if (og + 1u == (tg + 1u) * nx) xb_add(&bar[XB_TOPGEN], 1u);
            else XB_SPIN(xb_ld(&bar[XB_TOPGEN]) == tg, bar);
            __builtin_amdgcn_fence(__ATOMIC_ACQUIRE, "agent");
            xb_add(&bar[XB_XGEN(b.x)], 1u);
            asm volatile("s_waitcnt vmcnt(0)" ::: "memory");
        } else {
            XB_SPIN(xb_ld(&bar[XB_XGEN(b.x)]) == gen, bar);
            __builtin_amdgcn_fence(__ATOMIC_ACQUIRE, "agent");
            asm volatile("s_waitcnt vmcnt(0)" ::: "memory");
        }
    }
    __syncthreads();
}

typedef __bf16 bf16x2_t __attribute__((ext_vector_type(2)));
typedef float f32x2 __attribute__((ext_vector_type(2)));
__device__ __forceinline__ unsigned cvtpk(float lo, float hi) { f32x2 v = {lo, hi}; bf16x2_t b = __builtin_convertvector(v, bf16x2_t); return __builtin_bit_cast(unsigned, b); }
__device__ __forceinline__ float bf2f(unsigned short v) { return __uint_as_float((unsigned)v << 16); }
__device__ __forceinline__ float bflo(unsigned w) { return __uint_as_float(w << 16); }
__device__ __forceinline__ float bfhi(unsigned w) { return __uint_as_float(w & 0xffff0000u); }
__device__ __forceinline__ void st4bf(bf16_t* p, f32x4 v) { u32x2 w; w.x = cvtpk(v[0], v[1]); w.y = cvtpk(v[2], v[3]); *(u32x2*)p = w; }
__device__ __forceinline__ void st8bf(bf16_t* p, f32x4 a, f32x4 b) { u32x4 w; w.x = cvtpk(a[0], a[1]); w.y = cvtpk(a[2], a[3]); w.z = cvtpk(b[0], b[1]); w.w = cvtpk(b[2], b[3]); *(u32x4*)p = w; }
__device__ __forceinline__ float wsum(float v) {
#pragma unroll
    for (int o = 32; o > 0; o >>= 1) v += __shfl_xor(v, o);
    return v; }
__device__ __forceinline__ float wmax(float v) {
#pragma unroll
    for (int o = 32; o > 0; o >>= 1) v = fmaxf(v, __shfl_xor(v, o));
    return v; }
__device__ __forceinline__ float sigmf(float v) { return __builtin_amdgcn_rcpf(1.f + __builtin_amdgcn_exp2f(-1.4426950408889634f * v)); }
__device__ __forceinline__ float siluf(float v) { return v * sigmf(v); }
__device__ __forceinline__ void glds16(const void* g, unsigned lds_base) {
    unsigned sv; asm volatile("s_mov_b32 %0, m0\n\ts_mov_b32 m0, %2\n\ts_nop 0\n\tglobal_load_lds_dwordx4 %1, off\n\ts_mov_b32 m0, %0" : "=&s"(sv) : "v"(g), "s"(lds_base) : "memory"); }
__device__ __forceinline__ const void* rfl_ptr(const void* p) { const unsigned long long v = (unsigned long long)p; const unsigned lo = __builtin_amdgcn_readfirstlane((unsigned)v), hi = __builtin_amdgcn_readfirstlane((unsigned)(v >> 32)); return (const void*)(((unsigned long long)hi << 32) | lo); }
__device__ __forceinline__ void glds16s(const void* sbase, unsigned voff, unsigned lds_base) {
    unsigned sv; asm volatile("s_mov_b32 %0, m0\n\ts_mov_b32 m0, %3\n\ts_nop 0\n\tglobal_load_lds_dwordx4 %1, %2\n\ts_mov_b32 m0, %0" : "=&s"(sv) : "v"(voff), "s"(sbase), "s"(lds_base) : "memory"); }
#define RFL(x) __builtin_amdgcn_readfirstlane(x)
#define MFMA16(a, b, c) __builtin_amdgcn_mfma_f32_16x16x32_bf16(a, b, c, 0, 0, 0)
#define MFMA32(a, b, c) __builtin_amdgcn_mfma_f32_32x32x16_bf16(a, b, c, 0, 0, 0)
#define WAITVM0() asm volatile("s_waitcnt vmcnt(0)" ::: "memory")
#define WAITLGKM0() asm volatile("s_waitcnt lgkmcnt(0)" ::: "memory")
__device__ __forceinline__ int crow(int r, int hi) { return (r & 3) + 8 * (r >> 2) + 4 * hi; }
__device__ __forceinline__ s16x4 vtr(lds_cptr p) { return __builtin_bit_cast(s16x4, __builtin_amdgcn_ds_read_tr16_b64_v4i16((LAS v4i16_t*)p)); }
__device__ __forceinline__ bf16x8 cat8(s16x4 a, s16x4 b) { return (bf16x8){a[0], a[1], a[2], a[3], b[0], b[1], b[2], b[3]}; }

__device__ __forceinline__ int xcd_slot() { const int G = gridDim.x, b = blockIdx.x; return (G & 7) ? b : (b & 7) * (G >> 3) + (b >> 3); }
struct Params {
    const float* x; const float* p; const int* pos;
    const float *norm_mix_g, *w_in, *q_norm_g, *w_uq, *kv_norm_g, *w_ukv, *conv_w, *conv_b, *w_mq, *w_mk, *w_mv, *b_igate, *b_fgate,
                *mh_norm_g, *ml_skip, *w_o, *norm_ffn_g, *w_rg, *b_rg, *w_re, *b_re, *w_gate_e, *w_up_e, *w_down_e, *norm_ple_g, *w_ple, *w_pg, *final_g;
    float* out; unsigned char* ws; int ph_lo, ph_hi, sub, pad;
};

constexpr int G_STAGE = 49152;
constexpr int LDS_GEMM = 3 * G_STAGE;
struct GDesc { const bf16_t* a0; const bf16_t* a1; const int* gather; const bf16_t* bt; int ld0, ld1, ksplit, m0, nvalid, ldb, nk; };
__device__ __forceinline__ GDesc gdesc(const bf16_t* a, int lda, int m0, const bf16_t* bt, int ldb, int nk) {
    GDesc d; d.a0 = a; d.a1 = a; d.gather = nullptr; d.bt = bt; d.ld0 = lda; d.ld1 = lda; d.ksplit = 1 << 30; d.m0 = m0; d.nvalid = 0; d.ldb = ldb; d.nk = nk; return d; }
template <int MT> __device__ __forceinline__ void g_rows(const GDesc& d, int (&rows)[MT]) {
    const int lane = threadIdx.x & 63, wid = RFL(threadIdx.x >> 6);
#pragma unroll
    for (int i = 0; i < MT; ++i) { const int r = i * 64 + wid * 8 + (lane >> 3); rows[i] = d.gather ? (r < d.nvalid ? d.gather[r] : 0) : d.m0 + r; }
}
template <int MT> __device__ __forceinline__ void g_stage(const GDesc& d, const int (&rows)[MT], int kt, int buf, unsigned lds0) {
    const int lane = threadIdx.x & 63, wid = RFL(threadIdx.x >> 6); const int cch = (lane & 7) ^ (lane >> 3);
    const bf16_t* ab = d.a0; int ld = d.ld0, kk = kt;
    if (kt >= d.ksplit) { ab = d.a1; ld = d.ld1; kk = kt - d.ksplit; }
#pragma unroll
    for (int i = 0; i < MT; ++i) glds16(ab + (size_t)rows[i] * ld + kk * 64 + cch * 8, RFL(lds0 + buf * G_STAGE + i * 8192 + wid * 1024));
    const bf16_t* bp = d.bt + (size_t)(wid * 8 + (lane >> 3)) * d.ldb + cch * 8 + kt * 64;
    glds16(bp, RFL(lds0 + buf * G_STAGE + 32768 + wid * 1024));
    glds16(bp + (size_t)64 * d.ldb, RFL(lds0 + buf * G_STAGE + 32768 + 8192 + wid * 1024));
}
template <int MT> __device__ __forceinline__ void g_compute(f32x4 (&acc)[MT][4], const char* sa) {
    const int lane = threadIdx.x & 63, wid = RFL(threadIdx.x >> 6), wr = wid >> 1, wc = wid & 1, fr = lane & 15, fq = lane >> 4;
    const char* sb = sa + 32768;
#pragma unroll
    for (int kk = 0; kk < 2; ++kk) {
        bf16x8 af[MT], bfr[4];
        const int sw = ((4 * kk + fq) ^ (fr & 7)) << 4;
#pragma unroll
        for (int m = 0; m < MT; ++m) af[m] = *(const bf16x8*)(sa + (wr * 16 * MT + 16 * m + fr) * 128 + sw);
#pragma unroll
        for (int n = 0; n < 4; ++n) bfr[n] = *(const bf16x8*)(sb + (wc * 64 + 16 * n + fr) * 128 + sw);
#pragma unroll
        for (int m = 0; m < MT; ++m)
#pragma unroll
            for (int n = 0; n < 4; ++n) acc[m][n] = MFMA16(bfr[n], af[m], acc[m][n]);
    }
}
constexpr int G_NS = 3;
template <int MT, int ESTORES = 0, class DescFn, class EpiFn>
__device__ __forceinline__ void gemm_tiles(int ntiles, DescFn df, EpiFn ef, char* lds) {
    if (ntiles <= 0) return;
    constexpr int OPS = MT + 2;
    const unsigned lds0 = (unsigned)(uintptr_t)lds;
    GDesc dc = df(0), di = dc; int rows[MT]; g_rows<MT>(di, rows);
    int ti = 0, ki = 0, issued = 0, done = 0, sepi = 2;
    auto issue = [&]() { if (ti < ntiles) { g_stage<MT>(di, rows, ki, issued % G_NS, lds0); ++issued; ++ki; if (ki == di.nk) { ++ti; ki = 0; if (ti < ntiles) { di = df(ti); g_rows<MT>(di, rows); } } } };
    __syncthreads();
    for (int q = 0; q < G_NS - 1; ++q) issue();
    for (int t = 0; t < ntiles; ++t) {
        f32x4 acc[MT][4];
#pragma unroll
        for (int m = 0; m < MT; ++m)
#pragma unroll
            for (int n = 0; n < 4; ++n) acc[m][n] = (f32x4){0.f, 0.f, 0.f, 0.f};
        const int nk = dc.nk;
        for (int kt = 0; kt < nk; ++kt) {
            const int fly = issued - done - 1;
            if (fly >= 1) { if (ESTORES > 0 && sepi < 2) asm volatile("s_waitcnt vmcnt(%0)" :: "n"(OPS + ESTORES) : "memory"); else asm volatile("s_waitcnt vmcnt(%0)" :: "n"(OPS) : "memory"); }
            else asm volatile("s_waitcnt vmcnt(0)" ::: "memory");
            ++sepi;
            asm volatile("s_waitcnt lgkmcnt(0)\n\ts_barrier" ::: "memory");
            issue();
            g_compute<MT>(acc, lds + (done % G_NS) * G_STAGE); ++done;
        }
        asm volatile("s_waitcnt lgkmcnt(0)\n\ts_barrier" ::: "memory");
        ef(t, acc, lds + ((done + G_NS - 1) % G_NS) * G_STAGE); sepi = 0;
        if (t + 1 < ntiles) dc = (ti == t + 1) ? di : df(t + 1);
    }
}
template <int NF> struct G2C { static constexpr int BN = 64 * NF, A_BYTES = 16384, B_BYTES = BN * 64, STAGE = A_BYTES + B_BYTES, DPS = 2 + NF / 2; };
template <int NF> __device__ __forceinline__ void g2_offs(const GDesc& d, unsigned (&ao)[2], unsigned (&bo)[NF / 2]) {
    const int lane = threadIdx.x & 63, wid = RFL(threadIdx.x >> 6); const unsigned cch = (unsigned)((lane & 3) ^ ((0 - (lane >> 4)) & 3)) * 16u;
#pragma unroll
    for (int i = 0; i < 2; ++i) { const int r = 16 * (i * 8 + wid) + (lane >> 2); const int gr = d.gather ? (r < d.nvalid ? d.gather[r] : 0) : d.m0 + r; ao[i] = (unsigned)gr * (unsigned)(d.ld0 * 2) + cch; }
#pragma unroll
    for (int i = 0; i < NF / 2; ++i) bo[i] = (unsigned)(16 * (i * 8 + wid) + (lane >> 2)) * (unsigned)(d.ldb * 2) + cch;
}
template <int NF> __device__ __forceinline__ void g2_piece(const GDesc& d, const unsigned (&ao)[2], const unsigned (&bo)[NF / 2], int kt, int slot, unsigned lds0, int p) {
    const int wid = RFL(threadIdx.x >> 6);
    const unsigned sb = lds0 + slot * G2C<NF>::STAGE;
    if (p < 2) { const bf16_t* ab = d.a0; int kk = kt;
        if (kt >= d.ksplit) { ab = d.a1; kk = kt - d.ksplit; }
        glds16s(rfl_ptr(ab + kk * 32), ao[p], RFL(sb + (p * 8 + wid) * 1024));
    } else { const int i = p - 2; glds16s(rfl_ptr(d.bt + kt * 32), bo[i], RFL(sb + 16384 + (i * 8 + wid) * 1024)); }
}
template <int N> __device__ __forceinline__ void waitvm() { asm volatile("s_waitcnt vmcnt(%0)" :: "n"(N) : "memory"); }
template <int NF, class DescFn, class EpiFn>
__device__ __forceinline__ void gemm2_tiles(int ntiles, DescFn df, EpiFn ef, char* lds, int dbg = 0) {
    if (ntiles <= 0) return;
    constexpr int DPS = G2C<NF>::DPS, STG = G2C<NF>::STAGE;
    const unsigned lds0 = (unsigned)(uintptr_t)lds;
    const int lane = threadIdx.x & 63, wid = RFL(threadIdx.x >> 6), wr2 = wid >> 2, wc4 = wid & 3, fr = lane & 15, fq = lane >> 4;
    const int sw = (fq ^ ((0 - (fr >> 2)) & 3)) << 4;
    const int aoff = (wr2 * 128 + fr) * 64 + sw, boff = 16384 + (wc4 * 16 * NF + fr) * 64 + sw;
    GDesc dc = df(0), di = dc; unsigned ao[2], bo[NF / 2]; g2_offs<NF>(di, ao, bo);
    int ti = 0, ki = 0, issued = 0, done = 0;
    auto advance = [&]() { ++issued; ++ki; if (ki == di.nk) { ++ti; ki = 0; if (ti < ntiles) { di = df(ti); g2_offs<NF>(di, ao, bo); } } };
#define G2_BAR() do { if (!(dbg & 16)) asm volatile("s_waitcnt lgkmcnt(0)\n\ts_barrier" ::: "memory"); } while (0)
#define G2_WAIT(need) do { const int fly_ = issued - (need) - 1; if (fly_ >= 2) waitvm<2 * DPS>(); else if (fly_ == 1) waitvm<DPS>(); else waitvm<0>(); } while (0)
    __syncthreads();
    for (int q = 0; q < 3; ++q) if (ti < ntiles) {
#pragma unroll
        for (int p = 0; p < DPS; ++p) g2_piece<NF>(di, ao, bo, ki, issued & 3, lds0, p);
        advance(); }
    if (wr2) { G2_WAIT(0); G2_BAR(); }
    bf16x8 fa[8], fb[NF];
    for (int t = 0; t < ntiles; ++t) {
        f32x4 acc[8][NF];
#pragma unroll
        for (int m = 0; m < 8; ++m)
#pragma unroll
            for (int n = 0; n < NF; ++n) acc[m][n] = (f32x4){0.f, 0.f, 0.f, 0.f};
        const int nk = dc.nk;
        for (int kt = 0; kt < nk; ++kt) {
            if (!wr2) G2_WAIT(done);
            G2_BAR();
            { const char* sc = lds + (done & 3) * STG; const bool doi = ti < ntiles && !(dbg & 2); const int islot = issued & 3;
#pragma unroll
              for (int n = 0; n < NF; ++n) fb[n] = *(const bf16x8*)(sc + boff + n * 1024);
#pragma unroll
              for (int m = 0; m < 8; ++m) { fa[m] = *(const bf16x8*)(sc + aoff + m * 1024);
                  if ((m & 1) && (m >> 1) < DPS) { if (doi) g2_piece<NF>(di, ao, bo, ki, islot, lds0, m >> 1); } }
              if (ti < ntiles) advance(); }
            if (wr2) G2_WAIT(done + 1);
            G2_BAR();
            __builtin_amdgcn_s_setprio(1);
            if (!(dbg & 1)) {
#pragma unroll
            for (int m = 0; m < 8; ++m)
#pragma unroll
                for (int n = 0; n < NF; ++n) acc[m][n] = MFMA16(fb[n], fa[m], acc[m][n]); }
            __builtin_amdgcn_s_setprio(0);
            ++done;
        }
        if (!(dbg & 4)) ef(t, acc);
        if (t + 1 < ntiles) dc = (ti == t + 1) ? di : df(t + 1);
    }
    if (!wr2) G2_BAR();
#undef G2_BAR
#undef G2_WAIT
}

namespace g8 {
constexpr int BM = 256, BK = 64, HALF = 128, HTB = HALF * BK * 2;
__device__ __forceinline__ int lds_byte(int r, int c) { const int st = (r >> 4) * 2 + (c >> 5), rr = r & 15, cc = c & 31, ob = rr * 64 + cc * 2; return st * 1024 + (ob ^ (((ob >> 9) & 1) << 5)); }
__device__ __forceinline__ int perm32(int rho) { const int n = rho >> 4, i = rho & 15; return 8 * (i >> 2) + 4 * n + (i & 3); }
__device__ __forceinline__ void stage_rc(int b, int& R, int& C) { const int st = b / 1024, sb = b % 1024, swz = sb ^ (((sb >> 9) & 1) << 5); R = (st >> 1) * 16 + swz / 64; C = (st & 1) * 32 + (swz % 64) / 2; }
struct Unit { const char* A; const char* B; const int* gather; int nvalid, K, perm, i0, i1, i2; };
__device__ __forceinline__ void offs(const Unit& u, unsigned (&va)[2][2], unsigned (&vb)[2]) {
#pragma unroll
    for (int i = 0; i < 2; ++i) { int R, C; stage_rc(threadIdx.x * 16 + i * 8192, R, C);
        { const int Rb = u.perm ? ((R & ~31) + perm32(R & 31)) : R; vb[i] = (unsigned)(Rb * u.K + C) * 2u; }
#pragma unroll
        for (int h = 0; h < 2; ++h) { const int r = h * HALF + R; const int gr = u.gather ? (r < u.nvalid ? u.gather[r] : 0) : r; va[h][i] = (unsigned)(gr * u.K + C) * 2u; } }
}
template <class NextFn, class EpiFn>
__device__ __forceinline__ void phase(LAS unsigned char* lds, NextFn next, EpiFn epi) {
    const int tid = threadIdx.x, wid = __builtin_amdgcn_readfirstlane(tid >> 6), lane = tid & 63, wr = wid >> 2, wc = wid & 3, fr = lane & 15, fq = lane >> 4;
    const unsigned ldsw = (unsigned)wid * 1024u;
    const int aoff = lds_byte(wr * 64 + fr, fq * 8), boff = lds_byte(wc * 32 + fr, fq * 8);
#define G8_SA(b, h) (((b) * 2 + (h)) * HTB)
#define G8_SB(b, h) ((4 + (b) * 2 + (h)) * HTB)
#define G8_STAGE(bufoff, gbase, voff) do { _Pragma("unroll") for (int _i = 0; _i < 2; ++_i) \
        __builtin_amdgcn_global_load_lds((const unsigned*)((const char*)(gbase) + (voff)[_i]), (LAS unsigned*)(lds + (bufoff) + ldsw + _i * 8192), 16, 0, 0); } while (0)
#define G8_LDA(dst, b, h) do { _Pragma("unroll") for (int m = 0; m < 4; ++m) _Pragma("unroll") for (int k = 0; k < 2; ++k) dst[m][k] = *(const LAS bf16x8*)(lds + G8_SA(b, h) + aoff + m * 2048 + k * 1024); } while (0)
#define G8_LDB(dst, b, h) do { _Pragma("unroll") for (int n = 0; n < 2; ++n) _Pragma("unroll") for (int k = 0; k < 2; ++k) dst[n][k] = *(const LAS bf16x8*)(lds + G8_SB(b, h) + boff + n * 2048 + k * 1024); } while (0)
#define G8_MMA(ai, bj, At, Bt) do { __builtin_amdgcn_s_setprio(1); _Pragma("unroll") for (int m = 0; m < 4; ++m) _Pragma("unroll") for (int n = 0; n < 2; ++n) _Pragma("unroll") for (int k = 0; k < 2; ++k) \
        acc[ai][bj][m][n] = __builtin_amdgcn_mfma_f32_16x16x32_bf16(Bt[n][k], At[m][k], acc[ai][bj][m][n], 0, 0, 0); __builtin_amdgcn_s_setprio(0); } while (0)
#define G8_WAIT_V(n) asm volatile("s_waitcnt vmcnt(" #n ")" ::: "memory")
#define G8_WAIT_L(n) asm volatile("s_waitcnt lgkmcnt(" #n ")" ::: "memory")
#define G8_BAR __builtin_amdgcn_s_barrier()
#define G8_SCHED __builtin_amdgcn_sched_barrier(0)
    Unit cur, nxt; int ui = 0;
    if (!next(0, cur)) return;
    f32x4 acc[2][2][4][2];
#pragma unroll
    for (int a = 0; a < 2; ++a)
#pragma unroll
        for (int b = 0; b < 2; ++b)
#pragma unroll
            for (int m = 0; m < 4; ++m)
#pragma unroll
                for (int n = 0; n < 2; ++n) acc[a][b][m][n] = (f32x4){0.f, 0.f, 0.f, 0.f};
    bf16x8 At[4][2], B0[2][2], B1[2][2];
    unsigned vaC[2][2], vbC[2], vaN[2][2], vbN[2];
    offs(cur, vaC, vbC);
    const size_t kstep = (size_t)(BK * 2);
    __syncthreads();
    { const char* cA = cur.A; const char* cB = cur.B; const size_t hsB = (size_t)HALF * cur.K * 2;
      G8_STAGE(G8_SB(0, 0), cB, vbC); G8_STAGE(G8_SA(0, 0), cA, vaC[0]); G8_STAGE(G8_SB(0, 1), cB + hsB, vbC); G8_STAGE(G8_SA(0, 1), cA, vaC[1]);
      if (wr == 1) G8_BAR;
      G8_WAIT_V(4); G8_BAR;
      G8_STAGE(G8_SB(1, 0), cB + kstep, vbC); G8_STAGE(G8_SA(1, 0), cA + kstep, vaC[0]); G8_STAGE(G8_SB(1, 1), cB + hsB + kstep, vbC);
      G8_WAIT_V(6); G8_BAR; }
    for (;;) {
        const bool has_next = next(ui + 1, nxt);
        if (has_next) offs(nxt, vaN, vbN);
        else {
#pragma unroll
            for (int i = 0; i < 2; ++i) { vbN[i] = vbC[i]; vaN[0][i] = vaC[0][i]; vaN[1][i] = vaC[1][i]; } }
        const char* cA = cur.A; const char* cB = cur.B; const size_t hsB = (size_t)HALF * cur.K * 2;
        const char* nA = has_next ? nxt.A : cA; const char* nB = has_next ? nxt.B : cB; const size_t hsN = has_next ? (size_t)HALF * nxt.K * 2 : hsB;
        const int nt = cur.K / BK;
        for (int t = 0; t < nt; t += 2) {
            const bool last = (t == nt - 2);
            const char* a1 = cA + (size_t)(t + 1) * kstep;
            const char* a2 = last ? nA : cA + (size_t)(t + 2) * kstep; const char* b2 = last ? nB : cB + (size_t)(t + 2) * kstep;
            const char* a3 = a2 + kstep; const char* b3 = b2 + kstep; const size_t hs2 = last ? hsN : hsB;
            unsigned va2[2][2], vb2[2];
#pragma unroll
            for (int i = 0; i < 2; ++i) { vb2[i] = last ? vbN[i] : vbC[i]; va2[0][i] = last ? vaN[0][i] : vaC[0][i]; va2[1][i] = last ? vaN[1][i] : vaC[1][i]; }
            G8_LDB(B0, 0, 0); G8_SCHED; G8_LDA(At, 0, 0); G8_STAGE(G8_SA(1, 1), a1, vaC[1]);
            G8_WAIT_L(8); G8_BAR; G8_WAIT_L(0); G8_MMA(0, 0, At, B0); G8_BAR; G8_SCHED;
            G8_LDB(B1, 0, 1); G8_STAGE(G8_SB(0, 0), b2, vb2);
            G8_BAR; G8_WAIT_L(0); G8_MMA(0, 1, At, B1); G8_BAR;
            G8_LDA(At, 0, 1); G8_STAGE(G8_SA(0, 0), a2, va2[0]);
            G8_BAR; G8_WAIT_L(0); G8_MMA(1, 0, At, B0); G8_BAR; G8_SCHED;
            G8_STAGE(G8_SB(0, 1), b2 + hs2, vb2);
            G8_WAIT_V(6); G8_BAR; G8_MMA(1, 1, At, B1); G8_BAR;
            G8_LDB(B0, 1, 0); G8_SCHED; G8_LDA(At, 1, 0); G8_STAGE(G8_SA(0, 1), a2, va2[1]);
            G8_WAIT_L(8); G8_BAR; G8_WAIT_L(0); G8_MMA(0, 0, At, B0); G8_BAR; G8_SCHED;
            G8_LDB(B1, 1, 1); G8_STAGE(G8_SB(1, 0), b3, vb2);
            G8_BAR; G8_WAIT_L(0); G8_MMA(0, 1, At, B1); G8_BAR;
            G8_LDA(At, 1, 1); G8_STAGE(G8_SA(1, 0), a3, va2[0]);
            G8_BAR; G8_WAIT_L(0); G8_MMA(1, 0, At, B0); G8_BAR; G8_SCHED;
            G8_STAGE(G8_SB(1, 1), b3 + hs2, vb2);
            G8_WAIT_V(6); G8_BAR; G8_MMA(1, 1, At, B1); G8_BAR;
        }
        epi(acc, cur, wr, wc, fr, fq);
        if (!has_next) break;
#pragma unroll
        for (int a = 0; a < 2; ++a)
#pragma unroll
            for (int b = 0; b < 2; ++b)
#pragma unroll
                for (int m = 0; m < 4; ++m)
#pragma unroll
                    for (int n = 0; n < 2; ++n) acc[a][b][m][n] = (f32x4){0.f, 0.f, 0.f, 0.f};
        cur = nxt; ++ui;
#pragma unroll
        for (int i = 0; i < 2; ++i) { vbC[i] = vbN[i]; vaC[0][i] = vaN[0][i]; vaC[1][i] = vaN[1][i]; }
    }
    G8_WAIT_V(0);
    if (wr == 0) G8_BAR;
    G8_BAR;
#undef G8_SA
#undef G8_SB
#undef G8_STAGE
#undef G8_LDA
#undef G8_LDB
#undef G8_MMA
#undef G8_WAIT_V
#undef G8_WAIT_L
#undef G8_BAR
#undef G8_SCHED
}
}

__device__ __forceinline__ void gemm_ring128(f32x4 (&acc)[2][4], const GDesc& d, char* lds) {
    const unsigned lds0 = (unsigned)(uintptr_t)lds;
    const int lane = threadIdx.x & 63, wid = RFL(threadIdx.x >> 6), wr = wid >> 1, wc = wid & 1, fr = lane & 15, fq = lane >> 4; const int cch = (lane & 7) ^ (lane >> 3);
    int rows[2]; g_rows<2>(d, rows);
    auto stage = [&](int kt) { const unsigned sb = lds0 + (kt & 3) * 32768;
#pragma unroll
        for (int i = 0; i < 2; ++i) glds16(d.a0 + (size_t)rows[i] * d.ld0 + kt * 64 + cch * 8, RFL(sb + i * 8192 + wid * 1024));
        const bf16_t* bp = d.bt + (size_t)(wid * 8 + (lane >> 3)) * d.ldb + cch * 8 + kt * 64;
        glds16(bp, RFL(sb + 16384 + wid * 1024)); glds16(bp + (size_t)64 * d.ldb, RFL(sb + 16384 + 8192 + wid * 1024)); };
#pragma unroll
    for (int m = 0; m < 2; ++m)
#pragma unroll
        for (int n = 0; n < 4; ++n) acc[m][n] = (f32x4){0.f, 0.f, 0.f, 0.f};
    __syncthreads();
    for (int q = 0; q < 3; ++q) if (q < d.nk) stage(q);
    for (int kt = 0; kt < d.nk; ++kt) {
        const int fly = (d.nk - 1 - kt) < 2 ? (d.nk - 1 - kt) : 2;
        if (fly == 2) asm volatile("s_waitcnt vmcnt(8)" ::: "memory"); else if (fly == 1) asm volatile("s_waitcnt vmcnt(4)" ::: "memory"); else asm volatile("s_waitcnt vmcnt(0)" ::: "memory");
        asm volatile("s_waitcnt lgkmcnt(0)\n\ts_barrier" ::: "memory");
        if (kt + 3 < d.nk) stage(kt + 3);
        const char* sa = lds + (kt & 3) * 32768; const char* sb = sa + 16384;
#pragma unroll
        for (int kk = 0; kk < 2; ++kk) { bf16x8 af[2], bfr[4]; const int sw = ((4 * kk + fq) ^ (fr & 7)) << 4;
#pragma unroll
            for (int m = 0; m < 2; ++m) af[m] = *(const bf16x8*)(sa + (wr * 32 + 16 * m + fr) * 128 + sw);
#pragma unroll
            for (int n = 0; n < 4; ++n) bfr[n] = *(const bf16x8*)(sb + (wc * 64 + 16 * n + fr) * 128 + sw);
#pragma unroll
            for (int m = 0; m < 2; ++m)
#pragma unroll
                for (int n = 0; n < 4; ++n) acc[m][n] = MFMA16(bfr[n], af[m], acc[m][n]); }
    }
}
template <int MT> __device__ __forceinline__ void epi_store64(const f32x4 (&acc)[MT][4], char* stg, bf16_t* dst, size_t ld) {
    int tq = threadIdx.x; asm volatile("" : "+v"(tq)); const int lane = tq & 63, wid = RFL(tq >> 6), fr = lane & 15, fq = lane >> 4;
    char* st = stg + wid * 4608;
#pragma unroll
    for (int half = 0; half < MT / 2; ++half) {
#pragma unroll
        for (int mm = 0; mm < 2; ++mm)
#pragma unroll
            for (int n = 0; n < 4; ++n) { const f32x4 v = acc[2 * half + mm][n]; u32x2 w; w.x = cvtpk(v[0], v[1]); w.y = cvtpk(v[2], v[3]); *(u32x2*)(st + (16 * mm + fr) * 144 + (16 * n + 4 * fq) * 2) = w; }
        asm volatile("s_waitcnt lgkmcnt(0)" ::: "memory");
#pragma unroll
        for (int i = 0; i < 4; ++i) { const int r = 8 * i + (lane >> 3), ch = lane & 7; const u32x4 w = *(const u32x4*)(st + r * 144 + ch * 16);
            *(u32x4*)(dst + (size_t)(32 * half + r) * ld + ch * 8) = w; }
        asm volatile("s_waitcnt lgkmcnt(0)" ::: "memory");
    }
}

__device__ __forceinline__ void ld_row_bf16(const bf16_t* r, int lane, f32x4 (&a)[4]) {
    const u32x4 lo = *(const u32x4*)(r + lane * 8), hi = *(const u32x4*)(r + 512 + lane * 8);
    a[0] = (f32x4){bflo(lo[0]), bfhi(lo[0]), bflo(lo[1]), bfhi(lo[1])}; a[1] = (f32x4){bflo(lo[2]), bfhi(lo[2]), bflo(lo[3]), bfhi(lo[3])};
    a[2] = (f32x4){bflo(hi[0]), bfhi(hi[0]), bflo(hi[1]), bfhi(hi[1])}; a[3] = (f32x4){bflo(hi[2]), bfhi(hi[2]), bflo(hi[3]), bfhi(hi[3])}; }
__device__ __forceinline__ void st_row_bf16(bf16_t* r, int lane, const f32x4 (&a)[4]) {
    u32x4 lo, hi; lo[0] = cvtpk(a[0][0], a[0][1]); lo[1] = cvtpk(a[0][2], a[0][3]); lo[2] = cvtpk(a[1][0], a[1][1]); lo[3] = cvtpk(a[1][2], a[1][3]);
    hi[0] = cvtpk(a[2][0], a[2][1]); hi[1] = cvtpk(a[2][2], a[2][3]); hi[2] = cvtpk(a[3][0], a[3][1]); hi[3] = cvtpk(a[3][2], a[3][3]);
    *(u32x4*)(r + lane * 8) = lo; *(u32x4*)(r + 512 + lane * 8) = hi; }
__device__ __forceinline__ void norm_row_store_A(const f32x4 (&a)[4], const f32x4 (&gv)[4], int lane, bf16_t* dst) {
    float ss = 0.f;
#pragma unroll
    for (int i = 0; i < 4; ++i)
#pragma unroll
        for (int e = 0; e < 4; ++e) ss += a[i][e] * a[i][e];
    ss = wsum(ss); const float r = rsqrtf(ss * (1.0f / DM) + EPS);
#pragma unroll
    for (int i = 0; i < 4; ++i) st4bf(dst + 256 * i + 4 * lane, a[i] * r * gv[i]);
}
__device__ __forceinline__ void norm_row_store(const f32x4& a0, const f32x4& a1, const f32x4& a2, const f32x4& a3, const float* g, int lane, bf16_t* dst) {
    float ss = 0.f;
#pragma unroll
    for (int e = 0; e < 4; ++e) ss += a0[e] * a0[e] + a1[e] * a1[e] + a2[e] * a2[e] + a3[e] * a3[e];
    ss = wsum(ss); const float r = rsqrtf(ss * (1.0f / DM) + EPS);
    const f32x4 g0 = *(const f32x4*)(g + lane * 8), g1 = *(const f32x4*)(g + lane * 8 + 4), g2 = *(const f32x4*)(g + 512 + lane * 8), g3 = *(const f32x4*)(g + 512 + lane * 8 + 4);
    u32x4 w0, w1;
    w0.x = cvtpk(a0[0] * r * g0[0], a0[1] * r * g0[1]); w0.y = cvtpk(a0[2] * r * g0[2], a0[3] * r * g0[3]); w0.z = cvtpk(a1[0] * r * g1[0], a1[1] * r * g1[1]); w0.w = cvtpk(a1[2] * r * g1[2], a1[3] * r * g1[3]);
    w1.x = cvtpk(a2[0] * r * g2[0], a2[1] * r * g2[1]); w1.y = cvtpk(a2[2] * r * g2[2], a2[3] * r * g2[3]); w1.z = cvtpk(a3[0] * r * g3[0], a3[1] * r * g3[1]); w1.w = cvtpk(a3[2] * r * g3[2], a3[3] * r * g3[3]);
    *(u32x4*)(dst + lane * 8) = w0; *(u32x4*)(dst + 512 + lane * 8) = w1;
}

struct TrJob { const float* src; bf16_t* dst; const float* kgain; int N, k0, n0, ldd, mode; float scale; };
__device__ __forceinline__ TrJob tr_mk(const float* src, int N, int k0, int n0, bf16_t* dst, int ldd, int mode, float scale, const float* kgain) { TrJob j; j.src = src; j.dst = dst; j.kgain = kgain; j.N = N; j.k0 = k0; j.n0 = n0; j.ldd = ldd; j.mode = mode; j.scale = scale; return j; }
constexpr int TR_NJ = 12;
__device__ __forceinline__ int tr_total() { return 16 * 23 + 4 * 12 + 2 * 16 + 12 * 4 + 256 + 2048 + 2048 + 2048 + 64 + 256 + 16 + 16; }
__device__ __forceinline__ TrJob tr_job(const Params& P, int u) {
    unsigned char* ws = P.ws;
    const int cnt[TR_NJ] = {16 * 23, 4 * 12, 2 * 16, 12 * 4, 256, 2048, 2048, 2048, 64, 256, 16, 16};
    int j = 0, r = u;
#pragma unroll
    for (int jj = 0; jj < TR_NJ - 1; ++jj) if (j == jj && r >= cnt[jj]) { r -= cnt[jj]; j = jj + 1; }
    switch (j) {
    case 0: return tr_mk(P.w_in, INW, (r / 23) * 64, (r % 23) * 64, (bf16_t*)(ws + OFF_WIN), 1024, 0, 1.f, P.norm_mix_g);
    case 1: return tr_mk(P.w_uq, 768, (r / 12) * 64, (r % 12) * 64, (bf16_t*)(ws + OFF_WUQ), 256, 0, 1.f, P.q_norm_g);
    case 2: return tr_mk(P.w_ukv, 1024, (r / 16) * 64, (r % 16) * 64, (bf16_t*)(ws + OFF_WUKV), 128, 0, 1.f, P.kv_norm_g);
    case 3: { const int mat = r >> 2, t4 = r & 3, kind = mat >> 2, h = mat & 3; const float* sp = (kind == 0 ? P.w_mq : kind == 1 ? P.w_mk : P.w_mv) + h * 16384;
              return tr_mk(sp, 128, (t4 >> 1) * 64, (t4 & 1) * 64, (bf16_t*)(ws + OFF_WM) + mat * 16384, 128, 0, kind == 1 ? 0.08838834764831845f : 1.f, nullptr); }
    case 4: return tr_mk(P.w_o, 1024, (r >> 4) * 64, (r & 15) * 64, (bf16_t*)(ws + OFF_WO), 1024, 0, 1.f, nullptr);
    case 5: { const int e = r >> 6, t6 = r & 63; return tr_mk(P.w_gate_e + (size_t)e * 1024 * 256, 256, (t6 >> 2) * 64, (t6 & 3) * 64, (bf16_t*)(ws + OFF_WGU) + (size_t)e * 512 * 1024, 1024, 1, 1.f, P.norm_ffn_g); }
    case 6: { const int e = r >> 6, t6 = r & 63; return tr_mk(P.w_up_e + (size_t)e * 1024 * 256, 256, (t6 >> 2) * 64, (t6 & 3) * 64, (bf16_t*)(ws + OFF_WGU) + (size_t)e * 512 * 1024, 1024, 2, 1.f, P.norm_ffn_g); }
    case 7: { const int e = r >> 6, t6 = r & 63; return tr_mk(P.w_down_e + (size_t)e * 256 * 1024, 1024, (t6 >> 4) * 64, (t6 & 15) * 64, (bf16_t*)(ws + OFF_WD) + (size_t)e * 1024 * 256, 256, 0, 1.f, nullptr); }
    case 8: return tr_mk(P.w_ple, 1024, (r >> 4) * 64, (r & 15) * 64, (bf16_t*)(ws + OFF_WPLE), 256, 0, 1.f, nullptr);
    case 9: return tr_mk(P.w_pg, 1024, (r >> 4) * 64, (r & 15) * 64, (bf16_t*)(ws + OFF_WPG), 1024, 0, 1.f, P.norm_ple_g);
    case 10: return tr_mk(P.w_rg, 4, r * 64, 0, (bf16_t*)(ws + OFF_WR), 1024, 0, 1.f, P.norm_ffn_g);
    default: return tr_mk(P.w_re, 32, r * 64, 0, (bf16_t*)(ws + OFF_WR) + 4 * 1024, 1024, 0, 1.f, P.norm_ffn_g);
    }
}
__device__ __forceinline__ void tr_load(const TrJob& j, int tid, f32x4 (&v)[2], float (&g)[2], const float* gdummy) {
#pragma unroll
    for (int i = 0; i < 2; ++i) { const int idx = tid + 512 * i, kk = idx >> 4, nn = (idx & 15) * 4;
        const int cn = min(j.n0 + nn, j.N - 4); v[i] = __builtin_nontemporal_load((const f32x4*)(j.src + (size_t)(j.k0 + kk) * j.N + cn));
        g[i] = (j.kgain ? j.kgain : gdummy)[j.k0 + kk]; }
}
__device__ __forceinline__ void tr_store(const TrJob& j, int tid, const f32x4 (&v)[2], const float (&g)[2], float* tile) {
    asm volatile("s_waitcnt lgkmcnt(0)" ::: "memory"); __builtin_amdgcn_s_barrier();
#pragma unroll
    for (int i = 0; i < 2; ++i) { const int idx = tid + 512 * i, kk = idx >> 4, nn = (idx & 15) * 4;
        const float gs = (j.n0 + nn < j.N) ? (j.kgain ? g[i] : 1.f) * j.scale : 0.f;
#pragma unroll
        for (int e = 0; e < 4; ++e) tile[kk * 65 + nn + e] = v[i][e] * gs; }
    asm volatile("s_waitcnt lgkmcnt(0)" ::: "memory"); __builtin_amdgcn_s_barrier();
    { const int nn = tid >> 3, kk0 = (tid & 7) * 8, n = j.n0 + nn;
      if (n < j.N) { int r = n; if (j.mode) r = (n >> 7) * 256 + (j.mode - 1) * 128 + (n & 127);
          float t[8];
#pragma unroll
          for (int q = 0; q < 8; ++q) t[q] = tile[(kk0 + q) * 65 + nn];
          u32x4 w; w.x = cvtpk(t[0], t[1]); w.y = cvtpk(t[2], t[3]); w.z = cvtpk(t[4], t[5]); w.w = cvtpk(t[6], t[7]);
          *(u32x4*)(j.dst + (size_t)r * j.ldd + j.k0 + kk0) = w; } }
}

__device__ __forceinline__ void phase_prep(const Params& P, char* lds) {
    unsigned char* ws = P.ws; float* tile = (float*)lds;
    const int bid = blockIdx.x, nb = gridDim.x; int tid = threadIdx.x; asm volatile("" : "+v"(tid));
    if (!(P.sub & 16)) { const int total = tr_total();
        if (bid < total) { TrJob ja = tr_job(P, bid), jb = ja; f32x4 va[2], vb[2]; float ga[2], gb[2]; tr_load(ja, tid, va, ga, P.final_g);
#pragma unroll 1
            for (int u = bid; ; u += 2 * nb) {
                if (u + nb >= total) { tr_store(ja, tid, va, ga, tile); break; }
                jb = tr_job(P, u + nb); tr_load(jb, tid, vb, gb, P.final_g); tr_store(ja, tid, va, ga, tile);
                if (u + 2 * nb >= total) { tr_store(jb, tid, vb, gb, tile); break; }
                ja = tr_job(P, u + 2 * nb); tr_load(ja, tid, va, ga, P.final_g); tr_store(jb, tid, vb, gb, tile); } } }
    { u32x4 z = (u32x4){0u, 0u, 0u, 0u};
      u32x4* a = (u32x4*)((bf16_t*)(ws + OFF_WIN) + (size_t)INW * 1024); const int na = (INWP - INW) * 1024 / 8;
      for (int i = bid * 512 + tid; i < na; i += nb * 512) a[i] = z;
      u32x4* b = (u32x4*)((bf16_t*)(ws + OFF_WR) + 36 * 1024); const int nbz = (128 - 36) * 1024 / 8;
      for (int i = bid * 512 + tid; i < nbz; i += nb * 512) b[i] = z; }
    if (!(P.sub & 128)) { float2* rt = (float2*)(ws + OFF_ROPE);
      const int j = tid & 15; const float invrev = 0.15915494309189535f * __builtin_amdgcn_exp2f(-0.8304820237218407f * (float)j);
      for (int i = bid * 512 + tid; i < T_TOK * 16; i += nb * 512) { const int t = i >> 4;
          const float rev = (float)P.pos[t] * invrev; const float fr2 = rev - floorf(rev); rt[i] = make_float2(__builtin_amdgcn_cosf(fr2), __builtin_amdgcn_sinf(fr2)); } }
    if (!(P.sub & 64)) { const f32x4* src = (const f32x4*)P.p; u32x2* dst = (u32x2*)(ws + OFF_PB);
      for (int i = bid * 512 + tid; i < T_TOK * 256 / 4; i += nb * 512) { const f32x4 v = __builtin_nontemporal_load(src + i); u32x2 w; w.x = cvtpk(v[0], v[1]); w.y = cvtpk(v[2], v[3]); dst[i] = w; } }
    if (!(P.sub & 32)) { const int lane = tid & 63, wv = tid >> 6; bf16_t* xn = (bf16_t*)(ws + OFF_XN);
      for (int r0 = (bid * 8 + wv) * 4; r0 < T_TOK; r0 += nb * 8 * 4) {
          f32x4 a[4][4];
#pragma unroll
          for (int q = 0; q < 4; ++q) { const float* xr = P.x + (size_t)(r0 + q) * DM;
#pragma unroll
              for (int i = 0; i < 4; ++i) a[q][i] = __builtin_nontemporal_load((const f32x4*)(xr + 256 * i + 4 * lane)); }
#pragma unroll
          for (int q = 0; q < 4; ++q) { float ss = 0.f;
#pragma unroll
              for (int i = 0; i < 4; ++i)
#pragma unroll
                  for (int e = 0; e < 4; ++e) ss += a[q][i][e] * a[q][i][e];
              ss = wsum(ss); if (lane == 0) ((float*)(ws + OFF_RS0))[r0 + q] = rsqrtf(ss * (1.0f / DM) + EPS);
#pragma unroll
              for (int i = 0; i < 4; ++i) st4bf(xn + (size_t)(r0 + q) * DM + 256 * i + 4 * lane, a[q][i]); } } }
}

__device__ __forceinline__ void phase_inproj(const Params& P, char* lds) {
    unsigned char* ws = P.ws; const bf16_t* xn = (const bf16_t*)(ws + OFF_XN); const bf16_t* Wt = (const bf16_t*)(ws + OFF_WIN);
    bf16_t* proj = (bf16_t*)(ws + OFF_PROJ); bf16_t* Kb = (bf16_t*)P.out + (size_t)T_TOK * QW; float* gates = (float*)(ws + OFF_GATES); const float2* rope = (const float2*)(ws + OFF_ROPE);
    const int G = gridDim.x, xs = xcd_slot();
    g8::phase((LAS unsigned char*)lds,
      [&](int i, g8::Unit& u) { const int id = xs + i * G; if (id >= 128 * 6) return false; const int mt = id / 6, nt = id % 6;
          u.A = (const char*)(xn + (size_t)mt * 256 * DM); u.B = (const char*)(Wt + (size_t)nt * 256 * DM); u.gather = nullptr; u.nvalid = 0; u.K = DM; u.perm = (nt != 1); u.i0 = mt; u.i1 = nt; u.i2 = 0; return true; },
      [&](const f32x4 (&acc)[2][2][4][2], const g8::Unit& u, int wr, int wc, int fr, int fq) {
        const int m0 = u.i0 * 256, n0 = u.i1 * 256;
        float r8[8];
#pragma unroll
        for (int k = 0; k < 8; ++k) r8[k] = ((const float*)(P.ws + OFF_RS0))[m0 + 128 * (k >> 2) + 64 * wr + 16 * (k & 3) + fr];
        if (u.perm) {
#pragma unroll
            for (int ai = 0; ai < 2; ++ai)
#pragma unroll
              for (int m = 0; m < 4; ++m) { const int row = m0 + 128 * ai + 64 * wr + 16 * m + fr; const float rr = r8[ai * 4 + m];
#pragma unroll
                for (int bj = 0; bj < 2; ++bj) { const int c32 = n0 + 128 * bj + 32 * wc;
                    if (c32 + 32 <= C_IG) st8bf(proj + (size_t)row * INWP + c32 + 8 * fq, acc[ai][bj][m][0] * rr, acc[ai][bj][m][1] * rr);
                    else if (c32 == C_IG && fq == 0) { *(f32x4*)(gates + (size_t)row * 8) = acc[ai][bj][m][0] * rr; *(f32x4*)(gates + (size_t)row * 8 + 4) = acc[ai][bj][m][1] * rr; } } }
            return; }
        const bool has_rope = (n0 + 32 * wc == C_KR) || (n0 + 128 + 32 * wc == C_KR);
#pragma unroll
        for (int ai = 0; ai < 2; ++ai) {
          f32x4 rp[4][2];
          if (has_rope) {
#pragma unroll
              for (int m = 0; m < 4; ++m) { const f32x4* rq = (const f32x4*)(rope + (size_t)(m0 + 128 * ai + 64 * wr + 16 * m + fr) * 16 + 4 * fq); rp[m][0] = rq[0]; rp[m][1] = rq[1]; } }
#pragma unroll
          for (int m = 0; m < 4; ++m) { const int row = m0 + 128 * ai + 64 * wr + 16 * m + fr; const float rr = r8[ai * 4 + m];
#pragma unroll
            for (int bj = 0; bj < 2; ++bj)
#pragma unroll
              for (int n = 0; n < 2; ++n) { const int c16 = n0 + 128 * bj + 32 * wc + 16 * n, col = c16 + 4 * fq;
                if (c16 == C_KR) {
                    const f32x4 x1 = acc[ai][bj][m][0] * rr, x2 = acc[ai][bj][m][1] * rr; f32x4 o1, o2;
#pragma unroll
                    for (int e = 0; e < 4; ++e) { const float cx = rp[m][e >> 1][2 * (e & 1)], sy = rp[m][e >> 1][2 * (e & 1) + 1]; o1[e] = x1[e] * cx - x2[e] * sy; o2[e] = x1[e] * sy + x2[e] * cx; }
                    { bf16_t* kr = (bf16_t*)(P.ws + OFF_KROPE) + (size_t)row * 32; st4bf(kr + 4 * fq, o1); st4bf(kr + 16 + 4 * fq, o2); }
                } else if (c16 == C_KR + 16) {   }
                else if (c16 == C_IG) { if (fq < 2) *(f32x4*)(gates + (size_t)row * 8 + 4 * fq) = acc[ai][bj][m][n] * rr; }
                else if (c16 < C_IG) st4bf(proj + (size_t)row * INWP + col, acc[ai][bj][m][n] * rr);
              } } }
      });
}

constexpr int LDS_RS = LDS_GEMM;
template <int N> __device__ __forceinline__ float sumsq_bf16(const bf16_t* src) { u32x4 v[N]; float ss = 0.f;
#pragma unroll
    for (int i = 0; i < N; ++i) v[i] = *(const u32x4*)(src + i * 8);
#pragma unroll
    for (int i = 0; i < N; ++i)
#pragma unroll
        for (int e = 0; e < 4; ++e) { const float a = bflo(v[i][e]), b = bfhi(v[i][e]); ss += a * a + b * b; }
    return ss; }
constexpr int AR_A = 0, AR_B = 65536, AR_STG = AR_B + 3 * 16384, AR_RS = AR_STG + 8 * 4608;
static_assert(AR_RS + 1024 <= 160 * 1024 - 16, "A-resident LDS map");
template <class EpiFn>
__device__ __forceinline__ void gemm_ares(const bf16_t* A, int lda, int m0, int nk, const bf16_t* Bt, int ldb, int ntiles, EpiFn ef, char* lds) {
    const unsigned lds0 = (unsigned)(uintptr_t)lds; int tq = threadIdx.x; asm volatile("" : "+v"(tq));
    const int lane = tq & 63, wid = RFL(tq >> 6), wr = wid >> 1, wc = wid & 1, fr = lane & 15, fq = lane >> 4; const int cch = (lane & 7) ^ (lane >> 3);
    asm volatile("s_waitcnt lgkmcnt(0)" ::: "memory"); __builtin_amdgcn_s_barrier();
    for (int kt = 0; kt < nk; ++kt)
#pragma unroll
        for (int i = 0; i < 2; ++i) glds16(A + (size_t)(m0 + i * 64 + wid * 8 + (lane >> 3)) * lda + kt * 64 + cch * 8, RFL(lds0 + AR_A + kt * 16384 + i * 8192 + wid * 1024));
    const int S = ntiles * nk;
    auto issueB = [&](int st) { const int nt = st / nk, kt = st - nt * nk; const bf16_t* bp = Bt + (size_t)(nt * 128 + wid * 8 + (lane >> 3)) * ldb + cch * 8 + kt * 64;
        const unsigned dst = lds0 + AR_B + (st % 3) * 16384 + wid * 1024; glds16(bp, RFL(dst)); glds16(bp + (size_t)64 * ldb, RFL(dst + 8192)); };
    issueB(0); if (S > 1) issueB(1);
    int st = 0, sepi = 2;
    for (int nt = 0; nt < ntiles; ++nt) {
        f32x4 acc[2][4];
#pragma unroll
        for (int m = 0; m < 2; ++m)
#pragma unroll
            for (int n = 0; n < 4; ++n) acc[m][n] = (f32x4){0.f, 0.f, 0.f, 0.f};
        for (int kt = 0; kt < nk; ++kt) {
            if (st + 1 < S) { if (sepi < 2) asm volatile("s_waitcnt vmcnt(6)" ::: "memory"); else asm volatile("s_waitcnt vmcnt(2)" ::: "memory"); }
            else asm volatile("s_waitcnt vmcnt(0)" ::: "memory");
            ++sepi;
            asm volatile("s_waitcnt lgkmcnt(0)\n\ts_barrier" ::: "memory");
            if (st + 2 < S) issueB(st + 2);
            const char* sa = lds + AR_A + kt * 16384; const char* sb = lds + AR_B + (st % 3) * 16384;
#pragma unroll
            for (int kk = 0; kk < 2; ++kk) { bf16x8 af[2], bfr[4]; const int sw = ((4 * kk + fq) ^ (fr & 7)) << 4;
#pragma unroll
                for (int m = 0; m < 2; ++m) af[m] = *(const bf16x8*)(sa + (wr * 32 + 16 * m + fr) * 128 + sw);
#pragma unroll
                for (int n = 0; n < 4; ++n) bfr[n] = *(const bf16x8*)(sb + (wc * 64 + 16 * n + fr) * 128 + sw);
#pragma unroll
                for (int m = 0; m < 2; ++m)
#pragma unroll
                    for (int n = 0; n < 4; ++n) acc[m][n] = MFMA16(bfr[n], af[m], acc[m][n]); }
            ++st; }
        ef(nt, acc, lds + AR_STG); sepi = 0; }
}
__device__ __forceinline__ void mla_unit(const Params& P, int mt, char* lds) {
    unsigned char* ws = P.ws; const bf16_t* proj = (const bf16_t*)(ws + OFF_PROJ);
    bf16_t* Qb = (bf16_t*)P.out; bf16_t* Kb = Qb + (size_t)T_TOK * QW; bf16_t* Vb = Kb + (size_t)T_TOK * KW;
    const int tid = threadIdx.x; float* rsq = (float*)(lds + AR_RS); float* rskv = rsq + 128;
    const int m0 = mt * 128;
    __syncthreads();
    { const int row = tid >> 2, sub = tid & 3; const bf16_t* src = proj + (size_t)(m0 + row) * INWP;
      float sq = sumsq_bf16<8>(src + C_CQ + sub * 64), skv = sumsq_bf16<4>(src + C_CKV + sub * 32);
      sq += __shfl_xor(sq, 1); sq += __shfl_xor(sq, 2); skv += __shfl_xor(skv, 1); skv += __shfl_xor(skv, 2);
      if (sub == 0) { rsq[row] = rsqrtf(sq / 256.f + EPS); rskv[row] = rsqrtf(skv / 128.f + EPS); } }
    float posf[2];
    { const int lane = tid & 63, wid = tid >> 6;
#pragma unroll
      for (int m = 0; m < 2; ++m) posf[m] = (float)P.pos[m0 + (wid >> 1) * 32 + 16 * m + (lane & 15)]; }
    gemm_ares(proj + C_CQ, INWP, m0, 4, (const bf16_t*)(ws + OFF_WUQ), 256, 6,
      [&](int nt, f32x4 (&acc)[2][4], char* stg) {
        int tq = threadIdx.x; asm volatile("" : "+v"(tq)); const int lane = tq & 63, wid = RFL(tq >> 6), wr = wid >> 1, wc = wid & 1, fr = lane & 15, fq = lane >> 4; (void)lane;
#pragma unroll
        for (int m = 0; m < 2; ++m) { const int lr = wr * 32 + 16 * m + fr; const float r = rsq[lr] * QSCALE;
#pragma unroll
            for (int n = 0; n < 4; n += 2) { const int g16 = nt * 8 + wc * 4 + n, jj = g16 % 6;
                if (jj == 4) { const f32x4 x1 = acc[m][n] * r, x2 = acc[m][n + 1] * r; const float pf = posf[m];
#pragma unroll
                    for (int e = 0; e < 4; ++e) {
                        const float rev = pf * (0.15915494309189535f * __builtin_amdgcn_exp2f(-0.8304820237218407f * (float)(4 * fq + e))); const float fr2 = rev - floorf(rev);
                        const float sn = __builtin_amdgcn_sinf(fr2), cs_ = __builtin_amdgcn_cosf(fr2);
                        acc[m][n][e] = x1[e] * cs_ - x2[e] * sn; acc[m][n + 1][e] = x1[e] * sn + x2[e] * cs_; }
                } else { acc[m][n] = acc[m][n] * r; acc[m][n + 1] = acc[m][n + 1] * r; } } }
        epi_store64<2>(acc, stg, Qb + (size_t)(m0 + wr * 32) * QW + nt * 128 + wc * 64, QW);
      }, lds);
    gemm_ares(proj + C_CKV, INWP, m0, 2, (const bf16_t*)(ws + OFF_WUKV), 128, 8,
      [&](int nt, f32x4 (&acc)[2][4], char* stg) {
        int tq = threadIdx.x; asm volatile("" : "+v"(tq)); const int lane = tq & 63, wid = RFL(tq >> 6), wr = wid >> 1, wc = wid & 1, fr = lane & 15; (void)lane;
#pragma unroll
        for (int m = 0; m < 2; ++m) { const float r = rskv[wr * 32 + 16 * m + fr];
#pragma unroll
            for (int n = 0; n < 4; ++n) acc[m][n] = acc[m][n] * r; }
        if (wc == 0) epi_store64<2>(acc, stg, Kb + (size_t)(m0 + wr * 32) * KW + nt * 96, KW);
        else epi_store64<2>(acc, stg, Vb + (size_t)(m0 + wr * 32) * VW + nt * 64, VW);
      }, lds);
}

__device__ __forceinline__ void gate_prep(const Params& P, int tok0, int h, float* sb, float* sgs, float* spm, float* sbl, float* sa) {
    const float* gates = (const float*)(P.ws + OFF_GATES);
    const int tid = threadIdx.x, lane = tid & 63, w = tid >> 6;
    const float fpre = gates[(size_t)(tok0 + tid) * 8 + 4 + h] + P.b_fgate[h], ig = gates[(size_t)(tok0 + tid) * 8 + h] + P.b_igate[h];
    const float logf = fminf(fpre, 0.f) - log1pf(__expf(-fabsf(fpre)));
    float b = logf;
#pragma unroll
    for (int o = 1; o < 64; o <<= 1) { const float t = __shfl_up(b, o); if (lane >= o) b += t; }
    const float gs = ig - b; float pm = gs;
#pragma unroll
    for (int o = 1; o < 64; o <<= 1) { const float t = __shfl_up(pm, o); if (lane >= o) pm = fmaxf(pm, t); }
    const float bl = __shfl(b, 63), mx = __shfl(pm, 63);
    sb[tid] = b; sgs[tid] = gs; spm[tid] = pm;
    if (lane == 0) { sbl[w] = bl; sa[w] = bl + mx; }
}

constexpr int LDS_M1_G = LDS_GEMM + 1024;
__device__ __forceinline__ void mlstm_unit1(const Params& P, int u, char* lds) {
    unsigned char* ws = P.ws; const bf16_t* proj = (const bf16_t*)(ws + OFF_PROJ);
    bf16_t* xc = (bf16_t*)(ws + OFF_XC); bf16_t* mq = (bf16_t*)(ws + OFF_MQ); bf16_t* mk = (bf16_t*)(ws + OFF_MK); bf16_t* mv = (bf16_t*)(ws + OFF_MV);
    const int b = u >> 6, h = (u >> 4) & 3, g = u & 15, tok0 = b * SEQ + g * 512;
    const int tid = threadIdx.x, lane = tid & 63, wid = RFL(tid >> 6), wr = wid >> 1, wc = wid & 1, fr = lane & 15, fq = lane >> 4, r32 = lane & 31, hi = lane >> 5;
    { const int ch = h * 128 + (tid & 15) * 8, sl = tid >> 4;
      float wv[4][8], bias[8];
#pragma unroll
      for (int k = 0; k < 4; ++k)
#pragma unroll
          for (int e = 0; e < 8; ++e) wv[k][e] = P.conv_w[k * 512 + ch + e];
#pragma unroll
      for (int e = 0; e < 8; ++e) bias[e] = P.conv_b[ch + e];
      const int tin0 = g * 512 + sl * 16; const bf16_t* src = proj + (size_t)(b * SEQ + tin0) * INWP + C_XM + ch;
      u32x4 xr[19];
#pragma unroll
      for (int i = 0; i < 19; ++i) { const int tt = tin0 - 3 + i; xr[i] = (u32x4){0u, 0u, 0u, 0u}; if (tt >= 0) xr[i] = *(const u32x4*)(src + (ptrdiff_t)(i - 3) * INWP); }
#pragma unroll
      for (int i = 0; i < 16; ++i) { float a[8];
#pragma unroll
          for (int e = 0; e < 8; ++e) a[e] = bias[e];
#pragma unroll
          for (int k = 0; k < 4; ++k) { const u32x4 v = xr[i + k];
#pragma unroll
              for (int e = 0; e < 4; ++e) { a[2 * e] += wv[k][2 * e] * bflo(v[e]); a[2 * e + 1] += wv[k][2 * e + 1] * bfhi(v[e]); } }
          u32x4 o;
#pragma unroll
          for (int e = 0; e < 4; ++e) o[e] = cvtpk(siluf(a[2 * e]), siluf(a[2 * e + 1]));
          *(u32x4*)(xc + (size_t)(tok0 + sl * 16 + i) * 512 + ch) = o; } }
    WAITVM0(); __syncthreads();
    gemm_tiles<4, 8>(6, [&](int t) { const int kind = t >> 1, rt = t & 1; const bf16_t* A = kind < 2 ? xc + h * 128 : proj + C_XM + h * 128;
                                  return gdesc(A, kind < 2 ? 512 : INWP, tok0 + rt * 256, (const bf16_t*)(ws + OFF_WM) + (kind * 4 + h) * 16384, 128, 2); },
      [&](int t, f32x4 (&acc)[4][4], char* stg) { const int kind = t >> 1, rt = t & 1, m0 = tok0 + rt * 256; bf16_t* dst = kind == 0 ? mq : kind == 1 ? mk : mv;
        int tq = threadIdx.x; asm volatile("" : "+v"(tq)); const int wid = RFL(tq >> 6), wr = wid >> 1, wc = wid & 1;
        epi_store64<4>(acc, stg, dst + (size_t)(m0 + wr * 64) * 512 + h * 128 + wc * 64, 512);
      }, lds);
    WAITVM0(); __syncthreads();
    float* sb = (float*)(lds + LDS_M1_G); float* sgs = sb + 512; float* spm = sgs + 512; float* sbl = spm + 512; float* sa = sbl + 8;
    gate_prep(P, tok0, h, sb, sgs, spm, sbl, sa);
    __syncthreads();
    if (tid < 8) { float* cs = (float*)(ws + OFF_CSTAT) + ((size_t)(b * 4 + h) * 128 + g * 8 + tid) * 2; cs[0] = sbl[tid]; cs[1] = sa[tid]; }
    float tail[8]; float mend = -INFINITY;
    { float acc = 0.f;
#pragma unroll
      for (int j = 7; j >= 0; --j) { tail[j] = acc; mend = fmaxf(mend, acc + sa[j]); acc += sbl[j]; } }
    f32x16 cacc[2], nacc; cacc[0] = f32x16{}; cacc[1] = f32x16{}; nacc = f32x16{};
    const bf16x8 ones = (bf16x8){0x3f80, 0x3f80, 0x3f80, 0x3f80, 0x3f80, 0x3f80, 0x3f80, 0x3f80};
    const int s0 = tid >> 4, c8 = tid & 15; const size_t gbase = (size_t)(tok0 + s0) * 512 + h * 128 + c8 * 8;
    u32x4 kq0 = *(const u32x4*)(mk + gbase), kq1 = *(const u32x4*)(mk + gbase + 32 * 512), vq0 = *(const u32x4*)(mv + gbase), vq1 = *(const u32x4*)(mv + gbase + 32 * 512);
#pragma unroll 1
    for (int j = 0; j < 8; ++j) {
        char* img = lds + (j & 1) * 32768;
        { const float e0 = tail[j] + sbl[j] - mend; const float w0 = __expf(e0 + sgs[j * 64 + s0]), w1 = __expf(e0 + sgs[j * 64 + s0 + 32]);
          u32x4 k0, k1;
#pragma unroll
          for (int e = 0; e < 4; ++e) { k0[e] = cvtpk(bflo(kq0[e]) * w0, bfhi(kq0[e]) * w0); k1[e] = cvtpk(bflo(kq1[e]) * w1, bfhi(kq1[e]) * w1); }
          const int off = (c8 >> 2) * 4096 + s0 * 64 + (c8 & 3) * 16;
          *(u32x4*)(img + off) = k0; *(u32x4*)(img + off + 32 * 64) = k1; *(u32x4*)(img + 16384 + off) = vq0; *(u32x4*)(img + 16384 + off + 32 * 64) = vq1; }
        { const size_t gn = gbase + (size_t)(j < 7 ? j + 1 : 7) * 64 * 512; kq0 = *(const u32x4*)(mk + gn); kq1 = *(const u32x4*)(mk + gn + 32 * 512); vq0 = *(const u32x4*)(mv + gn); vq1 = *(const u32x4*)(mv + gn + 32 * 512); }
        asm volatile("s_waitcnt lgkmcnt(0)" ::: "memory"); __builtin_amdgcn_s_barrier();
        { const int q = (lane & 15) >> 2, p = lane & 3, cb = (lane >> 4) & 1;
          const lds_cptr kp = (lds_cptr)img + wr * 4096 + (4 * hi + q) * 64 + cb * 32 + p * 8;
          const lds_cptr vp = (lds_cptr)img + 16384 + (2 * wc) * 4096 + (4 * hi + q) * 64 + cb * 32 + p * 8;
#pragma unroll
          for (int ks = 0; ks < 4; ++ks) { const bf16x8 af = cat8(vtr(kp + ks * 1024), vtr(kp + ks * 1024 + 512));
              const bf16x8 b0 = cat8(vtr(vp + ks * 1024), vtr(vp + ks * 1024 + 512)), b1 = cat8(vtr(vp + 4096 + ks * 1024), vtr(vp + 4096 + ks * 1024 + 512));
              cacc[0] = MFMA32(af, b0, cacc[0]); cacc[1] = MFMA32(af, b1, cacc[1]);
              if (wc == 0) nacc = MFMA32(af, ones, nacc); } }
    }
    bf16_t* st = (bf16_t*)(ws + OFF_STATE) + (size_t)u * 16384; float* nst = (float*)(ws + OFF_NST) + (size_t)u * 128; float* mst = (float*)(ws + OFF_MST) + u;
#pragma unroll
    for (int nb2 = 0; nb2 < 2; ++nb2)
#pragma unroll
        for (int r = 0; r < 16; ++r) st[(wr * 32 + crow(r, hi)) * 128 + wc * 64 + nb2 * 32 + r32] = (bf16_t)(cvtpk(cacc[nb2][r], 0.f) & 0xffffu);
    if (wc == 0 && r32 == 0) {
#pragma unroll
        for (int r = 0; r < 16; ++r) nst[wr * 32 + crow(r, hi)] = nacc[r]; }
    if (tid == 0) mst[0] = mend;
    __syncthreads();
}

constexpr int LDS_AK = 0, LDS_AV = 2 * 12288, LDS_AW = LDS_AV + 2 * 8192, LDS_AO = LDS_AW + 2048;
#ifndef ATT_THR
#define ATT_THR 8.0f
#endif
__device__ __forceinline__ void attn_unit(const Params& P, int b, int h, int qb, char* lds) {
    const bf16_t* Qb = (const bf16_t*)P.out; const bf16_t* Kb = Qb + (size_t)T_TOK * QW; const bf16_t* Vb = Kb + (size_t)T_TOK * KW; bf16_t* att = (bf16_t*)(P.ws + OFF_MIX);
    const int tid = threadIdx.x, lane = tid & 63, r32 = lane & 31, hi = lane >> 5; const int wid = RFL(tid >> 6);
    const unsigned lds0 = (unsigned)(uintptr_t)lds;
    const size_t rowbase = (size_t)b * SEQ; const int q0 = qb * 256, NT = 4 * qb + 4, mynt = 4 * qb + (wid >> 1) + 1;
    const bf16_t* Qw = Qb + (rowbase + q0 + wid * 32 + r32) * QW + h * 96;
    bf16x8 qr[6];
#pragma unroll
    for (int d0 = 0; d0 < 6; ++d0) qr[d0] = *(const bf16x8*)(Qw + d0 * 16 + hi * 8);
    const bf16_t* ksrc0 = Kb + (rowbase + lane) * KW + h * 96 + wid * 8;
    const bf16_t* ksrc1 = (const bf16_t*)(P.ws + OFF_KROPE) + (rowbase + lane) * 32 + (wid & 3) * 8;
    const bf16_t* vsrc = Vb + (rowbase + 16 * (wid & 3) + (lane >> 2)) * VW + h * 64 + (wid >> 2) * 32 + (lane & 3) * 8;
    float* wsf = (float*)(lds + LDS_AW) + wid * 64;
    float mhat = 0.f; f32x16 o0 = f32x16{}, o1 = f32x16{}, lacc = f32x16{}; f32x16 negm = f32x16{}; asm volatile("" : "+v"(negm));
    const bf16x8 ones = (bf16x8){0x3f80, 0x3f80, 0x3f80, 0x3f80, 0x3f80, 0x3f80, 0x3f80, 0x3f80};
    const lds_cptr vp0 = (lds_cptr)lds + LDS_AV + ((lane >> 4) & 1) * 32 + (lane & 3) * 8 + (4 * hi + ((lane & 15) >> 2)) * 64;
    const char* kp0 = lds + LDS_AK + hi * 1024 + r32 * 16;
    auto dma = [&](int t, int slot) {
        glds16(ksrc0 + (size_t)t * 64 * KW, RFL(lds0 + LDS_AK + slot * 12288 + wid * 1024));
        if (wid < 4) glds16(ksrc1 + (size_t)t * 64 * 32, RFL(lds0 + LDS_AK + slot * 12288 + (8 + wid) * 1024));
        glds16(vsrc + (size_t)t * 64 * VW, RFL(lds0 + LDS_AV + slot * 8192 + wid * 1024));
    };
    asm volatile("s_waitcnt lgkmcnt(0)" ::: "memory"); __builtin_amdgcn_s_barrier();
    if (wid >= 4) __builtin_amdgcn_s_setprio(1);
    dma(0, 0);
    for (int t = 0; t < NT; ++t) {
        asm volatile("s_waitcnt vmcnt(0) lgkmcnt(0)" ::: "memory"); __builtin_amdgcn_s_barrier();
        if (t + 1 < NT) dma(t + 1, (t + 1) & 1);
        if (t < mynt) {
            const char* kp = kp0 + (t & 1) * 12288;
            f32x16 s0, s1;
            { const bf16x8 k0 = *(const bf16x8*)(kp), k1 = *(const bf16x8*)(kp + 512); s0 = MFMA32(k0, qr[0], negm); s1 = MFMA32(k1, qr[0], negm); }
#pragma unroll
            for (int d0 = 1; d0 < 6; ++d0) { const bf16x8 k0 = *(const bf16x8*)(kp + d0 * 2048), k1 = *(const bf16x8*)(kp + d0 * 2048 + 512);
                s0 = MFMA32(k0, qr[d0], s0); s1 = MFMA32(k1, qr[d0], s1); }
            float rm = s0[0];
#pragma unroll
            for (int r = 1; r < 16; ++r) rm = fmaxf(rm, s0[r]);
#pragma unroll
            for (int r = 0; r < 16; ++r) rm = fmaxf(rm, s1[r]);
            { auto rr = __builtin_amdgcn_permlane32_swap(__float_as_uint(rm), __float_as_uint(rm), false, false); rm = fmaxf(__uint_as_float(rr[0]), __uint_as_float(rr[1])); }
            if (t == 0 || __any(rm > ATT_THR)) {
                const float dl = (t == 0) ? rm : fmaxf(rm, 0.f); mhat += dl;
#pragma unroll
                for (int r = 0; r < 16; ++r) { s0[r] -= dl; s1[r] -= dl; negm[r] -= dl; }
                asm volatile("" : "+v"(negm));
                if (t > 0) { const float f = __builtin_amdgcn_exp2f(-dl);
#pragma unroll
                    for (int r = 0; r < 16; ++r) { o0[r] *= f; o1[r] *= f; lacc[r] *= f; } } }
#pragma unroll
            for (int r = 0; r < 16; ++r) { s0[r] = __builtin_amdgcn_exp2f(s0[r]); s1[r] = __builtin_amdgcn_exp2f(s1[r]); }
            u32x4 pw[4];
#pragma unroll
            for (int i = 0; i < 4; ++i) { pw[0][i] = cvtpk(s0[2 * i], s0[2 * i + 1]); pw[1][i] = cvtpk(s0[8 + 2 * i], s0[8 + 2 * i + 1]); pw[2][i] = cvtpk(s1[2 * i], s1[2 * i + 1]); pw[3][i] = cvtpk(s1[8 + 2 * i], s1[8 + 2 * i + 1]); }
            const lds_cptr vp = vp0 + (t & 1) * 8192;
#pragma unroll
            for (int ks = 0; ks < 4; ++ks) { const bf16x8 pa = __builtin_bit_cast(bf16x8, pw[ks]);
                const bf16x8 v0 = cat8(vtr(vp + ks * 1024), vtr(vp + ks * 1024 + 512)), v1 = cat8(vtr(vp + 4096 + ks * 1024), vtr(vp + 4096 + ks * 1024 + 512));
                o0 = MFMA32(v0, pa, o0); o1 = MFMA32(v1, pa, o1); lacc = MFMA32(ones, pa, lacc); }
        }
    }
    __builtin_amdgcn_s_setprio(0);
    bf16_t* Ow = att + (rowbase + q0 + wid * 32) * 1024 + h * 64;
    { const float rl = __builtin_amdgcn_rcpf(lacc[0]); char* st = lds + LDS_AO + wid * 4608;
#pragma unroll
      for (int g = 0; g < 4; ++g) { u32x2 w0, w1;
          w0.x = cvtpk(o0[4 * g] * rl, o0[4 * g + 1] * rl); w0.y = cvtpk(o0[4 * g + 2] * rl, o0[4 * g + 3] * rl); w1.x = cvtpk(o1[4 * g] * rl, o1[4 * g + 1] * rl); w1.y = cvtpk(o1[4 * g + 2] * rl, o1[4 * g + 3] * rl);
          *(u32x2*)(st + r32 * 144 + (8 * g + 4 * hi) * 2) = w0; *(u32x2*)(st + r32 * 144 + 64 + (8 * g + 4 * hi) * 2) = w1; }
      WAITLGKM0();
#pragma unroll
      for (int i = 0; i < 4; ++i) { const int r = 8 * i + (lane >> 3), ch = lane & 7; const u32x4 w = *(const u32x4*)(st + r * 144 + ch * 16); *(u32x4*)(Ow + (size_t)r * 1024 + ch * 8) = w; }
      WAITLGKM0(); }
}

constexpr int LDS_M2_C = 0, LDS_M2_Q = 32768, LDS_M2_K = 49152, LDS_M2_V = 65536, LDS_M2_KS = 81920, LDS_M2_NUM = 98304  , LDS_M2_MISC = 98304 + 33792;
__device__ __forceinline__ void mlstm_unit2(const Params& P, int u, char* lds) {
    unsigned char* ws = P.ws; const bf16_t* proj = (const bf16_t*)(ws + OFF_PROJ);
    const bf16_t* xc = (const bf16_t*)(ws + OFF_XC); const bf16_t* mq = (const bf16_t*)(ws + OFF_MQ); const bf16_t* mk = (const bf16_t*)(ws + OFF_MK); const bf16_t* mv = (const bf16_t*)(ws + OFF_MV);
    bf16_t* mlo = (bf16_t*)(ws + OFF_MIX) + 512;
    const int b = u >> 6, h = (u >> 4) & 3, g = u & 15, tok0 = b * SEQ + g * 512, seq = b * 4 + h;
    const int tid = threadIdx.x, lane = tid & 63, wid = RFL(tid >> 6), r32 = lane & 31, hi = lane >> 5, wr = wid >> 1, wc = wid & 1;
    float* misc = (float*)(lds + LDS_M2_MISC);
    float* sb = misc; float* sgs = sb + 512; float* spm = sgs + 512; float* sbl = spm + 512; float* sa = sbl + 8;
    float* marr = sa + 8; float* fbarr = marr + 136; float* cst = fbarr + 136;
    float* nfull = cst + 256; float* nseg = nfull + 128; float* sden = nseg + 128; float* swi = sden + 64; float* coef = swi + 64;
    float* gsk = coef + 16;
    __syncthreads();
    gate_prep(P, tok0, h, sb, sgs, spm, sbl, sa);
    if (tid < 256) { cst[tid] = ((const float*)(ws + OFF_CSTAT))[(size_t)seq * 256 + tid]; gsk[tid] = tid < 128 ? P.mh_norm_g[h * 128 + tid] : P.ml_skip[h * 128 + tid - 128]; }
    __syncthreads();
    if (wid == 0) { const float b0 = cst[4 * lane], a0 = cst[4 * lane + 1], b1 = cst[4 * lane + 2], a1 = cst[4 * lane + 3];
        float B = b0 + b1, A = fmaxf(a0 + b1, a1);
#pragma unroll
        for (int o = 1; o < 64; o <<= 1) { const float Bp = __shfl_up(B, o), Ap = __shfl_up(A, o); if (lane >= o) { A = fmaxf(Ap + B, A); B = Bp + B; } }
        float Be = __shfl_up(B, 1), Ae = __shfl_up(A, 1); if (lane == 0) { Be = 0.f; Ae = -INFINITY; }
        const float m_in = fmaxf(Be + 0.f, Ae);
        const float m_mid = fmaxf(b0 + m_in, a0);
        marr[2 * lane] = m_in; marr[2 * lane + 1] = m_mid; fbarr[2 * lane] = Be; fbarr[2 * lane + 1] = Be + b0;
        if (lane == 63) { marr[128] = fmaxf(b1 + m_mid, a1); fbarr[128] = B; } }
    __syncthreads();
    const float* mstg = (const float*)(ws + OFF_MST);
    if (tid < 16) { float c = 0.f; if (tid < g) c = __expf(mstg[u - g + tid] + (fbarr[8 * g] - fbarr[8 * (tid + 1)]) - marr[8 * g]); coef[tid] = c; }
    __syncthreads();
    f32x16 cacc[2];
    { float cseg[32];
#pragma unroll
      for (int i = 0; i < 32; ++i) cseg[i] = 0.f;
      float nsg = 0.f;
      const bf16_t* stall = (const bf16_t*)(ws + OFF_STATE); const float* nstall = (const float*)(ws + OFF_NST);
#pragma unroll 4
      for (int gp = 0; gp < g; ++gp) { const float c = coef[gp]; const bf16_t* st = stall + (size_t)(u - g + gp) * 16384;
#pragma unroll
          for (int i = 0; i < 4; ++i) { const u32x4 v = *(const u32x4*)(st + (i * 512 + tid) * 8);
#pragma unroll
              for (int e = 0; e < 4; ++e) { cseg[i * 8 + 2 * e] += c * bflo(v[e]); cseg[i * 8 + 2 * e + 1] += c * bfhi(v[e]); } }
          if (tid < 128) nsg += c * nstall[(size_t)(u - g + gp) * 128 + tid]; }
      if (tid < 128) nseg[tid] = nsg;
      float* tmp = (float*)lds;
#pragma unroll
      for (int i = 0; i < 4; ++i) { *(f32x4*)(tmp + (i * 512 + tid) * 8) = (f32x4){cseg[i * 8], cseg[i * 8 + 1], cseg[i * 8 + 2], cseg[i * 8 + 3]}; *(f32x4*)(tmp + (i * 512 + tid) * 8 + 4) = (f32x4){cseg[i * 8 + 4], cseg[i * 8 + 5], cseg[i * 8 + 6], cseg[i * 8 + 7]}; }
      __syncthreads();
#pragma unroll
      for (int nb2 = 0; nb2 < 2; ++nb2)
#pragma unroll
          for (int r = 0; r < 16; ++r) cacc[nb2][r] = tmp[(wr * 32 + crow(r, hi)) * 128 + wc * 64 + nb2 * 32 + r32];
    }
    const int tb = wid & 1, db = wid >> 1;
    const int s0 = tid >> 4, c8 = tid & 15; const size_t gbase = (size_t)(tok0 + s0) * 512 + h * 128 + c8 * 8;
    u32x4 qa0 = *(const u32x4*)(mq + gbase), qa1 = *(const u32x4*)(mq + gbase + 32 * 512), ka0 = *(const u32x4*)(mk + gbase), ka1 = *(const u32x4*)(mk + gbase + 32 * 512),
          va0 = *(const u32x4*)(mv + gbase), va1 = *(const u32x4*)(mv + gbase + 32 * 512);
#pragma unroll 1
    for (int j = 0; j < 8; ++j) {
        int tz = threadIdx.x; asm volatile("" : "+v"(tz));
        const int tid = tz, lane = tz & 63, r32 = lane & 31, hi = lane >> 5; const int wid = RFL(tz >> 6), wr = wid >> 1, wc = wid & 1, tb = wid & 1, db = wid >> 1, s0 = tz >> 4, c8 = tz & 15;
        const int c = 8 * g + j; const float mc = marr[c], mn = marr[c + 1], bl = sbl[j]; const float decay = __expf(bl + mc - mn);
        asm volatile("s_waitcnt lgkmcnt(0)" ::: "memory"); __builtin_amdgcn_s_barrier();
#pragma unroll
        for (int nb2 = 0; nb2 < 2; ++nb2)
#pragma unroll
            for (int r = 0; r < 16; ++r) *(bf16_t*)(lds + LDS_M2_C + (2 * wc + nb2) * 8192 + (wr * 32 + crow(r, hi)) * 64 + r32 * 2) = (bf16_t)(cvtpk(cacc[nb2][r], 0.f) & 0xffffu);
        float* ncur = (j & 1) ? nfull : nseg; float* nnxt = (j & 1) ? nseg : nfull;
        { const float w0 = __expf(bl + sgs[j * 64 + s0] - mn), w1 = __expf(bl + sgs[j * 64 + s0 + 32] - mn);
          u32x4 k0, k1;
#pragma unroll
          for (int e = 0; e < 4; ++e) { k0[e] = cvtpk(bflo(ka0[e]) * w0, bfhi(ka0[e]) * w0); k1[e] = cvtpk(bflo(ka1[e]) * w1, bfhi(ka1[e]) * w1); }
          const int so0 = s0 * 256 + ((c8 ^ (s0 & 15)) << 4), so1 = (s0 + 32) * 256 + ((c8 ^ (s0 & 15)) << 4);
          *(u32x4*)(lds + LDS_M2_Q + so0) = qa0; *(u32x4*)(lds + LDS_M2_Q + so1) = qa1; *(u32x4*)(lds + LDS_M2_K + so0) = ka0; *(u32x4*)(lds + LDS_M2_K + so1) = ka1;
          const int off = (c8 >> 2) * 4096 + s0 * 64 + (c8 & 3) * 16;
          *(u32x4*)(lds + LDS_M2_V + off) = va0; *(u32x4*)(lds + LDS_M2_V + off + 32 * 64) = va1; *(u32x4*)(lds + LDS_M2_KS + off) = k0; *(u32x4*)(lds + LDS_M2_KS + off + 32 * 64) = k1; }
        if (tid < 64) swi[tid] = __expf(mc - fmaxf(spm[j * 64 + tid], mc));
        const int ft = tid >> 3, pp = tid & 7; const size_t ftok = (size_t)tok0 + j * 64 + ft; const int fch = h * 128 + 16 * pp;
        u32x4 xa, xb, za, zb;
        asm volatile("s_waitcnt lgkmcnt(0)" ::: "memory"); __builtin_amdgcn_s_barrier();
        xa = *(const u32x4*)(xc + ftok * 512 + fch); xb = *(const u32x4*)(xc + ftok * 512 + fch + 8);
        za = *(const u32x4*)(proj + ftok * INWP + C_Z + fch); zb = *(const u32x4*)(proj + ftok * INWP + C_Z + fch + 8);
        { const int t = 32 * tb + r32; const float mt = fmaxf(spm[j * 64 + t], mc);
          const char* qrow = lds + LDS_M2_Q + t * 256;
          f32x16 sT[2]; sT[0] = f32x16{}; sT[1] = f32x16{};
#pragma unroll
          for (int ks = 0; ks < 8; ++ks) { const bf16x8 qf = *(const bf16x8*)(qrow + (((2 * ks + hi) ^ (t & 15)) << 4));
              { const int s = r32; const bf16x8 kf = *(const bf16x8*)(lds + LDS_M2_K + s * 256 + (((2 * ks + hi) ^ (s & 15)) << 4)); sT[0] = MFMA32(kf, qf, sT[0]); }
              if (tb) { const int s = 32 + r32; const bf16x8 kf = *(const bf16x8*)(lds + LDS_M2_K + s * 256 + (((2 * ks + hi) ^ (s & 15)) << 4)); sT[1] = MFMA32(kf, qf, sT[1]); } }
          float dsum = 0.f;
#pragma unroll
          for (int sbk = 0; sbk < 2; ++sbk)
#pragma unroll
              for (int r = 0; r < 16; ++r) { const int s = 32 * sbk + crow(r, hi); const float w = (s <= t) ? __expf(sgs[j * 64 + s] - mt) : 0.f; const float v = sT[sbk][r] * w; sT[sbk][r] = v; dsum += v; }
          dsum += __shfl_xor(dsum, 32);
          if (db == 0 && hi == 0) sden[t] = dsum;
          u32x4 pw[4];
#pragma unroll
          for (int i = 0; i < 4; ++i) { pw[0][i] = cvtpk(sT[0][2 * i], sT[0][2 * i + 1]); pw[1][i] = cvtpk(sT[0][8 + 2 * i], sT[0][8 + 2 * i + 1]); pw[2][i] = cvtpk(sT[1][2 * i], sT[1][2 * i + 1]); pw[3][i] = cvtpk(sT[1][8 + 2 * i], sT[1][8 + 2 * i + 1]); }
          const int q = (lane & 15) >> 2, p = lane & 3, cb = (lane >> 4) & 1;
          const lds_cptr vp = (lds_cptr)lds + LDS_M2_V + db * 4096 + (4 * hi + q) * 64 + cb * 32 + p * 8;
          f32x16 o1 = f32x16{}, o2 = f32x16{};
#pragma unroll
          for (int ks = 0; ks < 4; ++ks) { if (ks < 2 * (tb + 1)) { const bf16x8 vf = cat8(vtr(vp + ks * 1024), vtr(vp + ks * 1024 + 512)); o1 = MFMA32(__builtin_bit_cast(bf16x8, pw[ks]), vf, o1); } }
          const lds_cptr cp = (lds_cptr)lds + LDS_M2_C + db * 8192 + (8 * hi + q) * 64 + cb * 32 + p * 8;
#pragma unroll
          for (int ks = 0; ks < 8; ++ks) { const bf16x8 qf = *(const bf16x8*)(qrow + (((2 * ks + hi) ^ (t & 15)) << 4)); const bf16x8 cf = cat8(vtr(cp + ks * 1024), vtr(cp + ks * 1024 + 256)); o2 = MFMA32(qf, cf, o2); }
          float* num = (float*)(lds + LDS_M2_NUM);
#pragma unroll
          for (int r = 0; r < 16; ++r) { const int tr_ = 32 * tb + crow(r, hi); num[tr_ * 132 + db * 32 + r32] = o1[r] + swi[tr_] * o2[r]; }
          { const size_t gn = gbase + (size_t)(j < 7 ? j + 1 : 7) * 64 * 512; qa0 = *(const u32x4*)(mq + gn); qa1 = *(const u32x4*)(mq + gn + 32 * 512); ka0 = *(const u32x4*)(mk + gn); ka1 = *(const u32x4*)(mk + gn + 32 * 512);
              va0 = *(const u32x4*)(mv + gn); va1 = *(const u32x4*)(mv + gn + 32 * 512); }
#pragma unroll
          for (int r = 0; r < 16; ++r) { cacc[0][r] *= decay; cacc[1][r] *= decay; }
          const lds_cptr kp = (lds_cptr)lds + LDS_M2_KS + wr * 4096 + (4 * hi + q) * 64 + cb * 32 + p * 8;
          const lds_cptr vp2 = (lds_cptr)lds + LDS_M2_V + (2 * wc) * 4096 + (4 * hi + q) * 64 + cb * 32 + p * 8;
#pragma unroll
          for (int ks = 0; ks < 4; ++ks) { const bf16x8 af = cat8(vtr(kp + ks * 1024), vtr(kp + ks * 1024 + 512));
              const bf16x8 b0 = cat8(vtr(vp2 + ks * 1024), vtr(vp2 + ks * 1024 + 512)), b1 = cat8(vtr(vp2 + 4096 + ks * 1024), vtr(vp2 + 4096 + ks * 1024 + 512));
              cacc[0] = MFMA32(af, b0, cacc[0]); cacc[1] = MFMA32(af, b1, cacc[1]); }
          if (tid < 128) { float a = 0.f; const char* kcol = lds + LDS_M2_KS + (tid >> 5) * 4096 + (tid & 31) * 2;
#pragma unroll 8
              for (int s2 = 0; s2 < 64; ++s2) a += bf2f(*(const bf16_t*)(kcol + s2 * 64));
              nnxt[tid] = decay * ncur[tid] + a; } }
        asm volatile("s_waitcnt lgkmcnt(0)" ::: "memory"); __builtin_amdgcn_s_barrier();
        { const int t = ft; const float* num = (const float*)(lds + LDS_M2_NUM);
          float qn = 0.f;
#pragma unroll
          for (int cc = 0; cc < 2; ++cc) { const u32x4 qv = *(const u32x4*)(lds + LDS_M2_Q + t * 256 + (((2 * pp + cc) ^ (t & 15)) << 4));
#pragma unroll
              for (int e = 0; e < 4; ++e) qn += bflo(qv[e]) * ncur[16 * pp + 8 * cc + 2 * e] + bfhi(qv[e]) * ncur[16 * pp + 8 * cc + 2 * e + 1]; }
          qn += __shfl_xor(qn, 1); qn += __shfl_xor(qn, 2); qn += __shfl_xor(qn, 4);
          const float mt = sb[j * 64 + t] + fmaxf(spm[j * 64 + t], mc);
          float den = sden[t] + swi[t] * qn; den = fmaxf(fabsf(den), __expf(-mt)); const float rden = __builtin_amdgcn_rcpf(den);
          float hv[16]; float s1 = 0.f;
#pragma unroll
          for (int e = 0; e < 16; ++e) { hv[e] = num[t * 132 + 16 * pp + e] * rden; s1 += hv[e]; }
          s1 += __shfl_xor(s1, 1); s1 += __shfl_xor(s1, 2); s1 += __shfl_xor(s1, 4);
          const float mu = s1 * (1.0f / 128.0f); float s2 = 0.f;
#pragma unroll
          for (int e = 0; e < 16; ++e) { const float d = hv[e] - mu; s2 += d * d; }
          s2 += __shfl_xor(s2, 1); s2 += __shfl_xor(s2, 2); s2 += __shfl_xor(s2, 4);
          const float rstd = rsqrtf(s2 * (1.0f / 128.0f) + EPS);
          float ov[16];
#pragma unroll
          for (int e = 0; e < 16; ++e) { const unsigned xw = e < 8 ? xa[e >> 1] : xb[(e - 8) >> 1], zw = e < 8 ? za[e >> 1] : zb[(e - 8) >> 1];
              const float xcv = (e & 1) ? bfhi(xw) : bflo(xw), zv = (e & 1) ? bfhi(zw) : bflo(zw);
              const float hn = (hv[e] - mu) * rstd * gsk[16 * pp + e];
              ov[e] = (hn + gsk[128 + 16 * pp + e] * xcv) * siluf(zv); }
          u32x4 oa, ob;
#pragma unroll
          for (int e = 0; e < 4; ++e) { oa[e] = cvtpk(ov[2 * e], ov[2 * e + 1]); ob[e] = cvtpk(ov[8 + 2 * e], ov[8 + 2 * e + 1]); }
          *(u32x4*)(mlo + ftok * 1024 + fch) = oa; *(u32x4*)(mlo + ftok * 1024 + fch + 8) = ob; }
    }
}

__device__ __forceinline__ void phase_outproj(const Params& P, char* lds) {
    unsigned char* ws = P.ws; const bf16_t* mix = (const bf16_t*)(ws + OFF_MIX); const bf16_t* Wt = (const bf16_t*)(ws + OFF_WO);
    const int G = gridDim.x, xs = xcd_slot();
    g8::phase((LAS unsigned char*)lds,
      [&](int i, g8::Unit& u) { const int id = xs + i * G; if (id >= 128 * 4) return false; const int mt = id >> 2, nt = id & 3;
          u.A = (const char*)(mix + (size_t)mt * 256 * DM); u.B = (const char*)(Wt + (size_t)nt * 256 * DM); u.gather = nullptr; u.nvalid = 0; u.K = DM; u.perm = 1; u.i0 = mt; u.i1 = nt; u.i2 = 0; return true; },
      [&](const f32x4 (&acc)[2][2][4][2], const g8::Unit& u, int wr, int wc, int fr, int fq) {
        const int m0 = u.i0 * 256, n0 = u.i1 * 256;
        int rl = 64 * wr + fr, cl = 32 * wc + 8 * fq; asm volatile("" : "+v"(rl), "+v"(cl));
        const size_t e0 = (size_t)(m0 + rl) * DM + n0 + cl;
        u32x4 xw[2][4][2];
#pragma unroll
        for (int ai = 0; ai < 2; ++ai)
#pragma unroll
            for (int m = 0; m < 4; ++m)
#pragma unroll
                for (int bj = 0; bj < 2; ++bj) xw[ai][m][bj] = *(const u32x4*)((const bf16_t*)(P.ws + OFF_XN) + e0 + (size_t)(128 * ai + 16 * m) * DM + 128 * bj);
#pragma unroll
        for (int ai = 0; ai < 2; ++ai) {
#pragma unroll
            for (int m = 0; m < 4; ++m) { float ss = 0.f;
#pragma unroll
                for (int bj = 0; bj < 2; ++bj) { const u32x4 w = xw[ai][m][bj]; const f32x4 x0 = (f32x4){bflo(w.x), bfhi(w.x), bflo(w.y), bfhi(w.y)} + acc[ai][bj][m][0], x1 = (f32x4){bflo(w.z), bfhi(w.z), bflo(w.w), bfhi(w.w)} + acc[ai][bj][m][1];
#pragma unroll
                    for (int e = 0; e < 4; ++e) ss += x0[e] * x0[e] + x1[e] * x1[e];
                    st8bf((bf16_t*)(P.ws + OFF_RES) + e0 + (size_t)(128 * ai + 16 * m) * DM + 128 * bj, x0, x1); }
                ss += __shfl_xor(ss, 16); ss += __shfl_xor(ss, 32);
                if (fq == 0) ((float*)(P.ws + OFF_SSQ))[(size_t)(m0 + rl + 128 * ai + 16 * m) * 16 + u.i1 * 4 + wc] = ss; } }
      });
}

constexpr int LDS_LOGIT = 4 * 32768;
__device__ __forceinline__ void phase_router(const Params& P, char* lds) {
    unsigned char* ws = P.ws; const bool shd = (P.sub & 256) != 0; const bf16_t* res = (const bf16_t*)(ws + OFF_RES); const bf16_t* Wr = (const bf16_t*)(ws + OFF_WR);
    unsigned* cnt = (unsigned*)(ws + OFF_CNT + (shd ? 8192 : 0)); int* list = (int*)(ws + (shd ? OFF_PROJ + 64 * MiB : OFF_LIST)); float* tokrec = (float*)(ws + (shd ? OFF_PROJ + 72 * MiB : OFF_TOKREC));
    float* lrs = (float*)(ws + (shd ? OFF_PROJ + 84 * MiB : OFF_LRS));
    const int tid = threadIdx.x, lane = tid & 63, wid = RFL(tid >> 6), wr = wid >> 1, wc = wid & 1, fr = lane & 15, fq = lane >> 4;
    float* logit = (float*)(lds + LDS_LOGIT); float* rsl = logit + 128 * 40;
    unsigned* lcnt = (unsigned*)(rsl + 128); unsigned* lbase = lcnt + NEXP;
    if (tid < NEXP) lcnt[tid] = 0u;
    for (int u = blockIdx.x; u < 256; u += gridDim.x) {
        const int m0 = u * 128;
        __syncthreads();
        if (tid < 128) { const f32x4* pp = (const f32x4*)((const float*)(ws + OFF_SSQ) + (size_t)(m0 + tid) * 16); const f32x4 s4 = pp[0] + pp[1] + pp[2] + pp[3];
            rsl[tid] = rsqrtf((s4[0] + s4[1] + s4[2] + s4[3]) * (1.0f / DM) + EPS); }
        { f32x4 acc[2][4]; gemm_ring128(acc, gdesc(res, DM, m0, Wr, DM, 16), lds);
            if (wc == 0) {
#pragma unroll
                for (int m = 0; m < 2; ++m) { const int lr = wr * 32 + 16 * m + fr;
#pragma unroll
                    for (int n = 0; n < 3; ++n) { const int col = 16 * n + 4 * fq; if (col < 36) *(f32x4*)(logit + lr * 40 + col) = acc[m][n]; } } } }
        __syncthreads();
        int ex1 = 0, ex2 = 0; unsigned p1 = 0u, p2 = 0u; float w1 = 0.f, w2 = 0.f, rs = 0.f;
        if (tid < 128) { const float* lg = logit + tid * 40;
            float gl[4]; float gm = -INFINITY; int gi = 0; rs = rsl[tid];
#pragma unroll
            for (int k = 0; k < 4; ++k) { gl[k] = lg[k] * rs + P.b_rg[k]; if (gl[k] > gm) { gm = gl[k]; gi = k; } }
            float gsum = 0.f;
#pragma unroll
            for (int k = 0; k < 4; ++k) gsum += __expf(gl[k] - gm);
            const float gtop = 1.0f / gsum;
            float el[8]; float e1 = -INFINITY, e2 = -INFINITY; int i1 = 0, i2 = 0;
#pragma unroll
            for (int k = 0; k < 8; ++k) { el[k] = lg[4 + gi * 8 + k] * rs + P.b_re[gi * 8 + k]; }
#pragma unroll
            for (int k = 0; k < 8; ++k) { if (el[k] > e1) { e2 = e1; i2 = i1; e1 = el[k]; i1 = k; } else if (el[k] > e2) { e2 = el[k]; i2 = k; } }
            const float rr = __expf(e2 - e1); w1 = gtop / (1.f + rr); w2 = gtop * rr / (1.f + rr);
            ex1 = gi * 8 + i1; ex2 = gi * 8 + i2;
            p1 = atomicAdd(lcnt + ex1, 1u); p2 = atomicAdd(lcnt + ex2, 1u); }
        __syncthreads();
        if (tid < NEXP) { const unsigned c = lcnt[tid]; lbase[tid] = c ? __hip_atomic_fetch_add(cnt + tid * 64, c, __ATOMIC_RELAXED, __HIP_MEMORY_SCOPE_AGENT) : 0u; lcnt[tid] = 0u; }
        __syncthreads();
        if (tid < 128) { const int tok = m0 + tid; p1 += lbase[ex1]; p2 += lbase[ex2];
            list[(size_t)ex1 * T_TOK + p1] = tok; list[(size_t)ex2 * T_TOK + p2] = tok; lrs[(size_t)ex1 * T_TOK + p1] = rs; lrs[(size_t)ex2 * T_TOK + p2] = rs;
            f32x4 rec; rec[0] = __uint_as_float((unsigned)(ex1 << 16) | 0u); rec[1] = w1; rec[2] = __uint_as_float(p1); rec[3] = w2;
            rec[0] = __uint_as_float((unsigned)ex1 | ((unsigned)ex2 << 8));
            *(f32x4*)(tokrec + (size_t)tok * 4) = rec;
            ((unsigned*)(ws + (shd ? OFF_PROJ + 80 * MiB : OFF_GATES)))[tok] = p2;
        }
        __syncthreads();
    }
}

__device__ __forceinline__ int moe_bases(const Params& P, int* sbase, int* stile) {
    const unsigned* cnt = (const unsigned*)(P.ws + OFF_CNT);
    __syncthreads();
    if (threadIdx.x < NEXP) {
        const int lane = threadIdx.x; const int c = (int)__hip_atomic_load(cnt + lane * 64, __ATOMIC_RELAXED, __HIP_MEMORY_SCOPE_AGENT); const int nt = (c + 255) >> 8;
        int incl = nt;
#pragma unroll
        for (int o = 1; o < NEXP; o <<= 1) { const int v = __shfl_up(incl, o); if (lane >= o) incl += v; }
        stile[lane] = incl - nt; sbase[lane] = (incl - nt) * 256;
        if (lane == NEXP - 1) { stile[NEXP] = incl; sbase[NEXP] = incl * 256; } }
    __syncthreads();
    return stile[NEXP];
}

constexpr int LDS_MOE = 4 * 32768 + 1024;
__device__ __forceinline__ void pe_unit(const Params& P, int pid, g8::Unit& u) { const int mt = pid >> 2, nt = pid & 3;
    u.A = (const char*)((const bf16_t*)(P.ws + OFF_PB) + (size_t)mt * 256 * 256); u.B = (const char*)((const bf16_t*)(P.ws + OFF_WPLE) + (size_t)nt * 256 * 256); u.gather = nullptr; u.nvalid = 0; u.K = 256; u.perm = 1; u.i0 = mt * 256; u.i1 = nt; u.i2 = -1; }
__device__ __forceinline__ void pe_store(bf16_t* pe, const f32x4 (&acc)[2][2][4][2], const g8::Unit& u, int wr, int wc, int fr, int fq) {
    int rl = 64 * wr + fr, cl = 32 * wc + 8 * fq; asm volatile("" : "+v"(rl), "+v"(cl));
    bf16_t* base = pe + ((size_t)u.i0 + rl) * DM + u.i1 * 256 + cl;
#pragma unroll
    for (int ai = 0; ai < 2; ++ai)
#pragma unroll
      for (int m = 0; m < 4; ++m)
#pragma unroll
        for (int bj = 0; bj < 2; ++bj) st8bf(base + (size_t)(128 * ai + 16 * m) * DM + 128 * bj, acc[ai][bj][m][0], acc[ai][bj][m][1]);
}
struct PeSplit { int R6, r6, R7, r7, npe6, npe7; };
__device__ __forceinline__ PeSplit pe_split(int ntiles, int G) { PeSplit s; const int n6 = ntiles * 2, n7 = ntiles * 4;
    s.R6 = (n6 + G - 1) / G; s.r6 = n6 - (s.R6 - 1) * G; s.R7 = (n7 + G - 1) / G; s.r7 = n7 - (s.R7 - 1) * G;
    s.npe6 = min(512, 2 * (G - s.r6)); s.npe7 = min(512, s.npe6 + (G - s.r7)); return s; }
__device__ __forceinline__ void phase_moe_gu(const Params& P, char* lds) {
    unsigned char* ws = P.ws; const bf16_t* hn = (const bf16_t*)(ws + OFF_RES); bf16_t* act = (bf16_t*)(ws + OFF_ACT); const int* list = (const int*)(ws + OFF_LIST); const float* lrs = (const float*)(ws + OFF_LRS);
    const unsigned* cnt = (const unsigned*)(ws + OFF_CNT); bf16_t* pe = (bf16_t*)P.out;
    int* sbase = (int*)(lds + LDS_MOE); int* stile = sbase + 40;
    const int ntiles = moe_bases(P, sbase, stile);
    const int G = gridDim.x, xs = xcd_slot(); const PeSplit sp = pe_split(ntiles, G);
    g8::phase((LAS unsigned char*)lds,
      [&](int i, g8::Unit& u) { const int id = xs + i * G;
          if (id >= ntiles * 2) { const int f = i - (sp.R6 - 1), pid = 2 * (xs - sp.r6) + f; if (xs < sp.r6 || f > 1 || pid >= 512) return false; pe_unit(P, pid, u); return true; }
          const int ti = id >> 1, nt = id & 1; int e = 0; for (int k = 1; k < NEXP; ++k) if (stile[k] <= ti) e = k;
          const int it = ti - stile[e]; const int ce = (int)cnt[e * 64];
          u.A = (const char*)hn; u.B = (const char*)((const bf16_t*)(ws + OFF_WGU) + ((size_t)e * 512 + nt * 256) * 1024); u.gather = list + (size_t)e * T_TOK + it * 256; u.nvalid = ce - it * 256; u.K = DM; u.perm = 1;
          u.i0 = sbase[e] + it * 256; u.i1 = nt; u.i2 = e; return true; },
      [&](const f32x4 (&acc)[2][2][4][2], const g8::Unit& u, int wr, int wc, int fr, int fq) {
        if (u.i2 < 0) { pe_store(pe, acc, u, wr, wc, fr, fq); return; }
        int rl = 64 * wr + fr, cl = 32 * wc + 8 * fq; asm volatile("" : "+v"(rl), "+v"(cl));
        bf16_t* base = act + ((size_t)u.i0 + rl) * DEXP + u.i1 * 128 + cl; const float* lr = lrs + (u.gather - list) + rl;
        float rs8[8];
#pragma unroll
        for (int k = 0; k < 8; ++k) rs8[k] = lr[128 * (k >> 2) + 16 * (k & 3)];
#pragma unroll
        for (int ai = 0; ai < 2; ++ai)
#pragma unroll
          for (int m = 0; m < 4; ++m) { f32x4 v0, v1; const float rsv = (128 * ai + 16 * m + rl < u.nvalid) ? rs8[ai * 4 + m] : 0.f;
#pragma unroll
                for (int q = 0; q < 4; ++q) { v0[q] = siluf(acc[ai][0][m][0][q] * rsv) * (acc[ai][1][m][0][q] * rsv); v1[q] = siluf(acc[ai][0][m][1][q] * rsv) * (acc[ai][1][m][1][q] * rsv); }
                st8bf(base + (size_t)(128 * ai + 16 * m) * DEXP, v0, v1); }
      });
}
__device__ __forceinline__ void phase_moe_down(const Params& P, char* lds) {
    unsigned char* ws = P.ws; const bf16_t* act = (const bf16_t*)(ws + OFF_ACT); bf16_t* y = (bf16_t*)(ws + OFF_Y); bf16_t* pe = (bf16_t*)P.out;
    int* sbase = (int*)(lds + LDS_MOE); int* stile = sbase + 40;
    const int ntiles = moe_bases(P, sbase, stile);
    const int G = gridDim.x, xs = xcd_slot(); const PeSplit sp = pe_split(ntiles, G);
    g8::phase((LAS unsigned char*)lds,
      [&](int i, g8::Unit& u) { const int id = xs + i * G;
          if (id >= ntiles * 4) { const int pid = sp.npe6 + (xs - sp.r7); if (xs < sp.r7 || i != sp.R7 - 1 || pid >= 512) return false; pe_unit(P, pid, u); return true; }
          const int ti = id >> 2, nt = id & 3; int e = 0; for (int k = 1; k < NEXP; ++k) if (stile[k] <= ti) e = k;
          const int rbase = sbase[e] + (ti - stile[e]) * 256;
          u.A = (const char*)(act + (size_t)rbase * DEXP); u.B = (const char*)((const bf16_t*)(ws + OFF_WD) + ((size_t)e * 1024 + nt * 256) * 256); u.gather = nullptr; u.nvalid = 0; u.K = DEXP; u.perm = 1; u.i0 = rbase; u.i1 = nt; u.i2 = e; return true; },
      [&](const f32x4 (&acc)[2][2][4][2], const g8::Unit& u, int wr, int wc, int fr, int fq) {
        pe_store(u.i2 < 0 ? pe : y, acc, u, wr, wc, fr, fq);
      });
}
__device__ __forceinline__ void phase_combine(const Params& P, char* lds) {
    unsigned char* ws = P.ws; const bf16_t* y = (const bf16_t*)(ws + OFF_Y); float* rs2 = (float*)(ws + OFF_RS2); const float* tokrec = (const float*)(ws + OFF_TOKREC);
    int* sbase = (int*)(lds + LDS_MOE); int* stile = sbase + 40;
    (void)moe_bases(P, sbase, stile);
    const int tid = threadIdx.x, lane = tid & 63, wv = tid >> 6;
    const int rstep = gridDim.x * 8 * 4; f32x4 recn[4]; unsigned p2n[4];
    { const int r0 = (blockIdx.x * 8 + wv) * 4;
#pragma unroll
      for (int q = 0; q < 4; ++q) { recn[q] = *(const f32x4*)(tokrec + (size_t)(r0 + q) * 4); p2n[q] = ((const unsigned*)(ws + OFF_GATES))[r0 + q]; } }
    for (int r0 = (blockIdx.x * 8 + wv) * 4; r0 < T_TOK; r0 += rstep) {
        f32x4 rec[4]; unsigned p2[4];
#pragma unroll
        for (int q = 0; q < 4; ++q) { rec[q] = recn[q]; p2[q] = p2n[q]; }
        if (r0 + rstep < T_TOK) {
#pragma unroll
            for (int q = 0; q < 4; ++q) { recn[q] = *(const f32x4*)(tokrec + (size_t)(r0 + rstep + q) * 4); p2n[q] = ((const unsigned*)(ws + OFF_GATES))[r0 + rstep + q]; } }
        f32x4 a[4][4]; u32x4 ya[4][4];
#pragma unroll
        for (int q = 0; q < 4; ++q) { const unsigned ee = __float_as_uint(rec[q][0]); const int e1 = ee & 255, e2 = (ee >> 8) & 255; const unsigned p1 = __float_as_uint(rec[q][2]);
            const bf16_t* y1 = y + ((size_t)sbase[e1] + p1) * DM; const bf16_t* y2 = y + ((size_t)sbase[e2] + p2[q]) * DM;
            ld_row_bf16((const bf16_t*)(P.ws + OFF_RES) + (size_t)(r0 + q) * DM, lane, a[q]);
            ya[q][0] = *(const u32x4*)(y1 + lane * 8); ya[q][1] = *(const u32x4*)(y1 + 512 + lane * 8); ya[q][2] = *(const u32x4*)(y2 + lane * 8); ya[q][3] = *(const u32x4*)(y2 + 512 + lane * 8); }
#pragma unroll
        for (int q = 0; q < 4; ++q) { const float w1 = rec[q][1], w2 = rec[q][3]; bf16_t* xr = (bf16_t*)(P.ws + ((P.sub & 256) ? OFF_PROJ : OFF_RES)) + (size_t)(r0 + q) * DM;
#pragma unroll
            for (int e = 0; e < 2; ++e) { a[q][0][2 * e] += w1 * bflo(ya[q][0][e]) + w2 * bflo(ya[q][2][e]); a[q][0][2 * e + 1] += w1 * bfhi(ya[q][0][e]) + w2 * bfhi(ya[q][2][e]);
                a[q][1][2 * e] += w1 * bflo(ya[q][0][2 + e]) + w2 * bflo(ya[q][2][2 + e]); a[q][1][2 * e + 1] += w1 * bfhi(ya[q][0][2 + e]) + w2 * bfhi(ya[q][2][2 + e]);
                a[q][2][2 * e] += w1 * bflo(ya[q][1][e]) + w2 * bflo(ya[q][3][e]); a[q][2][2 * e + 1] += w1 * bfhi(ya[q][1][e]) + w2 * bfhi(ya[q][3][e]);
                a[q][3][2 * e] += w1 * bflo(ya[q][1][2 + e]) + w2 * bflo(ya[q][3][2 + e]); a[q][3][2 * e + 1] += w1 * bfhi(ya[q][1][2 + e]) + w2 * bfhi(ya[q][3][2 + e]); }
            st_row_bf16(xr, lane, a[q]);
            { float ss = 0.f;
#pragma unroll
              for (int i = 0; i < 4; ++i)
#pragma unroll
                for (int e = 0; e < 4; ++e) ss += a[q][i][e] * a[q][i][e];
              ss = wsum(ss); if (lane == 0) rs2[r0 + q] = rsqrtf(ss * (1.0f / DM) + EPS); } }
    }
}
__device__ __forceinline__ void phase_ple(const Params& P, char* lds) {
    unsigned char* ws = P.ws; const bf16_t* pb = (const bf16_t*)(ws + OFF_PB); bf16_t* pe = (bf16_t*)P.out; const bf16_t* res = (const bf16_t*)(ws + OFF_RES); bf16_t* xout = (bf16_t*)(ws + OFF_XN); const float* rs2 = (const float*)(ws + OFF_RS2);
    int* sbase = (int*)(lds + LDS_MOE); int* stile = sbase + 40;
    const int ntiles = moe_bases(P, sbase, stile);
    const int G = gridDim.x, xs = xcd_slot(); const int npe = pe_split(ntiles, G).npe7;
    g8::phase((LAS unsigned char*)lds,
      [&](int i, g8::Unit& u) { int id = xs, j = i, c;
          for (;;) { if (id >= 128 * 4) return false; c = (id >= npe) ? 2 : 1; if (j < c) break; j -= c; id += G; }
          const int mt = id >> 2, nt = id & 3, gate = (c == 1 || j == 1) ? 1 : 0; u.gather = nullptr; u.nvalid = 0; u.perm = 1; u.i0 = mt; u.i1 = nt; u.i2 = gate;
          if (gate) { u.A = (const char*)(res + (size_t)mt * 256 * DM); u.B = (const char*)((const bf16_t*)(ws + OFF_WPG) + (size_t)nt * 256 * DM); u.K = DM; }
          else { u.A = (const char*)(pb + (size_t)mt * 256 * 256); u.B = (const char*)((const bf16_t*)(ws + OFF_WPLE) + (size_t)nt * 256 * 256); u.K = 256; }
          return true; },
      [&](const f32x4 (&acc)[2][2][4][2], const g8::Unit& u, int wr, int wc, int fr, int fq) {
        const int m0 = u.i0 * 256, n0 = u.i1 * 256;
        int rl = 64 * wr + fr, cl = 32 * wc + 8 * fq; asm volatile("" : "+v"(rl), "+v"(cl));
        const size_t e0 = (size_t)(m0 + rl) * DM + n0 + cl;
        if (!u.i2) {
#pragma unroll
            for (int ai = 0; ai < 2; ++ai)
#pragma unroll
              for (int m = 0; m < 4; ++m)
#pragma unroll
                for (int bj = 0; bj < 2; ++bj) st8bf(pe + e0 + (size_t)(128 * ai + 16 * m) * DM + 128 * bj, acc[ai][bj][m][0], acc[ai][bj][m][1]);
            return; }
#define P9_LD(Q, S) do { _Pragma("unroll") for (int mm = 0; mm < 2; ++mm) { const int ai_ = (Q) >> 1, m_ = 2 * ((Q) & 1) + mm; r2##S[mm] = rs2[m0 + rl + 128 * ai_ + 16 * m_]; \
            _Pragma("unroll") for (int bj = 0; bj < 2; ++bj) { const size_t eo = e0 + (size_t)(128 * ai_ + 16 * m_) * DM + 128 * bj; pw##S[mm][bj] = *(const u32x4*)(pe + eo); xw##S[mm][bj] = *(const u32x4*)(res + eo); } } } while (0)
#define P9_ST(Q, S) do { _Pragma("unroll") for (int mm = 0; mm < 2; ++mm) { const int ai_ = (Q) >> 1, m_ = 2 * ((Q) & 1) + mm; \
            _Pragma("unroll") for (int bj = 0; bj < 2; ++bj) { const u32x4 p4 = pw##S[mm][bj], x4 = xw##S[mm][bj]; const f32x4 a0 = acc[ai_][bj][m_][0] * r2##S[mm], a1 = acc[ai_][bj][m_][1] * r2##S[mm]; f32x4 o0, o1; \
                o0[0] = bflo(x4.x) + bflo(p4.x) * sigmf(a0[0]); o0[1] = bfhi(x4.x) + bfhi(p4.x) * sigmf(a0[1]); o0[2] = bflo(x4.y) + bflo(p4.y) * sigmf(a0[2]); o0[3] = bfhi(x4.y) + bfhi(p4.y) * sigmf(a0[3]); \
                o1[0] = bflo(x4.z) + bflo(p4.z) * sigmf(a1[0]); o1[1] = bfhi(x4.z) + bfhi(p4.z) * sigmf(a1[1]); o1[2] = bflo(x4.w) + bflo(p4.w) * sigmf(a1[2]); o1[3] = bfhi(x4.w) + bfhi(p4.w) * sigmf(a1[3]); \
                st8bf(xout + e0 + (size_t)(128 * ai_ + 16 * m_) * DM + 128 * bj, o0, o1); } } } while (0)
        { u32x4 pwA[2][2], xwA[2][2], pwB[2][2], xwB[2][2]; float r2A[2], r2B[2];
          P9_LD(0, A); P9_LD(1, B); P9_ST(0, A); P9_LD(2, A); P9_ST(1, B); P9_LD(3, B); P9_ST(2, A); P9_ST(3, B); }
#undef P9_LD
#undef P9_ST
      });
}
__device__ __forceinline__ void phase_final(const Params& P) {
    const int tid = threadIdx.x, lane = tid & 63, wv = tid >> 6; const float* g = P.final_g; const bf16_t* res = (const bf16_t*)(P.ws + OFF_XN);
    f32x4 gv[4];
#pragma unroll
    for (int i = 0; i < 4; ++i) gv[i] = *(const f32x4*)(g + 256 * i + 4 * lane);
    const int rstep = gridDim.x * 8 * 4; u32x2 wn[4][4];
    { const int r0 = (blockIdx.x * 8 + wv) * 4;
#pragma unroll
      for (int q = 0; q < 4; ++q)
#pragma unroll
        for (int i = 0; i < 4; ++i) wn[q][i] = *(const u32x2*)(res + (size_t)(r0 + q) * DM + 256 * i + 4 * lane); }
    for (int r0 = (blockIdx.x * 8 + wv) * 4; r0 < T_TOK; r0 += rstep) {
        u32x2 w[4][4];
#pragma unroll
        for (int q = 0; q < 4; ++q)
#pragma unroll
            for (int i = 0; i < 4; ++i) w[q][i] = wn[q][i];
        { const int rn = (r0 + rstep < T_TOK) ? r0 + rstep : r0;
#pragma unroll
          for (int q = 0; q < 4; ++q)
#pragma unroll
            for (int i = 0; i < 4; ++i) wn[q][i] = *(const u32x2*)(res + (size_t)(rn + q) * DM + 256 * i + 4 * lane); }
#pragma unroll
        for (int q = 0; q < 4; ++q) { float* xr = P.out + (size_t)(r0 + q) * DM; f32x4 a[4]; float ss = 0.f;
#pragma unroll
            for (int i = 0; i < 4; ++i) { a[i] = (f32x4){bflo(w[q][i].x), bfhi(w[q][i].x), bflo(w[q][i].y), bfhi(w[q][i].y)};
#pragma unroll
                for (int e = 0; e < 4; ++e) ss += a[i][e] * a[i][e]; }
            ss = wsum(ss); const float r = rsqrtf(ss * (1.0f / DM) + EPS);
#pragma unroll
            for (int i = 0; i < 4; ++i) *(f32x4*)(xr + 256 * i + 4 * lane) = a[i] * r * gv[i]; } }
}
constexpr int NPHASE = 11;
constexpr int LDS_BYTES = 160 * 1024;
__global__ void __launch_bounds__(512, 2) mk_fwd(Params P) {
    extern __shared__ __attribute__((aligned(16))) char lds[];
    volatile LAS unsigned* xbw = (volatile LAS unsigned*)(LAS char*)(lds + LDS_BYTES - 16);
    if (threadIdx.x == 0) { xbw[0] = 0u; xbw[1] = 0u; xbw[2] = 0u; xbw[3] = 0u; }
    __syncthreads();
    XcdBarrier bar = xcd_barrier_post((unsigned*)(P.ws + OFF_BAR), xbw);
    const int lo = P.ph_lo, hi = P.ph_hi;
#define PH(k) (lo <= (k) && (k) < hi)
#define SEAM(k) if (lo <= (k) && (k) + 1 < hi) xcd_barrier(bar)
    if (PH(0)) phase_prep(P, lds);
    SEAM(0);
    if (PH(1) && !(P.sub & 8)) phase_inproj(P, lds);
    SEAM(1);
    if (PH(2)) { if (__builtin_amdgcn_readfirstlane(threadIdx.x) >= 256) __builtin_amdgcn_s_setprio(1);
        for (int u = blockIdx.x; u < 256; u += gridDim.x) { if (!(P.sub & 1)) mla_unit(P, u, lds); if (!(P.sub & 2)) mlstm_unit1(P, u, lds); }
        __builtin_amdgcn_s_setprio(0); }
    SEAM(2);
    if (PH(3)) {
        if (!(P.sub & 1)) for (int u = blockIdx.x; u < 512; u += gridDim.x) { const int x = u & 7, kk = u >> 3, bh = x + 8 * (kk >> 4), j = kk & 15;
#pragma unroll 1
            for (int hf = 0; hf < 2; ++hf) attn_unit(P, bh >> 3, bh & 7, hf ? 31 - j : j, lds); }
        if (!(P.sub & 2)) for (int u = blockIdx.x; u < 256; u += gridDim.x) mlstm_unit2(P, u, lds);
    }
    SEAM(3);
    if (PH(4)) phase_outproj(P, lds);
    SEAM(4);
    if (PH(5)) phase_router(P, lds);
    SEAM(5);
    if (PH(6)) phase_moe_gu(P, lds);
    SEAM(6);
    if (PH(7)) phase_moe_down(P, lds);
    SEAM(7);
    if (PH(8)) phase_combine(P, lds);
    SEAM(8);
    if (PH(9)) phase_ple(P, lds);
    SEAM(9);
    if (PH(10)) phase_final(P);
}

#ifndef DUP_PHASE
#define DUP_PHASE -1
#endif
#ifndef DUP_REPS
#define DUP_REPS 2
#endif
#ifndef DUP_SUB
#define DUP_SUB 0
#endif
#ifndef DBG_PHASES
#define DBG_PHASES 0
#endif
#ifndef DBG_OFF
#define DBG_OFF OFF_MQ
#endif
#ifndef DBG_LD
#define DBG_LD 512
#endif
#ifndef DBG_C0
#define DBG_C0 0
#endif
#ifndef DBG_NC
#define DBG_NC 512
#endif
#ifndef DBG_ROWS
#define DBG_ROWS T_TOK
#endif
__global__ void __launch_bounds__(256) dbg_dump(const bf16_t* src, float* out) {
    for (size_t i = (size_t)blockIdx.x * 256 + threadIdx.x; i < (size_t)T_TOK * DM; i += (size_t)gridDim.x * 256) { const size_t r = i / DM; const int c = (int)(i % DM); float a = 0.f;
        for (size_t rr = r; rr < (size_t)DBG_ROWS; rr += T_TOK) for (int cc = c; cc < DBG_NC; cc += DM) a += bf2f(src[rr * DBG_LD + DBG_C0 + cc]);
        out[i] = a; }
}
extern "C" void kernel_launch(void* const* d_in, const int* in_sizes, int n_in, void* d_out, int out_size, void* d_ws, size_t ws_size, hipStream_t stream) {
    static int grid = 0;
    if (grid == 0) {
        if (n_in != 31 || in_sizes[0] != T_TOK * DM || out_size != T_TOK * DM || ws_size < WS_END) { fprintf(stderr, "kernel_launch: unexpected shapes (n_in %d, ws %zu < %zu)\n", n_in, ws_size, (size_t)WS_END); grid = -1; return; }
        int dev = 0, cus = 0, per_cu = 0;
        if (hipGetDevice(&dev) != hipSuccess || hipDeviceGetAttribute(&cus, hipDeviceAttributeMultiprocessorCount, dev) != hipSuccess) { grid = -1; return; }
        if (hipFuncSetAttribute((const void*)mk_fwd, hipFuncAttributeMaxDynamicSharedMemorySize, LDS_BYTES) != hipSuccess) { fprintf(stderr, "kernel_launch: hipFuncSetAttribute failed\n"); grid = -1; return; }
        if (hipOccupancyMaxActiveBlocksPerMultiprocessor(&per_cu, (const void*)mk_fwd, 512, LDS_BYTES) != hipSuccess || per_cu < 1) fprintf(stderr, "kernel_launch: occupancy query reports %d\n", per_cu);
        (void)hipGetLastError();
        grid = cus;
    }
    if (grid < 0) return;
    (void)hipMemsetAsync(d_ws, 0, CTL_BYTES, stream);
    Params P{};
    P.x = (const float*)d_in[0]; P.p = (const float*)d_in[1]; P.pos = (const int*)d_in[2];
    P.norm_mix_g = (const float*)d_in[3]; P.w_in = (const float*)d_in[4]; P.q_norm_g = (const float*)d_in[5]; P.w_uq = (const float*)d_in[6]; P.kv_norm_g = (const float*)d_in[7]; P.w_ukv = (const float*)d_in[8];
    P.conv_w = (const float*)d_in[9]; P.conv_b = (const float*)d_in[10]; P.w_mq = (const float*)d_in[11]; P.w_mk = (const float*)d_in[12]; P.w_mv = (const float*)d_in[13];
    P.b_igate = (const float*)d_in[14]; P.b_fgate = (const float*)d_in[15]; P.mh_norm_g = (const float*)d_in[16]; P.ml_skip = (const float*)d_in[17]; P.w_o = (const float*)d_in[18];
    P.norm_ffn_g = (const float*)d_in[19]; P.w_rg = (const float*)d_in[20]; P.b_rg = (const float*)d_in[21]; P.w_re = (const float*)d_in[22]; P.b_re = (const float*)d_in[23];
    P.w_gate_e = (const float*)d_in[24]; P.w_up_e = (const float*)d_in[25]; P.w_down_e = (const float*)d_in[26]; P.norm_ple_g = (const float*)d_in[27]; P.w_ple = (const float*)d_in[28]; P.w_pg = (const float*)d_in[29]; P.final_g = (const float*)d_in[30];
    P.out = (float*)d_out; P.ws = (unsigned char*)d_ws;
#if DBG_PHASES
    for (int k = 0; k < DBG_PHASES; ++k) { P.ph_lo = k; P.ph_hi = k + 1; hipLaunchKernelGGL(mk_fwd, dim3(grid), dim3(512), LDS_BYTES, stream, P); }
    hipLaunchKernelGGL(dbg_dump, dim3(2048), dim3(256), 0, stream, (const bf16_t*)((unsigned char*)d_ws + DBG_OFF), (float*)d_out);
#elif MK_MULTI
    for (int k = 0; k < NPHASE; ++k) { P.ph_lo = k; P.ph_hi = k + 1;
        if (k == DUP_PHASE) for (int r = 0; r < DUP_REPS; ++r) { P.sub = DUP_SUB; hipLaunchKernelGGL(mk_fwd, dim3(grid), dim3(512), LDS_BYTES, stream, P); }
        P.sub = 0; hipLaunchKernelGGL(mk_fwd, dim3(grid), dim3(512), LDS_BYTES, stream, P); }
#else
    P.ph_lo = 0; P.ph_hi = NPHASE; hipLaunchKernelGGL(mk_fwd, dim3(grid), dim3(512), LDS_BYTES, stream, P);
#endif
}
```
